# Optimizing an MI355X kernel written in HIP

```python
import math
import jax, jax.numpy as jnp
from jax import lax
import numpy as np

D_MODEL = 1024
BATCH = 4
SEQ = 4096
DEPTH = 2
DEC_BATCH = 32
DEC_SEQ = 16
PAST_LEN = 1024

CHUNK = 64
MIX_WIDTH = D_MODEL
SSM_WIDTH = MIX_WIDTH // 4
SSM_GROUP = 16
SSM_GROUPS = SSM_WIDTH // SSM_GROUP
SSM_STATE = 64
DT_MIN = 0.001
DT_MAX = 0.1
HEAD_DIM = 64
ATT_WIDTH = MIX_WIDTH // 2
N_HEADS = ATT_WIDTH // HEAD_DIM
N_KV = N_HEADS // 4
Q_PER_KV = N_HEADS // N_KV
KV_WIDTH = N_KV * HEAD_DIM
WINDOW = 128
N_PREV_CHUNKS = WINDOW // CHUNK
ATT_SCALE = HEAD_DIM ** -0.5
LRU_WIDTH = MIX_WIDTH // 4
LRU_BLOCKS = 4
LRU_BLOCK = LRU_WIDTH // LRU_BLOCKS
CONV_WIDTH = 4
LRU_C = 8.0
OFF_Q = SSM_WIDTH
OFF_K = OFF_Q + ATT_WIDTH
OFF_V = OFF_K + KV_WIDTH
OFF_LX = OFF_V + KV_WIDTH
OFF_LG = OFF_LX + LRU_WIDTH
IN_WIDTH = OFF_LG + LRU_WIDTH
D_FF = 2816
EPS = 1e-6
NEG_INF = -1e30

kernel_name = 'hymba_s5_swa_rglru_streaming_step'


def _rms(x, g):
    xf = x.astype(jnp.float32)
    y = xf * lax.rsqrt(jnp.mean(xf * xf, axis=-1, keepdims=True) + EPS)
    return (y * g.astype(jnp.float32)).astype(x.dtype)


def _ffn(x, g, w_gate, w_up, w_down):
    h = _rms(x, g)
    return x + 0.5 * ((jax.nn.silu(h @ w_gate) * (h @ w_up)) @ w_down)


def _complex_combine(e1, e2):
    a1r, a1i, b1r, b1i = e1
    a2r, a2i, b2r, b2i = e2
    return (a2r * a1r - a2i * a1i,
            a2r * a1i + a2i * a1r,
            a2r * b1r - a2i * b1i + b2r,
            a2r * b1i + a2i * b1r + b2i)


def _real_combine(e1, e2):
    a1, b1 = e1
    a2, b2 = e2
    return a1 * a2, a2 * b1 + b2


def _s5(u, h0_re, h0_im, a_re, a_im, log_dt, b_re, b_im, c_re, c_im, d, w_glu):
    f32 = jnp.float32
    bn, L, _ = u.shape
    uf = u.astype(f32)
    ug = uf.reshape(bn, L, SSM_GROUPS, SSM_GROUP)
    a_re = a_re.astype(f32)
    a_im = a_im.astype(f32)
    dt = jnp.exp(log_dt.astype(f32))[:, None]
    mag = jnp.exp(a_re * dt)
    lb_re = mag * jnp.cos(a_im * dt)
    lb_im = mag * jnp.sin(a_im * dt)
    den = a_re * a_re + a_im * a_im
    nr = lb_re - 1.0
    k_re = (nr * a_re + lb_im * a_im) / den
    k_im = (lb_im * a_re - nr * a_im) / den
    b_re = b_re.astype(f32)
    b_im = b_im.astype(f32)
    bb_re = k_re[..., None] * b_re - k_im[..., None] * b_im
    bb_im = k_re[..., None] * b_im + k_im[..., None] * b_re
    x_re = jnp.einsum('gph,blgh->blgp', bb_re, ug)
    x_im = jnp.einsum('gph,blgh->blgp', bb_im, ug)
    h0_re = h0_re.astype(f32)
    h0_im = h0_im.astype(f32)
    x_re = x_re.at[:, 0].add(lb_re * h0_re - lb_im * h0_im)
    x_im = x_im.at[:, 0].add(lb_re * h0_im + lb_im * h0_re)
    a_full_re = jnp.broadcast_to(lb_re, x_re.shape)
    a_full_im = jnp.broadcast_to(lb_im, x_re.shape)
    _, _, h_re, h_im = lax.associative_scan(
        _complex_combine, (a_full_re, a_full_im, x_re, x_im), axis=1)
    y = (jnp.einsum('ghp,blgp->blgh', c_re.astype(f32), h_re)
         - jnp.einsum('ghp,blgp->blgh', c_im.astype(f32), h_im))
    y = y.reshape(bn, L, SSM_WIDTH) + d.astype(f32) * uf
    z = jax.nn.gelu(y)
    out = z * jax.nn.sigmoid(z @ w_glu.astype(f32))
    return out, h_re[:, -1], h_im[:, -1]


def _sink_softmax(s, sink):
    sk = jnp.broadcast_to(sink.astype(jnp.float32)[:, :, None, None], s.shape[:-1] + (1,))
    p = jax.nn.softmax(jnp.concatenate([s, sk], axis=-1), axis=-1)
    return p[..., :-1]


def _attn_prompt(q, k, v, sink):
    bn, L, _ = q.shape
    nc = L // CHUNK
    qc = q.reshape(bn, nc, CHUNK, N_KV, Q_PER_KV, HEAD_DIM)
    pad = ((0, 0), (N_PREV_CHUNKS, 0), (0, 0), (0, 0), (0, 0))
    kp = jnp.pad(k.reshape(bn, nc, CHUNK, N_KV, HEAD_DIM), pad)
    vp = jnp.pad(v.reshape(bn, nc, CHUNK, N_KV, HEAD_DIM), pad)
    kb = jnp.concatenate([kp[:, j:j + nc] for j in range(N_PREV_CHUNKS + 1)], axis=2)
    vb = jnp.concatenate([vp[:, j:j + nc] for j in range(N_PREV_CHUNKS + 1)], axis=2)
    chunk_ids = jnp.arange(nc)[:, None] - N_PREV_CHUNKS + jnp.arange(N_PREV_CHUNKS + 1)[None, :]
    valid = jnp.repeat(chunk_ids >= 0, CHUNK, axis=1)
    s = jnp.einsum('bcqhgd,bcshd->bchgqs', qc, kb).astype(jnp.float32) * ATT_SCALE
    s = jnp.where(valid[None, :, None, None, None, :], s, NEG_INF)
    p = _sink_softmax(s, sink)
    o = jnp.einsum('bchgqs,bcshd->bcqhgd', p.astype(vb.dtype), vb)
    return o.reshape(bn, L, ATT_WIDTH)


def _attn_sample(q, k, v, ck, cv, sink):
    bn, S, _ = q.shape
    qh = q.reshape(bn, S, N_KV, Q_PER_KV, HEAD_DIM)
    kk = jnp.concatenate([ck.astype(k.dtype), k.reshape(bn, S, N_KV, HEAD_DIM)], axis=1)
    vv = jnp.concatenate([cv.astype(v.dtype), v.reshape(bn, S, N_KV, HEAD_DIM)], axis=1)
    s = jnp.einsum('bqhgd,bshd->bhgqs', qh, kk).astype(jnp.float32) * ATT_SCALE
    p = _sink_softmax(s, sink)
    o = jnp.einsum('bhgqs,bshd->bqhgd', p.astype(vv.dtype), vv)
    return o.reshape(bn, S, ATT_WIDTH)


def _causal_conv(xb, prev, w, b):
    L = xb.shape[1]
    xp = jnp.concatenate([prev.astype(xb.dtype), xb], axis=1)
    acc = b + w[0] * xp[:, 0:L]
    for t in range(1, CONV_WIDTH):
        acc = acc + w[t] * xp[:, t:t + L]
    return acc, xp[:, -(CONV_WIDTH - 1):]


def _rg_lru(xc, h0, w_a, b_a, w_x, b_x, lam):
    f32 = jnp.float32
    bn, L, _ = xc.shape
    xf = xc.astype(f32)
    xb = xf.reshape(bn, L, LRU_BLOCKS, LRU_BLOCK)
    r = jax.nn.sigmoid(jnp.einsum('blni,nio->blno', xb, w_a.astype(f32)).reshape(bn, L, LRU_WIDTH) + b_a.astype(f32))
    i = jax.nn.sigmoid(jnp.einsum('blni,nio->blno', xb, w_x.astype(f32)).reshape(bn, L, LRU_WIDTH) + b_x.astype(f32))
    log_a = LRU_C * r * jax.nn.log_sigmoid(lam.astype(f32))
    a = jnp.exp(log_a)
    mult = jnp.sqrt(-jnp.expm1(2.0 * log_a))
    bterm = mult * i * xf
    bterm = bterm.at[:, 0].add(a[:, 0] * h0.astype(f32))
    _, h = lax.associative_scan(_real_combine, (a, bterm), axis=1)
    return h, h[:, -1]


def _mixer(h, p, st):
    f32 = jnp.float32
    bn, L, _ = h.shape
    proj = h @ p['w_in']
    u = proj[..., :OFF_Q]
    q = proj[..., OFF_Q:OFF_K]
    k = proj[..., OFF_K:OFF_V]
    v = proj[..., OFF_V:OFF_LX]
    xl = proj[..., OFF_LX:OFF_LG]
    gl = proj[..., OFF_LG:]
    sink = p['attn_sink'].reshape(N_KV, Q_PER_KV)
    if st is None:
        s_re = jnp.zeros((bn, SSM_GROUPS, SSM_STATE), f32)
        s_im = jnp.zeros((bn, SSM_GROUPS, SSM_STATE), f32)
        conv_prev = jnp.zeros((bn, CONV_WIDTH - 1, LRU_WIDTH), h.dtype)
        lru_h = jnp.zeros((bn, LRU_WIDTH), f32)
        y_att = _attn_prompt(q, k, v, sink)
        rows = min(WINDOW, L)
        new_k = k[:, L - rows:].reshape(bn, rows, N_KV, HEAD_DIM)
        new_v = v[:, L - rows:].reshape(bn, rows, N_KV, HEAD_DIM)
    else:
        ck, cv, s_re, s_im, conv_prev, lru_h = st
        y_att = _attn_sample(q, k, v, ck, cv, sink)
        new_k = k.reshape(bn, L, N_KV, HEAD_DIM)
        new_v = v.reshape(bn, L, N_KV, HEAD_DIM)
    y_ssm, n_re, n_im = _s5(u, s_re, s_im, p['ssm_a_re'], p['ssm_a_im'], p['ssm_log_dt'],
                            p['ssm_b_re'], p['ssm_b_im'], p['ssm_c_re'], p['ssm_c_im'],
                            p['ssm_d'], p['ssm_w_glu'])
    xc, new_conv = _causal_conv(xl, conv_prev, p['conv_w'], p['conv_b'])
    hl, new_lru = _rg_lru(xc, lru_h, p['lru_w_a'], p['lru_b_a'], p['lru_w_x'], p['lru_b_x'], p['lru_lambda'])
    y_lru = jax.nn.gelu(gl.astype(f32)) * hl
    g = p['out_norm']
    y = jnp.concatenate([
        _rms(y_ssm.astype(f32), g[:SSM_WIDTH]),
        _rms(y_att.astype(f32), g[SSM_WIDTH:SSM_WIDTH + ATT_WIDTH]),
        _rms(y_lru, g[SSM_WIDTH + ATT_WIDTH:]),
    ], axis=-1).astype(h.dtype)
    return y @ p['w_out'], (new_k, new_v, n_re, n_im, new_conv, new_lru)


def setup_inputs(seed: int = 0) -> dict:
    key = jax.random.key(seed)
    keys = iter(jax.random.split(key, 64))

    def nrm(shape, scale):
        return scale * jax.random.normal(next(keys), shape, jnp.float32)

    def unif(shape, lo, hi):
        return jax.random.uniform(next(keys), shape, jnp.float32, lo, hi)

    cache_len = min(WINDOW, PAST_LEN)
    n = jnp.arange(SSM_STATE, dtype=jnp.float32)
    lru_target = unif((DEPTH, LRU_WIDTH), 0.9, 0.999)
    lru_base = lru_target ** (1.0 / LRU_C)
    return {
        'x_prompt': nrm((BATCH, SEQ, D_MODEL), 1.0),
        'x_sample': nrm((DEC_BATCH, DEC_SEQ, D_MODEL), 1.0),
        'cache_k': nrm((DEPTH, DEC_BATCH, cache_len, N_KV, HEAD_DIM), 1.0),
        'cache_v': nrm((DEPTH, DEC_BATCH, cache_len, N_KV, HEAD_DIM), 1.0),
        'state_ssm_re': nrm((DEPTH, DEC_BATCH, SSM_GROUPS, SSM_STATE), 0.1),
        'state_ssm_im': nrm((DEPTH, DEC_BATCH, SSM_GROUPS, SSM_STATE), 0.1),
        'state_conv': nrm((DEPTH, DEC_BATCH, CONV_WIDTH - 1, LRU_WIDTH), 1.0),
        'state_lru': nrm((DEPTH, DEC_BATCH, LRU_WIDTH), 0.5),
        'ffn1_norm': 1.0 + nrm((DEPTH, D_MODEL), 0.01),
        'ffn1_w_gate': nrm((DEPTH, D_MODEL, D_FF), D_MODEL ** -0.5),
        'ffn1_w_up': nrm((DEPTH, D_MODEL, D_FF), D_MODEL ** -0.5),
        'ffn1_w_down': nrm((DEPTH, D_FF, D_MODEL), D_FF ** -0.5),
        'mix_norm': 1.0 + nrm((DEPTH, D_MODEL), 0.01),
        'w_in': nrm((DEPTH, D_MODEL, IN_WIDTH), D_MODEL ** -0.5),
        'ssm_a_re': -0.5 + nrm((DEPTH, SSM_GROUPS, SSM_STATE), 0.01),
        'ssm_a_im': math.pi * n + nrm((DEPTH, SSM_GROUPS, SSM_STATE), 0.01),
        'ssm_log_dt': unif((DEPTH, SSM_GROUPS), math.log(DT_MIN), math.log(DT_MAX)),
        'ssm_b_re': nrm((DEPTH, SSM_GROUPS, SSM_STATE, SSM_GROUP), (2 * SSM_GROUP) ** -0.5),
        'ssm_b_im': nrm((DEPTH, SSM_GROUPS, SSM_STATE, SSM_GROUP), (2 * SSM_GROUP) ** -0.5),
        'ssm_c_re': nrm((DEPTH, SSM_GROUPS, SSM_GROUP, SSM_STATE), SSM_STATE ** -0.5),
        'ssm_c_im': nrm((DEPTH, SSM_GROUPS, SSM_GROUP, SSM_STATE), SSM_STATE ** -0.5),
        'ssm_d': nrm((DEPTH, SSM_WIDTH), 0.5),
        'ssm_w_glu': nrm((DEPTH, SSM_WIDTH, SSM_WIDTH), SSM_WIDTH ** -0.5),
        'attn_sink': nrm((DEPTH, N_HEADS), 0.5),
        'conv_w': nrm((DEPTH, CONV_WIDTH, LRU_WIDTH), CONV_WIDTH ** -0.5),
        'conv_b': nrm((DEPTH, LRU_WIDTH), 0.01),
        'lru_w_a': nrm((DEPTH, LRU_BLOCKS, LRU_BLOCK, LRU_BLOCK), LRU_BLOCK ** -0.5),
        'lru_b_a': nrm((DEPTH, LRU_WIDTH), 0.01),
        'lru_w_x': nrm((DEPTH, LRU_BLOCKS, LRU_BLOCK, LRU_BLOCK), LRU_BLOCK ** -0.5),
        'lru_b_x': nrm((DEPTH, LRU_WIDTH), 0.01),
        'lru_lambda': jnp.log(lru_base) - jnp.log1p(-lru_base),
        'out_norm': 1.0 + nrm((DEPTH, MIX_WIDTH), 0.01),
        'w_out': nrm((DEPTH, MIX_WIDTH, D_MODEL), MIX_WIDTH ** -0.5),
        'ffn2_norm': 1.0 + nrm((DEPTH, D_MODEL), 0.01),
        'ffn2_w_gate': nrm((DEPTH, D_MODEL, D_FF), D_MODEL ** -0.5),
        'ffn2_w_up': nrm((DEPTH, D_MODEL, D_FF), D_MODEL ** -0.5),
        'ffn2_w_down': nrm((DEPTH, D_FF, D_MODEL), D_FF ** -0.5),
        'final_norm': 1.0 + nrm((D_MODEL,), 0.01),
    }


def reference(x_prompt, x_sample, cache_k, cache_v, state_ssm_re, state_ssm_im, state_conv, state_lru,
              ffn1_norm, ffn1_w_gate, ffn1_w_up, ffn1_w_down, mix_norm, w_in,
              ssm_a_re, ssm_a_im, ssm_log_dt, ssm_b_re, ssm_b_im, ssm_c_re, ssm_c_im, ssm_d, ssm_w_glu,
              attn_sink, conv_w, conv_b, lru_w_a, lru_b_a, lru_w_x, lru_b_x, lru_lambda,
              out_norm, w_out, ffn2_norm, ffn2_w_gate, ffn2_w_up, ffn2_w_down, final_norm):

    def run(x, states_in):
        collected = [[], [], [], [], [], []]
        for l in range(DEPTH):
            p = {
                'w_in': w_in[l], 'ssm_a_re': ssm_a_re[l], 'ssm_a_im': ssm_a_im[l],
                'ssm_log_dt': ssm_log_dt[l], 'ssm_b_re': ssm_b_re[l], 'ssm_b_im': ssm_b_im[l],
                'ssm_c_re': ssm_c_re[l], 'ssm_c_im': ssm_c_im[l], 'ssm_d': ssm_d[l],
                'ssm_w_glu': ssm_w_glu[l], 'attn_sink': attn_sink[l], 'conv_w': conv_w[l],
                'conv_b': conv_b[l], 'lru_w_a': lru_w_a[l], 'lru_b_a': lru_b_a[l],
                'lru_w_x': lru_w_x[l], 'lru_b_x': lru_b_x[l], 'lru_lambda': lru_lambda[l],
                'out_norm': out_norm[l], 'w_out': w_out[l],
            }
            x = _ffn(x, ffn1_norm[l], ffn1_w_gate[l], ffn1_w_up[l], ffn1_w_down[l])
            st = None if states_in is None else tuple(s[l] for s in states_in)
            m, new = _mixer(_rms(x, mix_norm[l]), p, st)
            x = x + m
            x = _ffn(x, ffn2_norm[l], ffn2_w_gate[l], ffn2_w_up[l], ffn2_w_down[l])
            for lst, s in zip(collected, new):
                lst.append(s)
        return _rms(x, final_norm), [jnp.stack(c, axis=0) for c in collected]

    y_prompt, (k_p, v_p, sre_p, sim_p, conv_p, lru_p) = run(x_prompt, None)
    y_sample, (k_s, v_s, sre_s, sim_s, conv_s, lru_s) = run(
        x_sample, (cache_k, cache_v, state_ssm_re, state_ssm_im, state_conv, state_lru))
    return (y_prompt, y_sample, k_p, v_p, sre_p, sim_p, conv_p, lru_p,
            k_s, v_s, sre_s, sim_s, conv_s, lru_s)
```

```cpp
#include <hip/hip_runtime.h>
#include <hip/hip_cooperative_groups.h>
#include <cstdio>
namespace cg = cooperative_groups;
namespace pg8 {
#define PG8_LAS __attribute__((address_space(3)))
typedef unsigned short bf16_t;
typedef short bf16x8 __attribute__((ext_vector_type(8)));
typedef float f32x4 __attribute__((ext_vector_type(4)));
typedef unsigned u32x4 __attribute__((ext_vector_type(4)));
constexpr int BM = 256, BK = 64, HALF = 128, HTB = HALF * BK * 2  , STAGE_BYTES = 8 * HTB, NXCD = 8, WGM = 8;

__host__ __device__ __forceinline__ int lds_byte(int r, int c) { const int st = (r >> 4) * 2 + (c >> 5), rr = r & 15, cc = c & 31, ob = rr * 64 + cc * 2; return st * 1024 + (ob ^ (((ob >> 9) & 1) << 5)); }
__host__ __device__ __forceinline__ void stage_rc(int b, int& R, int& C) { const int st = b / 1024, sb = b % 1024, swz = sb ^ (((sb >> 9) & 1) << 5); R = (st >> 1) * 16 + swz / 64; C = (st & 1) * 32 + (swz % 64) / 2; }
__host__ __device__ __forceinline__ int perm32(int rho) { const int n = rho >> 4, i = rho & 15; return 8 * (i >> 2) + 4 * n + (i & 3); }

struct Unit { int pm, pn; };
struct Gemm { const bf16_t* A; const bf16_t* Bt; int M, N, K; };

struct StaticOrder {
    int nM, nN, nwg, G, c;
    __host__ __device__ void init(int M, int N, int G_, int c_) { nM = M / BM; nN = N / BM; nwg = nM * nN; G = G_; c = c_; }
    __host__ __device__ bool next(int i, Unit& u) const {
        const long L = (long)i * G + c; if (L >= nwg) return false;
        int wgid = (int)L; { const int q = nwg / NXCD, r = nwg % NXCD, xcd = wgid % NXCD, off = wgid / NXCD; wgid = (xcd < r ? xcd * (q + 1) : r * (q + 1) + (xcd - r) * q) + off; }
        const int nig = WGM * nN, gid = wgid / nig, fm = gid * WGM, gsz = (nM - fm) < WGM ? (nM - fm) : WGM;
        u.pm = fm + ((wgid % nig) % gsz); u.pn = (wgid % nig) / gsz; return true;
    }
    __device__ __forceinline__ void a_ready(const Unit&) const {}
    __device__ __forceinline__ void done(const Unit&) const {}
};
__device__ __forceinline__ unsigned cvt_pk_bf16(float lo, float hi) { unsigned r; asm volatile("v_cvt_pk_bf16_f32 %0, %1, %2" : "=v"(r) : "v"(lo), "v"(hi)); return r; }
typedef float f32x2 __attribute__((ext_vector_type(2)));
template <class Epi, class Sched, bool STAMP = false>
__device__ __forceinline__ void gemm_phase(PG8_LAS unsigned char* lds, const Gemm g, const Sched& S, const Epi& E, unsigned long long* stamps, const int tid) {
    const int wid = __builtin_amdgcn_readfirstlane(tid >> 6), lane = tid & 63, wr = wid >> 2, wc = wid & 3, fr = lane & 15, fq = lane >> 4;
    const int K = g.K, nt = K / BK;
    int ts_lo = 0, ts_hi = 0, nts = 0; const unsigned long long rt_entry = STAMP ? (unsigned long long)wall_clock64() : 0ull;
#define PG8_STAMP() do { if (STAMP && wid == 0 && nts < 64) { const unsigned long long _c = (unsigned long long)clock64(); \
        ts_lo = (lane == nts) ? (int)(unsigned)_c : ts_lo; ts_hi = (lane == nts) ? (int)(unsigned)(_c >> 32) : ts_hi; ++nts; } } while (0)
    PG8_STAMP();
    unsigned voffA[2], voffB[2];
#pragma unroll
    for (int i = 0; i < 2; ++i) { int R, C; stage_rc(tid * 16 + i * 8192, R, C); const int Rb = Epi::PERM ? ((R & ~31) + perm32(R & 31)) : R;
        voffA[i] = (unsigned)(R * K + C) * 2u; voffB[i] = (unsigned)(Rb * K + C) * 2u; }
    const size_t kstep = (size_t)(BK * 2);
    const size_t hstep = (size_t)HALF * K * 2;
    const size_t tstep = 2 * hstep;
    const unsigned ldsw = (unsigned)wid * 1024u;
    const int aoff = lds_byte(wr * 64 + fr, fq * 8), boff = lds_byte(wc * 32 + fr, fq * 8);
#define PG8_SA(b, h) (((b) * 2 + (h)) * HTB)
#define PG8_SB(b, h) ((4 + (b) * 2 + (h)) * HTB)
#define PG8_STAGE(bufoff, gbase, voff) do { _Pragma("unroll") for (int _i = 0; _i < 2; ++_i) \
        __builtin_amdgcn_global_load_lds((const unsigned*)((const char*)(gbase) + (voff)[_i]), (PG8_LAS unsigned*)(lds + (bufoff) + ldsw + _i * 8192), 16, 0, 0); } while (0)
#define PG8_LDA(dst, b, h) do { _Pragma("unroll") for (int m = 0; m < 4; ++m) _Pragma("unroll") for (int k = 0; k < 2; ++k) dst[m][k] = *(const PG8_LAS bf16x8*)(lds + PG8_SA(b, h) + aoff + m * 2048 + k * 1024); } while (0)
#define PG8_LDB(dst, b, h) do { _Pragma("unroll") for (int n = 0; n < 2; ++n) _Pragma("unroll") for (int k = 0; k < 2; ++k) dst[n][k] = *(const PG8_LAS bf16x8*)(lds + PG8_SB(b, h) + boff + n * 2048 + k * 1024); } while (0)
#define PG8_MMA(ai, bj, At, Bt) do { __builtin_amdgcn_s_setprio(1); _Pragma("unroll") for (int m = 0; m < 4; ++m) _Pragma("unroll") for (int n = 0; n < 2; ++n) _Pragma("unroll") for (int k = 0; k < 2; ++k) \
        acc[ai][bj][m][n] = __builtin_amdgcn_mfma_f32_16x16x32_bf16(Bt[n][k], At[m][k], acc[ai][bj][m][n], 0, 0, 0); __builtin_amdgcn_s_setprio(0); } while (0)
#define PG8_WAIT_V(n) asm volatile("s_waitcnt vmcnt(" #n ")" ::: "memory")
#define PG8_WAIT_L(n) asm volatile("s_waitcnt lgkmcnt(" #n ")" ::: "memory")
#define PG8_BAR __builtin_amdgcn_s_barrier()
#define PG8_SCHED __builtin_amdgcn_sched_barrier(0)
    Unit cur, nxt; int ui = 0;
    if (!S.next(0, cur)) return;
    f32x4 acc[2][2][4][2];
#pragma unroll
    for (int a = 0; a < 2; ++a)
#pragma unroll
        for (int b = 0; b < 2; ++b)
#pragma unroll
            for (int m = 0; m < 4; ++m)
#pragma unroll
                for (int n = 0; n < 2; ++n) acc[a][b][m][n] = (f32x4){0.f, 0.f, 0.f, 0.f};
    bf16x8 At[4][2], B0[2][2], B1[2][2];
    const char* cA = (const char*)g.A + (size_t)cur.pm * tstep; const char* cB = (const char*)g.Bt + (size_t)cur.pn * tstep;
    S.a_ready(cur);
    PG8_STAGE(PG8_SB(0, 0), cB, voffB); PG8_STAGE(PG8_SA(0, 0), cA, voffA); PG8_STAGE(PG8_SB(0, 1), cB + hstep, voffB); PG8_STAGE(PG8_SA(0, 1), cA + hstep, voffA);
    if (wr == 1) PG8_BAR;
    PG8_WAIT_V(4); PG8_BAR;
    PG8_STAGE(PG8_SB(1, 0), cB + kstep, voffB); PG8_STAGE(PG8_SA(1, 0), cA + kstep, voffA); PG8_STAGE(PG8_SB(1, 1), cB + hstep + kstep, voffB);
    PG8_WAIT_V(6); PG8_BAR;
    PG8_STAMP();
    for (;;) {
        const bool has_next = S.next(ui + 1, nxt);
        const char* nA = has_next ? (const char*)g.A + (size_t)nxt.pm * tstep : cA; const char* nB = has_next ? (const char*)g.Bt + (size_t)nxt.pn * tstep : cB;
        for (int t = 0; t < nt; t += 2) {
            const bool last = (t == nt - 2);
            const char* a1 = cA + (size_t)(t + 1) * kstep;
            const char* a2 = last ? nA : cA + (size_t)(t + 2) * kstep; const char* b2 = last ? nB : cB + (size_t)(t + 2) * kstep;
            const char* a3 = a2 + kstep; const char* b3 = b2 + kstep;
            if (last && has_next) S.a_ready(nxt);
            PG8_LDB(B0, 0, 0); PG8_SCHED; PG8_LDA(At, 0, 0); PG8_STAGE(PG8_SA(1, 1), a1 + hstep, voffA);
            PG8_WAIT_L(8); PG8_BAR; PG8_WAIT_L(0); PG8_MMA(0, 0, At, B0); PG8_BAR; PG8_SCHED;
            PG8_LDB(B1, 0, 1); PG8_STAGE(PG8_SB(0, 0), b2, voffB);
            PG8_BAR; PG8_WAIT_L(0); PG8_MMA(0, 1, At, B1); PG8_BAR;
            PG8_LDA(At, 0, 1); PG8_STAGE(PG8_SA(0, 0), a2, voffA);
            PG8_BAR; PG8_WAIT_L(0); PG8_MMA(1, 0, At, B0); PG8_BAR; PG8_SCHED;
            PG8_STAGE(PG8_SB(0, 1), b2 + hstep, voffB);
            PG8_WAIT_V(6); PG8_BAR; PG8_MMA(1, 1, At, B1); PG8_BAR;
            PG8_LDB(B0, 1, 0); PG8_SCHED; PG8_LDA(At, 1, 0); PG8_STAGE(PG8_SA(0, 1), a2 + hstep, voffA);
            PG8_WAIT_L(8); PG8_BAR; PG8_WAIT_L(0); PG8_MMA(0, 0, At, B0); PG8_BAR; PG8_SCHED;
            PG8_LDB(B1, 1, 1); PG8_STAGE(PG8_SB(1, 0), b3, voffB);
            PG8_BAR; PG8_WAIT_L(0); PG8_MMA(0, 1, At, B1); PG8_BAR;
            PG8_LDA(At, 1, 1); PG8_STAGE(PG8_SA(1, 0), a3, voffA);
            PG8_BAR; PG8_WAIT_L(0); PG8_MMA(1, 0, At, B0); PG8_BAR; PG8_SCHED;
            PG8_STAGE(PG8_SB(1, 1), b3 + hstep, voffB);
            PG8_WAIT_V(6); PG8_BAR; PG8_MMA(1, 1, At, B1); PG8_BAR;
        }
        PG8_STAMP();
        if constexpr (!Epi::AFTER_DRAIN) { E(acc, cur, wr, wc, fr, fq); S.done(cur); }
        PG8_STAMP();
        if (!has_next) break;
#pragma unroll
        for (int a = 0; a < 2; ++a)
#pragma unroll
            for (int b = 0; b < 2; ++b)
#pragma unroll
                for (int m = 0; m < 4; ++m)
#pragma unroll
                    for (int n = 0; n < 2; ++n) acc[a][b][m][n] = (f32x4){0.f, 0.f, 0.f, 0.f};
        cur = nxt; cA = nA; cB = nB; ++ui;
    }
    PG8_WAIT_V(0);
    if (wr == 0) PG8_BAR;
    PG8_BAR;
    if constexpr (Epi::AFTER_DRAIN) { E.fused(acc, cur, wr, wc, fr, fq, lds, wid, lane); S.done(cur); }
    PG8_STAMP();
    if (STAMP && wid == 0) { stamps[lane] = lane < nts ? (((unsigned long long)(unsigned)ts_hi << 32) | (unsigned)ts_lo) : 0ull;
        if (lane == 62) stamps[62] = rt_entry; if (lane == 63) stamps[63] = (unsigned long long)wall_clock64(); }
#undef PG8_STAMP
#undef PG8_SA
#undef PG8_SB
#undef PG8_STAGE
#undef PG8_LDA
#undef PG8_LDB
#undef PG8_MMA
#undef PG8_WAIT_V
#undef PG8_WAIT_L
#undef PG8_BAR
#undef PG8_SCHED
}
}
using pg8::bf16_t; using pg8::bf16x8; using pg8::f32x4; using pg8::u32x4; using pg8::f32x2; using pg8::cvt_pk_bf16;
#define LAS __attribute__((address_space(3)))
typedef unsigned u32x2 __attribute__((ext_vector_type(2)));
typedef short s16x4 __attribute__((ext_vector_type(4)));
#define DI __device__ __forceinline__

constexpr int DM = 1024, MP = 16384, MS = 512, MT = 16896, DFF = 2816, NIN = 1536;
constexpr float EPS = 1e-6f;
constexpr int NTHR = 512;
constexpr int LDS_BYTES = 152 * 1024;

constexpr size_t SZ_WGU = (size_t)5632 * 1024 * 2, SZ_WD = (size_t)1024 * 2816 * 2, SZ_WIN = (size_t)1536 * 1024 * 2, SZ_WOUT = (size_t)1024 * 1024 * 2;
constexpr size_t WS_WGU = 0;
constexpr size_t WS_WD = WS_WGU + 4 * SZ_WGU;
constexpr size_t WS_WIN = WS_WD + 4 * SZ_WD;
constexpr size_t WS_WOUT = WS_WIN + 2 * SZ_WIN;
constexpr size_t SZ_XB = (size_t)MT * 1024 * 2;
constexpr size_t WS_XB = WS_WOUT + 2 * SZ_WOUT;
constexpr size_t WS_Y = WS_XB + SZ_XB;
constexpr size_t WS_BIG = WS_Y + SZ_XB;
constexpr size_t SZ_BIG = (size_t)MT * DFF * 2;
constexpr size_t SZ_F256 = (size_t)MT * 256 * 4;
constexpr size_t WS_XL = WS_BIG, WS_HL = WS_XL + SZ_F256, WS_PC = WS_HL + SZ_F256, WS_KBP = WS_PC + SZ_F256;
constexpr size_t SZ_KBP = (size_t)4 * 4096 * 128 * 2;
constexpr size_t WS_VTP = WS_KBP + SZ_KBP;
static_assert(WS_VTP + SZ_KBP <= WS_BIG + SZ_BIG, "mixer scratch must fit in the act buffer");
constexpr size_t WS_SS = WS_BIG + SZ_BIG;
constexpr size_t WS_KBS = WS_SS + (size_t)MT * 16 * 4;
constexpr size_t SZ_KBS = (size_t)32 * 160 * 128 * 2;
constexpr size_t WS_VTS = WS_KBS + 2 * SZ_KBS;
constexpr size_t WS_SSUM = WS_VTS + 2 * SZ_KBS;
constexpr size_t WS_LSUM = WS_SSUM + (size_t)4 * 64 * 16 * 64 * 8;
constexpr size_t WS_SPAR = WS_LSUM + (size_t)4 * 64 * 2 * 256 * 4;
constexpr size_t SZ_SPAR = 16384 + 131072;
constexpr size_t WS_CC = WS_SPAR + 2 * SZ_SPAR;
constexpr size_t WS_WGLU = WS_CC + 2 * 65536;
constexpr size_t WS_WAX = WS_WGLU + 2 * 131072;
constexpr size_t WS_END = WS_WAX + 2 * 65536;
static_assert(WS_END <= (size_t)256 * 1024 * 1024, "workspace budget");

constexpr size_t O_YP = 0, O_YS = (size_t)MP * 1024, O_KP = O_YS + (size_t)MS * 1024, O_VP = O_KP + 131072, O_SREP = O_VP + 131072, O_SIMP = O_SREP + 8192,
                 O_CONVP = O_SIMP + 8192, O_LRUP = O_CONVP + 6144, O_KS = O_LRUP + 2048, O_VS = O_KS + 131072, O_SRES = O_VS + 131072, O_SIMS = O_SRES + 65536,
                 O_CONVS = O_SIMS + 65536, O_LRUS = O_CONVS + 49152, O_END = O_LRUS + 16384;

struct Params { const float* in[38]; float* out; unsigned char* ws; int ph_lo, ph_hi; };
typedef const Params __attribute__((address_space(4))) CParams;

DI float bf2f(bf16_t v) { return __uint_as_float(((unsigned)v) << 16); }
DI bf16_t f2bf(float f) { return (bf16_t)(cvt_pk_bf16(f, 0.f) & 0xffffu); }
DI float sigmoidf_(float x) { return __builtin_amdgcn_rcpf(1.f + __expf(-x)); }
DI float gelu_tanh(float x) { const float v = 1.5957691216057308f * (x + 0.044715f * x * x * x); return x * __builtin_amdgcn_rcpf(1.f + __expf(-v)); }
DI f32x4 mfma16(bf16x8 a, bf16x8 b, f32x4 c) { return __builtin_amdgcn_mfma_f32_16x16x32_bf16(a, b, c, 0, 0, 0); }
DI f32x2 cmul(f32x2 a, f32x2 b) { return (f32x2){a.x * b.x - a.y * b.y, a.x * b.y + a.y * b.x}; }
DI float row_rstd(const float* ss, int row, float invn) {
    const f32x4* p = (const f32x4*)(ss + (size_t)row * 16); const f32x4 a = p[0], b = p[1], c = p[2], d = p[3];
    const f32x4 t = (a + b) + (c + d); return rsqrtf(((t[0] + t[1]) + (t[2] + t[3])) * invn + EPS);
}
DI void lds_fence() { asm volatile("s_waitcnt lgkmcnt(0)" ::: "memory"); }

struct EpiGateUp {
    static constexpr bool PERM = true, AFTER_DRAIN = false;
    bf16_t* act; const float* ss;
    DI void operator()(const f32x4 (&acc)[2][2][4][2], const pg8::Unit& u, int wr, int wc, int fr, int fq) const {
        const int row0 = u.pm * 256 + wr * 64 + fr, col = u.pn * 128 + wc * 32 + 8 * fq;
#pragma unroll
        for (int ai = 0; ai < 2; ++ai)
#pragma unroll
            for (int m = 0; m < 4; ++m) {
                const int row = row0 + ai * 128 + m * 16;
                const float rs = row_rstd(ss, row, 1.f / 1024.f);
                float o[8];
#pragma unroll
                for (int n = 0; n < 2; ++n)
#pragma unroll
                    for (int j = 0; j < 4; ++j) { const float g = acc[ai][0][m][n][j] * rs, up = acc[ai][1][m][n][j] * rs; o[n * 4 + j] = g * __builtin_amdgcn_rcpf(1.f + __expf(-g)) * up; }
                u32x4 w; w.x = cvt_pk_bf16(o[0], o[1]); w.y = cvt_pk_bf16(o[2], o[3]); w.z = cvt_pk_bf16(o[4], o[5]); w.w = cvt_pk_bf16(o[6], o[7]);
                *(u32x4*)(act + (size_t)row * DFF + col) = w;
            }
    }
};
struct EpiResid {
    static constexpr bool PERM = true, AFTER_DRAIN = false;
    const float* xin_p; const float* xin_s; float* xout; bf16_t* xb; float* ssout; float scale;
    DI void operator()(const f32x4 (&acc)[2][2][4][2], const pg8::Unit& u, int wr, int wc, int fr, int fq) const {
        const int row0 = u.pm * 256 + wr * 64 + fr, colb = u.pn * 256 + wc * 32 + 8 * fq;
#pragma unroll
        for (int ai = 0; ai < 2; ++ai)
#pragma unroll
            for (int m = 0; m < 4; ++m) {
                const int row = row0 + ai * 128 + m * 16;
                const float* xi = (row < MP) ? xin_p + (size_t)row * 1024 : xin_s + (size_t)(row - MP) * 1024;
                float* xo = xout + (size_t)row * 1024; bf16_t* xbo = xb + (size_t)row * 1024;
                float s = 0.f;
#pragma unroll
                for (int bj = 0; bj < 2; ++bj) {
                    const int col = colb + bj * 128;
                    const f32x4 a0 = *(const f32x4*)(xi + col), a1 = *(const f32x4*)(xi + col + 4);
                    const f32x4 v0 = a0 + acc[ai][bj][m][0] * scale, v1 = a1 + acc[ai][bj][m][1] * scale;
                    *(f32x4*)(xo + col) = v0; *(f32x4*)(xo + col + 4) = v1;
                    u32x4 w; w.x = cvt_pk_bf16(v0[0], v0[1]); w.y = cvt_pk_bf16(v0[2], v0[3]); w.z = cvt_pk_bf16(v1[0], v1[1]); w.w = cvt_pk_bf16(v1[2], v1[3]);
                    *(u32x4*)(xbo + col) = w;
                    s += (v0[0] * v0[0] + v0[1] * v0[1]) + (v0[2] * v0[2] + v0[3] * v0[3]) + (v1[0] * v1[0] + v1[1] * v1[1]) + (v1[2] * v1[2] + v1[3] * v1[3]);
                }
                s += __shfl_xor(s, 16); s += __shfl_xor(s, 32);
                if (fq == 0) ssout[(size_t)row * 16 + u.pn * 4 + wc] = s;
                asm volatile("" ::: "memory");
            }
    }
};
struct EpiProj {
    static constexpr bool PERM = true, AFTER_DRAIN = false;
    const float* ss; bf16_t* y; float* xl; bf16_t* kbp; bf16_t* vtp; bf16_t* kbs; bf16_t* vts; float* okp; float* ovp; float* oks; float* ovs;
    DI void operator()(const f32x4 (&acc)[2][2][4][2], const pg8::Unit& u, int wr, int wc, int fr, int fq) const {
        const int row0 = u.pm * 256 + wr * 64 + fr, cl = wc * 32 + 8 * fq;
        const int pn = u.pn;
#pragma unroll
        for (int ai = 0; ai < 2; ++ai)
#pragma unroll
            for (int m = 0; m < 4; ++m) {
                const int row = row0 + ai * 128 + m * 16;
                float rs = row_rstd(ss, row, 1.f / 1024.f);
                if (pn == 4) {
#pragma unroll
                    for (int bj = 0; bj < 2; ++bj) { float* d = xl + (size_t)row * 256 + bj * 128 + cl; *(f32x4*)d = acc[ai][bj][m][0] * rs; *(f32x4*)(d + 4) = acc[ai][bj][m][1] * rs; }
                } else if (pn == 3) {
#pragma unroll
                    for (int bj = 0; bj < 2; ++bj) {
                        const f32x4 v0 = acc[ai][bj][m][0] * rs, v1 = acc[ai][bj][m][1] * rs;
                        float* of; bf16_t* kd; bf16_t* vd; int vstride;
                        const int kvh = cl >> 6, d0 = cl & 63;
                        if (row < MP) {
                            const int b = row >> 12, pos = row & 4095;
                            of = (pos >= 3968) ? (bj == 0 ? okp : ovp) + ((size_t)(b * 128 + (pos - 3968))) * 128 + cl : nullptr;
                            kd = kbp + (size_t)row * 128 + cl; vd = vtp + ((size_t)((b * 2 + kvh) * 64 + d0)) * 4096 + pos; vstride = 4096;
                        } else {
                            const int sb = (row - MP) >> 4, t = (row - MP) & 15;
                            of = (bj == 0 ? oks : ovs) + ((size_t)(sb * 16 + t)) * 128 + cl;
                            kd = kbs + ((size_t)(sb * 160 + 128 + t)) * 128 + cl; vd = vts + ((size_t)((sb * 2 + kvh) * 64 + d0)) * 160 + 128 + t; vstride = 160;
                        }
                        if (of) { *(f32x4*)of = v0; *(f32x4*)(of + 4) = v1; }
                        if (bj == 0) { u32x4 w; w.x = cvt_pk_bf16(v0[0], v0[1]); w.y = cvt_pk_bf16(v0[2], v0[3]); w.z = cvt_pk_bf16(v1[0], v1[1]); w.w = cvt_pk_bf16(v1[2], v1[3]); *(u32x4*)kd = w; }
                        else {
#pragma unroll
                            for (int j = 0; j < 4; ++j) { vd[(size_t)j * vstride] = f2bf(v0[j]); vd[(size_t)(j + 4) * vstride] = f2bf(v1[j]); }
                        }
                    }
                } else {
                    const int cbase = (pn == 0) ? 0 : (pn == 5 ? 768 : 256 + (pn - 1) * 256);
                    if (pn == 1 || pn == 2) rs *= 0.125f;
#pragma unroll
                    for (int bj = 0; bj < 2; ++bj) {
                        const f32x4 v0 = acc[ai][bj][m][0] * rs, v1 = acc[ai][bj][m][1] * rs;
                        u32x4 w; w.x = cvt_pk_bf16(v0[0], v0[1]); w.y = cvt_pk_bf16(v0[2], v0[3]); w.z = cvt_pk_bf16(v1[0], v1[1]); w.w = cvt_pk_bf16(v1[2], v1[3]);
                        *(u32x4*)(y + (size_t)row * 1024 + cbase + bj * 128 + cl) = w;
                    }
                }
            }
    }
};
DI void prep_phase(CParams& P, LAS unsigned char* lds, const int tid) {
    const int nb = gridDim.x, bid = blockIdx.x, lane = tid & 63, wave = tid >> 6;
    unsigned char* ws = P.ws;
    LAS bf16_t* T = (LAS bf16_t*)lds;
    for (int tile = bid; tile < 2 * 2432; tile += nb) {
        const int l = tile / 2432, r = tile % 2432;
        int j, tl; if (r < 2112) { j = r / 352; tl = r % 352; } else if (r < 2304) { j = 6; tl = r - 2112; } else { j = 7; tl = r - 2304; }
        const float* src; const float* gain; bf16_t* dst; int K, N, map = 0;
        if (j == 0 || j == 1 || j == 3 || j == 4) {
            const int f = j >= 3; const int which = (j == 1 || j == 4);
            src = P.in[(f ? 34 : 9) + which] + (size_t)l * 1024 * 2816; gain = P.in[f ? 33 : 8] + l * 1024; dst = (bf16_t*)(ws + WS_WGU + (size_t)(l * 2 + f) * SZ_WGU); K = 1024; N = 2816; map = 1 + which;
        } else if (j == 2 || j == 5) {
            const int f = j == 5; src = P.in[f ? 36 : 11] + (size_t)l * 2816 * 1024; gain = nullptr; dst = (bf16_t*)(ws + WS_WD + (size_t)(l * 2 + f) * SZ_WD); K = 2816; N = 1024;
        } else if (j == 6) { src = P.in[13] + (size_t)l * 1024 * 1536; gain = P.in[12] + l * 1024; dst = (bf16_t*)(ws + WS_WIN + (size_t)l * SZ_WIN); K = 1024; N = 1536; }
        else { src = P.in[32] + (size_t)l * 1024 * 1024; gain = P.in[31] + l * 1024; dst = (bf16_t*)(ws + WS_WOUT + (size_t)l * SZ_WOUT); K = 1024; N = 1024; }
        const int nkt = K / 128, kt = tl % nkt, nt = tl / nkt, k0 = kt * 128, n0 = nt * 64;
        {
            const int k = tid >> 2, ns = (tid & 3) * 16;
            const float* s = src + (size_t)(k0 + k) * N + n0 + ns;
            const float g = gain ? gain[k0 + k] : 1.f;
            f32x4 v[4];
#pragma unroll
            for (int i = 0; i < 4; ++i) v[i] = *(const f32x4*)(s + 4 * i);
#pragma unroll
            for (int i = 0; i < 4; ++i)
#pragma unroll
                for (int e = 0; e < 4; ++e) T[(ns + 4 * i + e) * 136 + k] = f2bf(v[i][e] * g);
        }
        __syncthreads();
        {
            const int n = tid >> 3, ks = (tid & 7) * 16;
            const int ng = n0 + n; const int drow = (map == 0) ? ng : (256 * (ng >> 7) + (ng & 127) + (map == 2 ? 128 : 0));
            const u32x4 a = *(const LAS u32x4*)(T + n * 136 + ks), b = *(const LAS u32x4*)(T + n * 136 + ks + 8);
            bf16_t* d = dst + (size_t)drow * K + k0 + ks;
            *(u32x4*)d = a; *(u32x4*)(d + 8) = b;
        }
        __syncthreads();
    }
    {
        bf16_t* xb = (bf16_t*)(ws + WS_XB); float* ss0 = (float*)(ws + WS_SS);
        for (int row = bid * 8 + wave; row < MT; row += nb * 8) {
            const float* x = (row < MP) ? P.in[0] + (size_t)row * 1024 : P.in[1] + (size_t)(row - MP) * 1024;
            float s = 0.f;
#pragma unroll
            for (int i = 0; i < 4; ++i) {
                const f32x4 v = *(const f32x4*)(x + i * 256 + lane * 4);
                s += v[0] * v[0] + v[1] * v[1] + v[2] * v[2] + v[3] * v[3];
                u32x2 w; w.x = cvt_pk_bf16(v[0], v[1]); w.y = cvt_pk_bf16(v[2], v[3]);
                *(u32x2*)(xb + (size_t)row * 1024 + i * 256 + lane * 4) = w;
            }
#pragma unroll
            for (int o = 1; o < 64; o <<= 1) s += __shfl_xor(s, o);
            if (lane < 16) ss0[(size_t)row * 16 + lane] = (lane == 0) ? s : 0.f;
        }
    }
    const int gt = bid * NTHR + tid, gs = nb * NTHR;
    for (int e = gt; e < 2 * 32 * 128 * 128; e += gs) {
        const int c = e & 127, r = (e >> 7) & 127, sb = (e >> 14) & 31, l = e >> 19;
        bf16_t* kbs = (bf16_t*)(ws + WS_KBS + (size_t)l * SZ_KBS); bf16_t* vts = (bf16_t*)(ws + WS_VTS + (size_t)l * SZ_KBS);
        kbs[((size_t)(sb * 160 + r)) * 128 + c] = f2bf(P.in[2][e]);
        vts[((size_t)((sb * 2 + (c >> 6)) * 64 + (c & 63))) * 160 + r] = f2bf(P.in[3][e]);
    }
    for (int e = gt; e < 2 * 32 * 16 * 128; e += gs) {
        const int c = e & 127, r = (e >> 7) & 15, sb = (e >> 11) & 31, l = e >> 16;
        bf16_t* kbs = (bf16_t*)(ws + WS_KBS + (size_t)l * SZ_KBS); bf16_t* vts = (bf16_t*)(ws + WS_VTS + (size_t)l * SZ_KBS);
        kbs[((size_t)(sb * 160 + 144 + r)) * 128 + c] = 0;
        vts[((size_t)((sb * 2 + (c >> 6)) * 64 + (c & 63))) * 160 + 144 + r] = 0;
    }
    for (int e = gt; e < 2 * 16 * 64; e += gs) {
        const int p = e & 63, g = (e >> 6) & 15, l = e >> 10;
        const float dt = expf(P.in[16][l * 16 + g]);
        const float are = P.in[14][e], aim = P.in[15][e];
        const float mag = expf(are * dt);
        const float lbr = mag * cosf(aim * dt), lbi = mag * sinf(aim * dt);
        const float den = are * are + aim * aim, nr = lbr - 1.f;
        const float kr = (nr * are + lbi * aim) / den, ki = (lbi * are - nr * aim) / den;
        f32x2 pw = (f32x2){lbr, lbi};
#pragma unroll
        for (int i = 0; i < 6; ++i) pw = cmul(pw, pw);
        float* lb = (float*)(ws + WS_SPAR + (size_t)l * SZ_SPAR) + (size_t)(g * 64 + p) * 4;
        lb[0] = lbr; lb[1] = lbi; lb[2] = pw.x; lb[3] = pw.y;
        float* bb = (float*)(ws + WS_SPAR + (size_t)l * SZ_SPAR + 16384) + (size_t)(g * 64 + p) * 32;
        const float* bre = P.in[17] + (size_t)e * 16; const float* bim = P.in[18] + (size_t)e * 16;
#pragma unroll
        for (int h = 0; h < 16; ++h) { const float br = bre[h], bi = bim[h]; bb[2 * h] = kr * br - ki * bi; bb[2 * h + 1] = kr * bi + ki * br; }
    }
    for (int e = gt; e < 2 * 16 * 16 * 128; e += gs) {
        const int k = e & 127, h = (e >> 7) & 15, g = (e >> 11) & 15, l = e >> 15;
        const size_t si = ((size_t)((l * 16 + g) * 16 + h)) * 64 + (k & 63);
        ((bf16_t*)(ws + WS_CC))[e] = f2bf(k < 64 ? P.in[19][si] : -P.in[20][si]);
    }
    for (int e = gt; e < 2 * 256 * 256; e += gs) {
        const int k = e & 255, n = (e >> 8) & 255, l = e >> 16;
        ((bf16_t*)(ws + WS_WGLU))[e] = f2bf(P.in[22][((size_t)(l * 256 + k)) * 256 + n]);
    }
    for (int e = gt; e < 2 * 2 * 4 * 64 * 64; e += gs) {
        const int i = e & 63, o = (e >> 6) & 63, blk = (e >> 12) & 3, which = (e >> 14) & 1, l = e >> 15;
        ((bf16_t*)(ws + WS_WAX))[e] = f2bf(P.in[which ? 28 : 26][((size_t)((l * 4 + blk) * 64 + i)) * 64 + o]);
    }
}

DI f32x2 ssm_x(const f32x2 (&bb)[16], const LAS float* ut) {
    const f32x4 u0 = *(const LAS f32x4*)ut, u1 = *(const LAS f32x4*)(ut + 4), u2 = *(const LAS f32x4*)(ut + 8), u3 = *(const LAS f32x4*)(ut + 12);
    f32x2 xa = bb[0] * u0[0], xb = bb[1] * u0[1], xc = bb[2] * u0[2], xd = bb[3] * u0[3];
    xa += bb[4] * u1[0]; xb += bb[5] * u1[1]; xc += bb[6] * u1[2]; xd += bb[7] * u1[3];
    xa += bb[8] * u2[0]; xb += bb[9] * u2[1]; xc += bb[10] * u2[2]; xd += bb[11] * u2[3];
    xa += bb[12] * u3[0]; xb += bb[13] * u3[1]; xc += bb[14] * u3[2]; xd += bb[15] * u3[3];
    return (xa + xb) + (xc + xd);
}
DI void stage_u(const bf16_t* y, int row0, int T, LAS float* U32, int tid) {
    for (int idx = tid; idx < T * 32; idx += NTHR) {
        const int t = idx >> 5, seg = idx & 31;
        const u32x4 v = *(const u32x4*)(y + (size_t)(row0 + t) * 1024 + seg * 8);
        f32x4 a, b;
        a[0] = __uint_as_float(v.x << 16); a[1] = __uint_as_float(v.x & 0xffff0000u); a[2] = __uint_as_float(v.y << 16); a[3] = __uint_as_float(v.y & 0xffff0000u);
        b[0] = __uint_as_float(v.z << 16); b[1] = __uint_as_float(v.z & 0xffff0000u); b[2] = __uint_as_float(v.w << 16); b[3] = __uint_as_float(v.w & 0xffff0000u);
        *(LAS f32x4*)(U32 + t * 256 + seg * 8) = a; *(LAS f32x4*)(U32 + t * 256 + seg * 8 + 4) = b;
    }
}

DI void attn_item(CParams& P, int l, int it, LAS float* ssq, int wave, int lane) {
    unsigned char* ws = P.ws;
    bf16_t* Y = (bf16_t*)(ws + WS_Y);
    const int row0 = it * 16, fr = lane & 15, fq = lane >> 4;
    const bf16_t* kb; const bf16_t* vt; int lpad, npair;
    const bool smp = row0 >= MP;
    if (!smp) {
        const int b = row0 >> 12, t0 = row0 & 4095, c = t0 >> 6, c0 = c >= 2 ? c - 2 : 0, klo = c0 * 64, nkeys = (c + 1) * 64 - klo;
        kb = (const bf16_t*)(ws + WS_KBP) + ((size_t)(b * 4096 + klo)) * 128; vt = (const bf16_t*)(ws + WS_VTP) + (size_t)(b * 2) * 64 * 4096 + klo; lpad = 4096; npair = nkeys >> 5;
    } else {
        const int sb = (row0 - MP) >> 4;
        kb = (const bf16_t*)(ws + WS_KBS + (size_t)l * SZ_KBS) + (size_t)sb * 160 * 128; vt = (const bf16_t*)(ws + WS_VTS + (size_t)l * SZ_KBS) + (size_t)sb * 2 * 64 * 160; lpad = 160; npair = 5;
    }
    const int h = wave, kvh = h >> 2;
    bf16_t* yq = Y + (size_t)(row0 + fr) * 1024 + 256 + h * 64;
    const bf16x8 q0 = *(const bf16x8*)(yq + fq * 8), q1 = *(const bf16x8*)(yq + 32 + fq * 8);
    f32x4 s[12];
#pragma unroll
    for (int i = 0; i < 6; ++i) {
        if (i < npair) {
#pragma unroll
            for (int e = 0; e < 2; ++e) {
                const int kt = 2 * i + e;
                const bf16_t* kp = kb + (size_t)(kt * 16 + fr) * 128 + kvh * 64 + fq * 8;
                const bf16x8 k0 = *(const bf16x8*)kp, k1 = *(const bf16x8*)(kp + 32);
                f32x4 a = (f32x4){0.f, 0.f, 0.f, 0.f};
                a = mfma16(k0, q0, a); a = mfma16(k1, q1, a);
                s[kt] = a;
            }
        } else { s[2 * i] = (f32x4){-1e30f, -1e30f, -1e30f, -1e30f}; s[2 * i + 1] = s[2 * i]; }
    }
    if (smp) s[9] = (f32x4){-1e30f, -1e30f, -1e30f, -1e30f};
    const float sink = P.in[23][l * 8 + h];
    float mx = sink;
#pragma unroll
    for (int kt = 0; kt < 12; ++kt)
#pragma unroll
        for (int j = 0; j < 4; ++j) mx = fmaxf(mx, s[kt][j]);
    mx = fmaxf(mx, __shfl_xor(mx, 16)); mx = fmaxf(mx, __shfl_xor(mx, 32));
    float sum = 0.f;
#pragma unroll
    for (int kt = 0; kt < 12; ++kt)
#pragma unroll
        for (int j = 0; j < 4; ++j) { const float p = __expf(s[kt][j] - mx); s[kt][j] = p; sum += p; }
    sum += __shfl_xor(sum, 16); sum += __shfl_xor(sum, 32);
    const float inv = 1.f / (sum + __expf(sink - mx));
    f32x4 O[4];
#pragma unroll
    for (int dt = 0; dt < 4; ++dt) O[dt] = (f32x4){0.f, 0.f, 0.f, 0.f};
#pragma unroll
    for (int i = 0; i < 6; ++i) {
        if (i < npair) {
            u32x4 pw; pw.x = cvt_pk_bf16(s[2 * i][0], s[2 * i][1]); pw.y = cvt_pk_bf16(s[2 * i][2], s[2 * i][3]); pw.z = cvt_pk_bf16(s[2 * i + 1][0], s[2 * i + 1][1]); pw.w = cvt_pk_bf16(s[2 * i + 1][2], s[2 * i + 1][3]);
            const bf16x8 pb = __builtin_bit_cast(bf16x8, pw);
#pragma unroll
            for (int dt = 0; dt < 4; ++dt) {
                const bf16_t* vp = vt + (size_t)(kvh * 64 + dt * 16 + fr) * lpad + i * 32 + fq * 4;
                const s16x4 lo = *(const s16x4*)vp, hi = *(const s16x4*)(vp + 16);
                const bf16x8 vf = __builtin_shufflevector(lo, hi, 0, 1, 2, 3, 4, 5, 6, 7);
                O[dt] = mfma16(vf, pb, O[dt]);
            }
        }
    }
    float sl = 0.f;
#pragma unroll
    for (int dt = 0; dt < 4; ++dt) { O[dt] = O[dt] * inv; sl += O[dt][0] * O[dt][0] + O[dt][1] * O[dt][1] + O[dt][2] * O[dt][2] + O[dt][3] * O[dt][3]; }
    sl += __shfl_xor(sl, 16); sl += __shfl_xor(sl, 32);
    if (fq == 0) ssq[h * 16 + fr] = sl;
    __syncthreads();
    float tot = 0.f;
#pragma unroll
    for (int hh = 0; hh < 8; ++hh) tot += ssq[hh * 16 + fr];
    const float rs = rsqrtf(tot * (1.f / 512.f) + EPS);
#pragma unroll
    for (int dt = 0; dt < 4; ++dt) {
        u32x2 w; w.x = cvt_pk_bf16(O[dt][0] * rs, O[dt][1] * rs); w.y = cvt_pk_bf16(O[dt][2] * rs, O[dt][3] * rs);
        *(u32x2*)(yq + dt * 16 + fq * 4) = w;
    }
    __syncthreads();
}

DI void lru_item(CParams& P, int l, int li, LAS unsigned char* lds, int tid) {
    unsigned char* ws = P.ws;
    const int wave = tid >> 6, lane = tid & 63, fr = lane & 15, fq = lane >> 4;
    const bool smp = li >= 256;
    const int b = smp ? li - 256 : li >> 6, c = smp ? 0 : li & 63;
    const int row0 = smp ? MP + b * 16 : b * 4096 + c * 64;
    const int T = smp ? 16 : 64, TH = smp ? 16 : 32, nh = smp ? 1 : 2;
    const float* XL = (const float*)(ws + WS_XL); float* HL = (float*)(ws + WS_HL); float* PC = (float*)(ws + WS_PC);
    LAS float* XC32 = (LAS float*)lds; LAS float* A32 = (LAS float*)(lds + 32768); LAS bf16_t* XCB = (LAS bf16_t*)(lds + 65536);
    const int ch = tid & 255, part = tid >> 8;
    const float cw0 = P.in[24][(l * 4 + 0) * 256 + ch], cw1 = P.in[24][(l * 4 + 1) * 256 + ch], cw2 = P.in[24][(l * 4 + 2) * 256 + ch], cw3 = P.in[24][(l * 4 + 3) * 256 + ch], cb = P.in[25][l * 256 + ch];
    const int blk = wave >> 1, ob = (wave & 1) * 32;
    const bf16_t* WAX = (const bf16_t*)(ws + WS_WAX) + (size_t)l * 2 * 4 * 64 * 64;
    bf16x8 Bw[2][2][2];
#pragma unroll
    for (int gq = 0; gq < 2; ++gq)
#pragma unroll
        for (int ot = 0; ot < 2; ++ot)
#pragma unroll
            for (int ks = 0; ks < 2; ++ks) Bw[gq][ot][ks] = *(const bf16x8*)(WAX + ((size_t)((gq * 4 + blk) * 64 + ob + ot * 16 + fr)) * 64 + ks * 32 + fq * 8);
    float ba[2], bx[2], ls[2];
#pragma unroll
    for (int ot = 0; ot < 2; ++ot) { const int cc = blk * 64 + ob + ot * 16 + fr; ba[ot] = P.in[27][l * 256 + cc]; bx[ot] = P.in[29][l * 256 + cc]; ls[ot] = -log1pf(expf(-P.in[30][l * 256 + cc])); }
    float hl = 0.f, pc = 1.f;
    for (int hf = 0; hf < nh; ++hf) {
        {
            const int tper = TH >> 1, tb = part * tper;
            for (int tt = 0; tt < tper; ++tt) {
                const int t = tb + tt, pos = (smp ? 0 : c * 64) + hf * 32 + t;
                float xv[4];
#pragma unroll
                for (int j = 0; j < 4; ++j) {
                    const int pp = pos + j - 3;
                    if (pp >= 0) xv[j] = XL[((size_t)(smp ? MP + b * 16 : b * 4096) + pp) * 256 + ch];
                    else xv[j] = smp ? P.in[6][((size_t)((l * 32 + b) * 3 + (pp + 3))) * 256 + ch] : 0.f;
                }
                const float a = cb + cw0 * xv[0] + cw1 * xv[1] + cw2 * xv[2] + cw3 * xv[3];
                XC32[t * 256 + ch] = a; XCB[t * 264 + ch] = f2bf(a);
            }
        }
        __syncthreads();
#pragma unroll
        for (int tt = 0; tt < 2; ++tt) {
            if (tt * 16 < TH) {
                bf16x8 A[2];
#pragma unroll
                for (int ks = 0; ks < 2; ++ks) A[ks] = *(const LAS bf16x8*)(XCB + (tt * 16 + fr) * 264 + blk * 64 + ks * 32 + fq * 8);
#pragma unroll
                for (int ot = 0; ot < 2; ++ot) {
                    f32x4 ga = (f32x4){0.f, 0.f, 0.f, 0.f}, gx = ga;
#pragma unroll
                    for (int ks = 0; ks < 2; ++ks) { ga = mfma16(A[ks], Bw[0][ot][ks], ga); gx = mfma16(A[ks], Bw[1][ot][ks], gx); }
                    const int cc = blk * 64 + ob + ot * 16 + fr;
#pragma unroll
                    for (int j = 0; j < 4; ++j) {
                        const int t = tt * 16 + fq * 4 + j;
                        const float r = sigmoidf_(ga[j] + ba[ot]), ig = sigmoidf_(gx[j] + bx[ot]);
                        const float la = 8.f * r * ls[ot];
                        const float av = __expf(la), mult = sqrtf(-expm1f(2.f * la));
                        const float xc = XC32[t * 256 + cc];
                        XC32[t * 256 + cc] = mult * ig * xc; A32[t * 256 + cc] = av;
                    }
                }
            }
        }
        __syncthreads();
        if (tid < 256) {
            for (int t = 0; t < TH; ++t) {
                const float av = A32[t * 256 + ch], bt = XC32[t * 256 + ch];
                hl = av * hl + bt; pc = av * pc;
                const size_t r = (size_t)(row0 + hf * 32 + t) * 256 + ch;
                HL[r] = hl; PC[r] = pc;
            }
        }
        __syncthreads();
    }
    if (tid < 256) {
        if (!smp) { float* ls_ = (float*)(ws + WS_LSUM) + ((size_t)(b * 64 + c) * 2) * 256; ls_[ch] = pc; ls_[256 + ch] = hl; }
        if (smp) { for (int i = 0; i < 3; ++i) P.out[O_CONVS + ((size_t)((l * 32 + b) * 3 + i)) * 256 + ch] = XL[((size_t)(MP + b * 16 + 13 + i)) * 256 + ch]; }
        else if (c == 63) { for (int i = 0; i < 3; ++i) P.out[O_CONVP + ((size_t)((l * 4 + b) * 3 + i)) * 256 + ch] = XL[((size_t)(b * 4096 + 4093 + i)) * 256 + ch]; }
    }
    (void)T;
}

DI void ssma_item(CParams& P, int l, int si, LAS unsigned char* lds, int tid) {
    unsigned char* ws = P.ws;
    const int wave = tid >> 6, lane = tid & 63;
    const int b = si >> 6, c = si & 63, row0 = b * 4096 + c * 64;
    LAS float* U32 = (LAS float*)lds;
    stage_u((const bf16_t*)(ws + WS_Y), row0, 64, U32, tid);
    __syncthreads();
#pragma unroll 1
    for (int gi = 0; gi < 2; ++gi) {
        const int g = wave * 2 + gi;
        const float* spar = (const float*)(ws + WS_SPAR + (size_t)l * SZ_SPAR);
        const f32x4 lb4 = *(const f32x4*)(spar + (size_t)(g * 64 + lane) * 4);
        const f32x2 lb = (f32x2){lb4[0], lb4[1]};
        f32x2 bb[16];
        const float* bp = spar + 4096 + (size_t)(g * 64 + lane) * 32;
#pragma unroll
        for (int i = 0; i < 8; ++i) { const f32x4 v = *(const f32x4*)(bp + 4 * i); bb[2 * i] = (f32x2){v[0], v[1]}; bb[2 * i + 1] = (f32x2){v[2], v[3]}; }
        f32x2 H = (f32x2){0.f, 0.f};
        for (int t = 0; t < 64; ++t) { const f32x2 x = ssm_x(bb, U32 + t * 256 + g * 16); H = cmul(lb, H) + x; }
        *(f32x2*)((float*)(ws + WS_SSUM) + ((size_t)((b * 64 + c) * 16 + g) * 64 + lane) * 2) = H;
    }
    __syncthreads();
}

DI void m1_phase(CParams& P, int l, LAS unsigned char* lds, const int tid) {
    const int wave = tid >> 6, lane = tid & 63;
    for (int id = blockIdx.x; id < 1600; id += gridDim.x) {
        if (id < 256) ssma_item(P, l, id, lds, tid);
        else if (id < 544) lru_item(P, l, id - 256, lds, tid);
        else attn_item(P, l, id - 544, (LAS float*)lds, wave, lane);
    }
}
DI void m2_item(CParams& P, int l, int id, LAS unsigned char* lds, int tid) {
    unsigned char* ws = P.ws;
    const int wave = tid >> 6, lane = tid & 63, fr = lane & 15, fq = lane >> 4;
    const bool smp = id >= 256;
    const int b = smp ? id - 256 : id >> 6, c = smp ? 0 : id & 63;
    const int row0 = smp ? MP + b * 16 : b * 4096 + c * 64;
    const int T = smp ? 16 : 64, ntb = T >> 4;
    const bool lastc = smp || c == 63;
    bf16_t* Y = (bf16_t*)(ws + WS_Y);
    LAS float* U32 = (LAS float*)lds;
    LAS bf16_t* Z = (LAS bf16_t*)(lds + 65536);
    LAS bf16_t* HS = (LAS bf16_t*)(lds + 65536 + 33792) + wave * (16 * 136);
    LAS float* RED = (LAS float*)(lds + 65536 + 33792 + 34816);
    stage_u(Y, row0, T, U32, tid);
    {
        const float* HL = (const float*)(ws + WS_HL); const float* PC = (const float*)(ws + WS_PC);
        f32x4 Hin = (f32x4){0.f, 0.f, 0.f, 0.f};
        if (smp) Hin = *(const f32x4*)(P.in[7] + (size_t)(l * 32 + b) * 256 + lane * 4);
        else {
            const float* lsum = (const float*)(ws + WS_LSUM) + (size_t)(b * 64) * 2 * 256 + lane * 4;
            for (int j = 0; j < c; ++j) { const f32x4 A = *(const f32x4*)(lsum + (size_t)j * 512), S = *(const f32x4*)(lsum + (size_t)j * 512 + 256); Hin = A * Hin + S; }
        }
        for (int t = wave; t < T; t += 8) {
            const size_t row = row0 + t;
            const f32x4 hl = *(const f32x4*)(HL + row * 256 + lane * 4), pc = *(const f32x4*)(PC + row * 256 + lane * 4);
            const f32x4 h = hl + pc * Hin;
            bf16_t* yp = Y + row * 1024 + 768 + lane * 4;
            const u32x2 gw = *(const u32x2*)yp;
            f32x4 gl; gl[0] = __uint_as_float(gw.x << 16); gl[1] = __uint_as_float(gw.x & 0xffff0000u); gl[2] = __uint_as_float(gw.y << 16); gl[3] = __uint_as_float(gw.y & 0xffff0000u);
            f32x4 yl; float s = 0.f;
#pragma unroll
            for (int j = 0; j < 4; ++j) { yl[j] = gelu_tanh(gl[j]) * h[j]; s += yl[j] * yl[j]; }
#pragma unroll
            for (int o = 1; o < 64; o <<= 1) s += __shfl_xor(s, o);
            const float rs = rsqrtf(s * (1.f / 256.f) + EPS);
            u32x2 w; w.x = cvt_pk_bf16(yl[0] * rs, yl[1] * rs); w.y = cvt_pk_bf16(yl[2] * rs, yl[3] * rs);
            *(u32x2*)yp = w;
            if (lastc && t == T - 1) *(f32x4*)(P.out + (smp ? O_LRUS + (size_t)(l * 32 + b) * 256 : O_LRUP + (size_t)(l * 4 + b) * 256) + lane * 4) = h;
        }
    }
    __syncthreads();
#pragma unroll 1
    for (int gi = 0; gi < 2; ++gi) {
        const int g = wave * 2 + gi;
        const float* spar = (const float*)(ws + WS_SPAR + (size_t)l * SZ_SPAR);
        const f32x4 lb4 = *(const f32x4*)(spar + (size_t)(g * 64 + lane) * 4);
        const f32x2 lb = (f32x2){lb4[0], lb4[1]}, lb64 = (f32x2){lb4[2], lb4[3]};
        f32x2 bb[16];
        const float* bp = spar + 4096 + (size_t)(g * 64 + lane) * 32;
#pragma unroll
        for (int i = 0; i < 8; ++i) { const f32x4 v = *(const f32x4*)(bp + 4 * i); bb[2 * i] = (f32x2){v[0], v[1]}; bb[2 * i + 1] = (f32x2){v[2], v[3]}; }
        bf16x8 Cw[4];
        const bf16_t* ccp = (const bf16_t*)(ws + WS_CC) + ((size_t)((l * 16 + g) * 16 + fr)) * 128 + fq * 8;
#pragma unroll
        for (int ks = 0; ks < 4; ++ks) Cw[ks] = *(const bf16x8*)(ccp + ks * 32);
        const float dsk = P.in[21][l * 256 + g * 16 + fr];
        f32x2 H = (f32x2){0.f, 0.f};
        if (smp) { const size_t si = ((size_t)((l * 32 + b) * 16 + g)) * 64 + lane; H = (f32x2){P.in[4][si], P.in[5][si]}; }
        else {
            const float* sp = (const float*)(ws + WS_SSUM) + ((size_t)((b * 64) * 16 + g) * 64 + lane) * 2;
            for (int j = 0; j < c; ++j) { const f32x2 S = *(const f32x2*)(sp + (size_t)j * 16 * 64 * 2); H = cmul(lb64, H) + S; }
        }
        for (int tb = 0; tb < ntb; ++tb) {
#pragma unroll 4
            for (int tt = 0; tt < 16; ++tt) {
                const int t = tb * 16 + tt;
                const f32x2 x = ssm_x(bb, U32 + t * 256 + g * 16);
                H = cmul(lb, H) + x;
                const unsigned pk = cvt_pk_bf16(H.x, H.y);
                HS[tt * 136 + lane] = (bf16_t)(pk & 0xffffu); HS[tt * 136 + 64 + lane] = (bf16_t)(pk >> 16);
            }
            lds_fence();
            f32x4 acc = (f32x4){0.f, 0.f, 0.f, 0.f};
#pragma unroll
            for (int ks = 0; ks < 4; ++ks) { const bf16x8 A = *(const LAS bf16x8*)(HS + fr * 136 + ks * 32 + fq * 8); acc = mfma16(A, Cw[ks], acc); }
#pragma unroll
            for (int j = 0; j < 4; ++j) {
                const int t = tb * 16 + fq * 4 + j;
                const float yv = acc[j] + dsk * U32[t * 256 + g * 16 + fr];
                Z[t * 264 + g * 16 + fr] = f2bf(gelu_tanh(yv));
            }
            lds_fence();
        }
        if (lastc) {
            const size_t so = smp ? ((size_t)((l * 32 + b) * 16 + g)) * 64 + lane : ((size_t)((l * 4 + b) * 16 + g)) * 64 + lane;
            P.out[(smp ? O_SRES : O_SREP) + so] = H.x; P.out[(smp ? O_SIMS : O_SIMP) + so] = H.y;
        }
    }
    __syncthreads();
    {
        const bf16_t* WG = (const bf16_t*)(ws + WS_WGLU) + (size_t)l * 65536;
        bf16x8 Bw[2][8];
#pragma unroll
        for (int i = 0; i < 2; ++i)
#pragma unroll
            for (int ks = 0; ks < 8; ++ks) Bw[i][ks] = *(const bf16x8*)(WG + ((size_t)((2 * wave + i) * 16 + fr)) * 256 + ks * 32 + fq * 8);
        float o[4][2][4];
#pragma unroll
        for (int tt = 0; tt < 4; ++tt) {
            if (tt < ntb) {
                f32x4 a0 = (f32x4){0.f, 0.f, 0.f, 0.f}, a1 = a0;
#pragma unroll
                for (int ks = 0; ks < 8; ++ks) { const bf16x8 A = *(const LAS bf16x8*)(Z + (tt * 16 + fr) * 264 + ks * 32 + fq * 8); a0 = mfma16(A, Bw[0][ks], a0); a1 = mfma16(A, Bw[1][ks], a1); }
#pragma unroll
                for (int j = 0; j < 4; ++j) {
                    const int t = tt * 16 + fq * 4 + j;
                    const float z0 = bf2f(Z[t * 264 + (2 * wave) * 16 + fr]), z1 = bf2f(Z[t * 264 + (2 * wave + 1) * 16 + fr]);
                    const float o0 = z0 * sigmoidf_(a0[j]), o1 = z1 * sigmoidf_(a1[j]);
                    o[tt][0][j] = o0; o[tt][1][j] = o1;
                    float s = o0 * o0 + o1 * o1;
                    s += __shfl_xor(s, 1); s += __shfl_xor(s, 2); s += __shfl_xor(s, 4); s += __shfl_xor(s, 8);
                    if (fr == 0) RED[wave * 64 + t] = s;
                }
            }
        }
        __syncthreads();
#pragma unroll
        for (int tt = 0; tt < 4; ++tt) {
            if (tt < ntb) {
#pragma unroll
                for (int j = 0; j < 4; ++j) {
                    const int t = tt * 16 + fq * 4 + j;
                    float tot = 0.f;
#pragma unroll
                    for (int w = 0; w < 8; ++w) tot += RED[w * 64 + t];
                    const float rs = rsqrtf(tot * (1.f / 256.f) + EPS);
                    bf16_t* yp = Y + (size_t)(row0 + t) * 1024 + (2 * wave) * 16 + fr;
                    yp[0] = f2bf(o[tt][0][j] * rs); yp[16] = f2bf(o[tt][1][j] * rs);
                }
            }
        }
    }
    __syncthreads();
}
DI void m2_phase(CParams& P, int l, LAS unsigned char* lds, const int tid) {
    for (int id = blockIdx.x; id < 288; id += gridDim.x) m2_item(P, l, id, lds, tid);
}

DI void final_phase(CParams& P, const int tid) {
    const int lane = tid & 63, wave = tid >> 6;
    const float* ss = (const float*)(P.ws + WS_SS);
    const float* g = P.in[37];
    f32x4 gv[4];
#pragma unroll
    for (int i = 0; i < 4; ++i) gv[i] = *(const f32x4*)(g + i * 256 + lane * 4);
    for (int row = blockIdx.x * 8 + wave; row < MT; row += gridDim.x * 8) {
        const float rs = row_rstd(ss, row, 1.f / 1024.f);
        float* x = P.out + (size_t)row * 1024;
#pragma unroll
        for (int i = 0; i < 4; ++i) { f32x4 v = *(const f32x4*)(x + i * 256 + lane * 4); v = v * rs * gv[i]; *(f32x4*)(x + i * 256 + lane * 4) = v; }
    }
}

__global__ void __launch_bounds__(NTHR) hymba_fwd(Params Pa) {
    extern __shared__ __attribute__((aligned(16))) unsigned char lds_raw[];
    LAS unsigned char* lds = (LAS unsigned char*)lds_raw;
    cg::grid_group grid = cg::this_grid();
    const int ph_lo = Pa.ph_lo, ph_hi = Pa.ph_hi;
    for (int ph = ph_lo; ph < ph_hi; ++ph) {
        CParams* Pk = (CParams*)__builtin_amdgcn_kernarg_segment_ptr();
        asm volatile("" : "+s"(Pk));
        CParams& P = *Pk;
        int tid = threadIdx.x; asm volatile("" : "+v"(tid));
        unsigned char* ws = P.ws;
        bf16_t* XB = (bf16_t*)(ws + WS_XB); bf16_t* Y = (bf16_t*)(ws + WS_Y); bf16_t* ACT = (bf16_t*)(ws + WS_BIG);
        float* SS = (float*)(ws + WS_SS);
        if (ph == 0) prep_phase(P, lds, tid);
        else if (ph == 17) final_phase(P, tid);
        else {
            const int l = (ph - 1) >> 3, s = (ph - 1) & 7;
            if (s == 0 || s == 6) {
                const int f = s == 6;
                pg8::Gemm g{XB, (const bf16_t*)(ws + WS_WGU + (size_t)(l * 2 + f) * SZ_WGU), MT, 5632, 1024};
                pg8::StaticOrder S; S.init(MT, 5632, gridDim.x, blockIdx.x);
                EpiGateUp E{ACT, SS};
                pg8::gemm_phase<EpiGateUp, pg8::StaticOrder>(lds, g, S, E, nullptr, tid);
            } else if (s == 1 || s == 7) {
                const int f = s == 7;
                pg8::Gemm g{ACT, (const bf16_t*)(ws + WS_WD + (size_t)(l * 2 + f) * SZ_WD), MT, 1024, 2816};
                pg8::StaticOrder S; S.init(MT, 1024, gridDim.x, blockIdx.x);
                const bool first = (l == 0 && f == 0);
                EpiResid E{first ? P.in[0] : P.out, first ? P.in[1] : P.out + O_YS, P.out, XB, SS, 0.5f};
                pg8::gemm_phase<EpiResid, pg8::StaticOrder>(lds, g, S, E, nullptr, tid);
            } else if (s == 2) {
                pg8::Gemm g{XB, (const bf16_t*)(ws + WS_WIN + (size_t)l * SZ_WIN), MT, 1536, 1024};
                pg8::StaticOrder S; S.init(MT, 1536, gridDim.x, blockIdx.x);
                EpiProj E{SS, Y, (float*)(ws + WS_XL), (bf16_t*)(ws + WS_KBP), (bf16_t*)(ws + WS_VTP),
                          (bf16_t*)(ws + WS_KBS + (size_t)l * SZ_KBS), (bf16_t*)(ws + WS_VTS + (size_t)l * SZ_KBS),
                          P.out + O_KP + (size_t)l * 4 * 128 * 128, P.out + O_VP + (size_t)l * 4 * 128 * 128, P.out + O_KS + (size_t)l * 32 * 16 * 128, P.out + O_VS + (size_t)l * 32 * 16 * 128};
                pg8::gemm_phase<EpiProj, pg8::StaticOrder>(lds, g, S, E, nullptr, tid);
            } else if (s == 3) m1_phase(P, l, lds, tid);
            else if (s == 4) m2_phase(P, l, lds, tid);
            else {
                pg8::Gemm g{Y, (const bf16_t*)(ws + WS_WOUT + (size_t)l * SZ_WOUT), MT, 1024, 1024};
                pg8::StaticOrder S; S.init(MT, 1024, gridDim.x, blockIdx.x);
                EpiResid E{P.out, P.out + O_YS, P.out, XB, SS, 1.0f};
                pg8::gemm_phase<EpiResid, pg8::StaticOrder>(lds, g, S, E, nullptr, tid);
            }
        }
        if (ph + 1 < ph_hi) grid.sync();
    }
}

#ifndef N_PHASE_LAUNCH
#define N_PHASE_LAUNCH 0
#endif
extern "C" void kernel_launch(void* const* d_in, const int* in_sizes, int n_in, void* d_out, int out_size, void* d_ws, size_t ws_size, hipStream_t stream) {
    static int grid_blocks = 0;
    if (!grid_blocks) {
        int dev = 0, cus = 0, per_cu = 0;
        hipGetDevice(&dev);
        hipDeviceGetAttribute(&cus, hipDeviceAttributeMultiprocessorCount, dev);
        if (hipFuncSetAttribute((const void*)hymba_fwd, hipFuncAttributeMaxDynamicSharedMemorySize, LDS_BYTES) != hipSuccess) fprintf(stderr, "hipFuncSetAttribute failed\n");
        if (hipOccupancyMaxActiveBlocksPerMultiprocessor(&per_cu, (const void*)hymba_fwd, NTHR, LDS_BYTES) != hipSuccess || per_cu < 1) { fprintf(stderr, "occupancy query: %d\n", per_cu); per_cu = 1; }
        (void)hipGetLastError();
        if (per_cu > 1) per_cu = 1;
        grid_blocks = cus * per_cu;
        if (n_in != 38 || (size_t)out_size != O_END || ws_size < WS_END) fprintf(stderr, "kernel_launch: unexpected sizes n_in %d out %d ws %zu\n", n_in, out_size, ws_size);
    }
    Params p{};
    for (int i = 0; i < 38; ++i) p.in[i] = (const float*)d_in[i];
    p.out = (float*)d_out; p.ws = (unsigned char*)d_ws;
#if N_PHASE_LAUNCH
    for (int ph = 0; ph < 18; ++ph) { p.ph_lo = ph; p.ph_hi = ph + 1; hipLaunchKernelGGL(hymba_fwd, dim3(grid_blocks), dim3(NTHR), LDS_BYTES, stream, p); }
#else
    p.ph_lo = 0; p.ph_hi = 18;
    void* args[] = {&p};
    hipError_t e = hipLaunchCooperativeKernel((const void*)hymba_fwd, dim3(grid_blocks), dim3(NTHR), args, LDS_BYTES, stream);
    if (e != hipSuccess) fprintf(stderr, "cooperative launch failed: %s (grid %d)\n", hipGetErrorString(e), grid_blocks);
#endif
}
```

```cpp
#include <hip/hip_runtime.h>
#include <hip/hip_cooperative_groups.h>
#include <cstdio>
namespace cg = cooperative_groups;
namespace pg8 {
#define PG8_LAS __attribute__((address_space(3)))
typedef unsigned short bf16_t;
typedef short bf16x8 __attribute__((ext_vector_type(8)));
typedef float f32x4 __attribute__((ext_vector_type(4)));
typedef unsigned u32x4 __attribute__((ext_vector_type(4)));
constexpr int BM = 256, BK = 64, HALF = 128, HTB = HALF * BK * 2  , STAGE_BYTES = 8 * HTB, NXCD = 8, WGM = 8;

__host__ __device__ __forceinline__ int lds_byte(int r, int c) { const int st = (r >> 4) * 2 + (c >> 5), rr = r & 15, cc = c & 31, ob = rr * 64 + cc * 2; return st * 1024 + (ob ^ (((ob >> 9) & 1) << 5)); }
__host__ __device__ __forceinline__ void stage_rc(int b, int& R, int& C) { const int st = b / 1024, sb = b % 1024, swz = sb ^ (((sb >> 9) & 1) << 5); R = (st >> 1) * 16 + swz / 64; C = (st & 1) * 32 + (swz % 64) / 2; }
__host__ __device__ __forceinline__ int perm32(int rho) { const int n = rho >> 4, i = rho & 15; return 8 * (i >> 2) + 4 * n + (i & 3); }

struct Unit { int pm, pn; };
struct Gemm { const bf16_t* A; const bf16_t* Bt; int M, N, K; };

struct StaticOrder {
    int nM, nN, nwg, G, c;
    __host__ __device__ void init(int M, int N, int G_, int c_) { nM = M / BM; nN = N / BM; nwg = nM * nN; G = G_; c = c_; }
    __host__ __device__ bool next(int i, Unit& u) const {
        const long L = (long)i * G + c; if (L >= nwg) return false;
        int wgid = (int)L; { const int q = nwg / NXCD, r = nwg % NXCD, xcd = wgid % NXCD, off = wgid / NXCD; wgid = (xcd < r ? xcd * (q + 1) : r * (q + 1) + (xcd - r) * q) + off; }
        const int nig = WGM * nN, gid = wgid / nig, fm = gid * WGM, gsz = (nM - fm) < WGM ? (nM - fm) : WGM;
        u.pm = fm + ((wgid % nig) % gsz); u.pn = (wgid % nig) / gsz; return true;
    }
    __device__ __forceinline__ void a_ready(const Unit&) const {}
    __device__ __forceinline__ void done(const Unit&) const {}
};
__device__ __forceinline__ unsigned cvt_pk_bf16(float lo, float hi) { unsigned r; asm volatile("v_cvt_pk_bf16_f32 %0, %1, %2" : "=v"(r) : "v"(lo), "v"(hi)); return r; }
typedef float f32x2 __attribute__((ext_vector_type(2)));
template <class Epi, class Sched, bool ALIGN_EPI = false, bool SP2 = false>
__device__ __forceinline__ void gemm_phase(PG8_LAS unsigned char* lds, const Gemm g, const Sched& S, const Epi& E, const int tid) {
    const int wid = __builtin_amdgcn_readfirstlane(tid >> 6), lane = tid & 63, wr = wid >> 2, wc = wid & 3, fr = lane & 15, fq = lane >> 4;
    const int K = g.K, nt = K / BK;
    unsigned voffA[2], voffB[2];
#pragma unroll
    for (int i = 0; i < 2; ++i) { int R, C; stage_rc(tid * 16 + i * 8192, R, C); const int Rb = Epi::PERM ? ((R & ~31) + perm32(R & 31)) : R;
        voffA[i] = (unsigned)(R * K + C) * 2u; voffB[i] = (unsigned)(Rb * K + C) * 2u; }
    const size_t kstep = (size_t)(BK * 2);
    const size_t hstep = (size_t)HALF * K * 2;
    const size_t tstep = 2 * hstep;
    const unsigned ldsw = (unsigned)wid * 1024u;
    const int aoff = lds_byte(wr * 64 + fr, fq * 8), boff = lds_byte(wc * 32 + fr, fq * 8);
#define PG8_SA(b, h) (((b) * 2 + (h)) * HTB)
#define PG8_SB(b, h) ((4 + (b) * 2 + (h)) * HTB)
#define PG8_STAGE(bufoff, gbase, voff) do { _Pragma("unroll") for (int _i = 0; _i < 2; ++_i) \
        __builtin_amdgcn_global_load_lds((const unsigned*)((const char*)(gbase) + (voff)[_i]), (PG8_LAS unsigned*)(lds + (bufoff) + ldsw + _i * 8192), 16, 0, 0); } while (0)
#define PG8_LDA(dst, b, h) do { _Pragma("unroll") for (int m = 0; m < 4; ++m) _Pragma("unroll") for (int k = 0; k < 2; ++k) dst[m][k] = *(const PG8_LAS bf16x8*)(lds + PG8_SA(b, h) + aoff + m * 2048 + k * 1024); } while (0)
#define PG8_LDB(dst, b, h) do { _Pragma("unroll") for (int n = 0; n < 2; ++n) _Pragma("unroll") for (int k = 0; k < 2; ++k) dst[n][k] = *(const PG8_LAS bf16x8*)(lds + PG8_SB(b, h) + boff + n * 2048 + k * 1024); } while (0)
#define PG8_MMA(ai, bj, At, Bt) do { __builtin_amdgcn_s_setprio(1); _Pragma("unroll") for (int m = 0; m < 4; ++m) _Pragma("unroll") for (int n = 0; n < 2; ++n) _Pragma("unroll") for (int k = 0; k < 2; ++k) \
        acc[ai][bj][m][n] = __builtin_amdgcn_mfma_f32_16x16x32_bf16(Bt[n][k], At[m][k], acc[ai][bj][m][n], 0, 0, 0); __builtin_amdgcn_s_setprio(0); } while (0)
#define PG8_WAIT_V(n) asm volatile("s_waitcnt vmcnt(" #n ")" ::: "memory")
#define PG8_WAIT_L(n) asm volatile("s_waitcnt lgkmcnt(" #n ")" ::: "memory")
#define PG8_BAR __builtin_amdgcn_s_barrier()
#define PG8_SCHED __builtin_amdgcn_sched_barrier(0)
    Unit cur, nxt; int ui = 0;
    if (!S.next(0, cur)) return;
    f32x4 acc[2][2][4][2];
#pragma unroll
    for (int a = 0; a < 2; ++a)
#pragma unroll
        for (int b = 0; b < 2; ++b)
#pragma unroll
            for (int m = 0; m < 4; ++m)
#pragma unroll
                for (int n = 0; n < 2; ++n) acc[a][b][m][n] = (f32x4){0.f, 0.f, 0.f, 0.f};
    bf16x8 At[4][2], B0[2][2], B1[2][2];
    const char* cA = (const char*)g.A + (size_t)cur.pm * tstep; const char* cB = (const char*)g.Bt + (size_t)cur.pn * tstep;
    S.a_ready(cur);
    if constexpr (SP2) {
        PG8_STAGE(PG8_SB(0, 0), cB, voffB); PG8_STAGE(PG8_SB(0, 1), cB + hstep, voffB); PG8_STAGE(PG8_SA(0, 0), cA, voffA); PG8_STAGE(PG8_SA(0, 1), cA + hstep, voffA);
        if (wr == 1) PG8_BAR;
        PG8_WAIT_V(2); PG8_BAR;
        PG8_STAGE(PG8_SB(1, 0), cB + kstep, voffB); PG8_STAGE(PG8_SA(1, 0), cA + kstep, voffA); PG8_STAGE(PG8_SB(1, 1), cB + hstep + kstep, voffB);
        PG8_WAIT_V(6); PG8_BAR;
    } else {
        PG8_STAGE(PG8_SB(0, 0), cB, voffB); PG8_STAGE(PG8_SA(0, 0), cA, voffA); PG8_STAGE(PG8_SB(0, 1), cB + hstep, voffB); PG8_STAGE(PG8_SA(0, 1), cA + hstep, voffA);
        if (wr == 1) PG8_BAR;
        PG8_WAIT_V(4); PG8_BAR;
        PG8_STAGE(PG8_SB(1, 0), cB + kstep, voffB); PG8_STAGE(PG8_SA(1, 0), cA + kstep, voffA); PG8_STAGE(PG8_SB(1, 1), cB + hstep + kstep, voffB);
        PG8_WAIT_V(6); PG8_BAR;
    }
    for (;;) {
        const bool has_next = S.next(ui + 1, nxt);
        const char* nA = has_next ? (const char*)g.A + (size_t)nxt.pm * tstep : cA; const char* nB = has_next ? (const char*)g.Bt + (size_t)nxt.pn * tstep : cB;
        for (int t = 0; t < nt; t += 2) {
            const bool last = (t == nt - 2);
            const char* a1 = cA + (size_t)(t + 1) * kstep;
            const char* a2 = last ? nA : cA + (size_t)(t + 2) * kstep; const char* b2 = last ? nB : cB + (size_t)(t + 2) * kstep;
            const char* a3 = a2 + kstep; const char* b3 = b2 + kstep;
            if (last && has_next) S.a_ready(nxt);
            if constexpr (SP2) {
            PG8_LDB(B0, 0, 0); PG8_LDB(B1, 0, 1); PG8_SCHED; PG8_LDA(At, 0, 0); PG8_STAGE(PG8_SA(1, 1), a1 + hstep, voffA);
            PG8_WAIT_V(8); PG8_WAIT_L(0); PG8_BAR; PG8_MMA(0, 0, At, B0); PG8_MMA(0, 1, At, B1); PG8_BAR; PG8_SCHED;
            PG8_LDA(At, 0, 1); PG8_STAGE(PG8_SB(0, 0), b2, voffB); PG8_STAGE(PG8_SB(0, 1), b2 + hstep, voffB); PG8_STAGE(PG8_SA(0, 0), a2, voffA);
            PG8_WAIT_V(8); PG8_WAIT_L(0); PG8_BAR; PG8_MMA(1, 0, At, B0); PG8_MMA(1, 1, At, B1); PG8_BAR; PG8_SCHED;
            PG8_LDB(B0, 1, 0); PG8_LDB(B1, 1, 1); PG8_SCHED; PG8_LDA(At, 1, 0); PG8_STAGE(PG8_SA(0, 1), a2 + hstep, voffA);
            PG8_WAIT_V(8); PG8_WAIT_L(0); PG8_BAR; PG8_MMA(0, 0, At, B0); PG8_MMA(0, 1, At, B1); PG8_BAR; PG8_SCHED;
            PG8_LDA(At, 1, 1); PG8_STAGE(PG8_SB(1, 0), b3, voffB); PG8_STAGE(PG8_SB(1, 1), b3 + hstep, voffB); PG8_STAGE(PG8_SA(1, 0), a3, voffA);
            PG8_WAIT_V(8); PG8_WAIT_L(0); PG8_BAR; PG8_MMA(1, 0, At, B0); PG8_MMA(1, 1, At, B1); PG8_BAR; PG8_SCHED;
            } else {
            PG8_LDB(B0, 0, 0); PG8_SCHED; PG8_LDA(At, 0, 0); PG8_STAGE(PG8_SA(1, 1), a1 + hstep, voffA);
            PG8_WAIT_L(8); PG8_BAR; PG8_WAIT_L(0); PG8_MMA(0, 0, At, B0); PG8_BAR; PG8_SCHED;
            PG8_LDB(B1, 0, 1); PG8_STAGE(PG8_SB(0, 0), b2, voffB);
            PG8_BAR; PG8_WAIT_L(0); PG8_MMA(0, 1, At, B1); PG8_BAR;
            PG8_LDA(At, 0, 1); PG8_STAGE(PG8_SA(0, 0), a2, voffA);
            PG8_BAR; PG8_WAIT_L(0); PG8_MMA(1, 0, At, B0); PG8_BAR; PG8_SCHED;
            PG8_STAGE(PG8_SB(0, 1), b2 + hstep, voffB);
            PG8_WAIT_V(6); PG8_BAR; PG8_MMA(1, 1, At, B1); PG8_BAR;
            PG8_LDB(B0, 1, 0); PG8_SCHED; PG8_LDA(At, 1, 0); PG8_STAGE(PG8_SA(0, 1), a2 + hstep, voffA);
            PG8_WAIT_L(8); PG8_BAR; PG8_WAIT_L(0); PG8_MMA(0, 0, At, B0); PG8_BAR; PG8_SCHED;
            PG8_LDB(B1, 1, 1); PG8_STAGE(PG8_SB(1, 0), b3, voffB);
            PG8_BAR; PG8_WAIT_L(0); PG8_MMA(0, 1, At, B1); PG8_BAR;
            PG8_LDA(At, 1, 1); PG8_STAGE(PG8_SA(1, 0), a3, voffA);
            PG8_BAR; PG8_WAIT_L(0); PG8_MMA(1, 0, At, B0); PG8_BAR; PG8_SCHED;
            PG8_STAGE(PG8_SB(1, 1), b3 + hstep, voffB);
            PG8_WAIT_V(6); PG8_BAR; PG8_MMA(1, 1, At, B1); PG8_BAR;
            }
        }
        if constexpr (ALIGN_EPI) { if (wr == 0) PG8_BAR; }
        if constexpr (!Epi::AFTER_DRAIN) { E(acc, cur, wr, wc, fr, fq); S.done(cur); }
        if (!has_next) break;
#pragma unroll
        for (int a = 0; a < 2; ++a)
#pragma unroll
            for (int b = 0; b < 2; ++b)
#pragma unroll
                for (int m = 0; m < 4; ++m)
#pragma unroll
                    for (int n = 0; n < 2; ++n) acc[a][b][m][n] = (f32x4){0.f, 0.f, 0.f, 0.f};
        cur = nxt; cA = nA; cB = nB; ++ui;
        if constexpr (ALIGN_EPI) { if (wr == 1) PG8_BAR; }
    }
    PG8_WAIT_V(0);
    if constexpr (!ALIGN_EPI) { if (wr == 0) PG8_BAR; }
    PG8_BAR;
    if constexpr (Epi::AFTER_DRAIN) { E.fused(acc, cur, wr, wc, fr, fq, lds, wid, lane); S.done(cur); }
#undef PG8_SA
#undef PG8_SB
#undef PG8_STAGE
#undef PG8_LDA
#undef PG8_LDB
#undef PG8_MMA
#undef PG8_WAIT_V
#undef PG8_WAIT_L
#undef PG8_BAR
#undef PG8_SCHED
}
}
using pg8::bf16_t; using pg8::bf16x8; using pg8::f32x4; using pg8::u32x4; using pg8::f32x2; using pg8::cvt_pk_bf16;
#define LAS __attribute__((address_space(3)))
#define XB_TMO      128
#define XB_XCNT(j)  (256  + 64 * (j))
#define XB_XSUB(j)  (1280 + 64 * (j))
#define XB_XGEN(j)  (2304 + 64 * (j))
#define XB_TOP      3328
#define XB_TOPGEN   3392
#define XCD_BAR_WORDS 3456
#define XB_SPIN_CAP (1u << 18)

__device__ __forceinline__ unsigned xb_ld(unsigned* p)              { return __hip_atomic_load(p, __ATOMIC_RELAXED, __HIP_MEMORY_SCOPE_AGENT); }
__device__ __forceinline__ unsigned xb_add(unsigned* p, unsigned v) { return __hip_atomic_fetch_add(p, v, __ATOMIC_RELAXED, __HIP_MEMORY_SCOPE_AGENT); }
__device__ __forceinline__ unsigned xb_xcc_id() { return (unsigned)__builtin_amdgcn_s_getreg((3 << 11) | 20) & 0xFu; }
#define XB_SPIN(cond, bar) do { unsigned _sp = 0; while (cond) { __builtin_amdgcn_s_sleep(1); \
    if ((++_sp & 255u) == 0u) { if (xb_ld(&(bar)[XB_TMO])) break; if (_sp > XB_SPIN_CAP) { atomicAdd(&(bar)[XB_TMO], 1u); break; } } } } while (0)

struct XcdBarrier {
    unsigned* bar; unsigned x;
    volatile LAS unsigned* st;
};

__device__ __forceinline__ XcdBarrier xcd_barrier_post(unsigned* bar, volatile LAS unsigned* st) {
    XcdBarrier b; b.bar = bar; b.x = xb_xcc_id(); b.st = st;
    if (threadIdx.x == 0) (void)xb_add(&bar[XB_XCNT(b.x)], 1u);
    return b;
}
__device__ __forceinline__ void xcd_barrier_complete(unsigned* bar, unsigned x, unsigned& nloc, unsigned& nx) {
    const unsigned G = gridDim.x * gridDim.y * gridDim.z;
    unsigned sum, cnt, mine, sp = 0u;
    for (;;) {
        sum = 0u; cnt = 0u; mine = 0u;
#pragma unroll
        for (unsigned j = 0; j < 16; ++j) { const unsigned c = xb_ld(&bar[XB_XCNT(j)]); sum += c; cnt += (c > 0u) ? 1u : 0u; mine = (j == x) ? c : mine; }
        if (sum == G) break;
        __builtin_amdgcn_s_sleep(1);
        if ((++sp & 255u) == 0u) { if (xb_ld(&bar[XB_TMO])) break; if (sp > XB_SPIN_CAP) { atomicAdd(&bar[XB_TMO], 1u); break; } }
    }
    nloc = mine > 0u ? mine : 1u; nx = cnt > 0u ? cnt : 1u;
}

__device__ __forceinline__ void xcd_barrier(const XcdBarrier& b, const bool leader_thread) {
    asm volatile("s_waitcnt vmcnt(0)" ::: "memory");
    __syncthreads();
    if (leader_thread) {
        unsigned* bar = b.bar;
        __builtin_amdgcn_s_waitcnt(0);
        unsigned nloc = b.st[0], nx = b.st[1];
        if (nloc == 0u) { xcd_barrier_complete(bar, b.x, nloc, nx); b.st[0] = nloc; b.st[1] = nx; }
        const unsigned old = xb_add(&bar[XB_XSUB(b.x)], 1u);
        const unsigned gen = old / nloc;
        if (old + 1u == (gen + 1u) * nloc) {
            __builtin_amdgcn_fence(__ATOMIC_RELEASE, "agent");
            asm volatile("s_waitcnt vmcnt(0)" ::: "memory");
            const unsigned og = xb_add(&bar[XB_TOP], 1u);
            const unsigned tg = og / nx;
            if (og + 1u == (tg + 1u) * nx) xb_add(&bar[XB_TOPGEN], 1u);
            else XB_SPIN(xb_ld(&bar[XB_TOPGEN]) == tg, bar);
            __builtin_amdgcn_fence(__ATOMIC_ACQUIRE, "agent");
            xb_add(&bar[XB_XGEN(b.x)], 1u);
            asm volatile("s_waitcnt vmcnt(0)" ::: "memory");
        } else {
            XB_SPIN(xb_ld(&bar[XB_XGEN(b.x)]) == gen, bar);
            __builtin_amdgcn_fence(__ATOMIC_ACQUIRE, "agent");
            asm volatile("s_waitcnt vmcnt(0)" ::: "memory");
        }
    }
    __syncthreads();
}

typedef unsigned u32x2 __attribute__((ext_vector_type(2)));
typedef short s16x4 __attribute__((ext_vector_type(4)));
#define DI __device__ __forceinline__
#ifndef GEMM_SP2
#define GEMM_SP2 true
#endif
#ifndef GEMM_ALIGN
#define GEMM_ALIGN true
#endif
#ifndef DUP
#define DUP 0
#endif

constexpr int DM = 1024, MP = 16384, MS = 512, MT = 16896, DFF = 2816, NIN = 1536;
constexpr float EPS = 1e-6f;
constexpr int NTHR = 512;
constexpr int LDS_BYTES = 152 * 1024;

constexpr size_t SZ_WGU = (size_t)5632 * 1024 * 2, SZ_WD = (size_t)1024 * 2816 * 2, SZ_WIN = (size_t)1536 * 1024 * 2, SZ_WOUT = (size_t)1024 * 1024 * 2;
constexpr size_t WS_WGU = 0;
constexpr size_t WS_WD = WS_WGU + 4 * SZ_WGU;
constexpr size_t WS_WIN = WS_WD + 4 * SZ_WD;
constexpr size_t WS_WOUT = WS_WIN + 2 * SZ_WIN;
constexpr size_t SZ_XB = (size_t)MT * 1024 * 2;
constexpr size_t WS_XB = WS_WOUT + 2 * SZ_WOUT;
constexpr size_t WS_Y = WS_XB + SZ_XB;
constexpr size_t WS_BIG = WS_Y + SZ_XB;
constexpr size_t SZ_BIG = (size_t)MT * DFF * 2;
constexpr size_t SZ_F256 = (size_t)MT * 256 * 4;
constexpr size_t WS_XL = WS_BIG, WS_HL = WS_XL + SZ_F256, WS_PC = WS_HL + SZ_F256, WS_KBP = WS_PC + SZ_F256;
constexpr size_t SZ_KBP = (size_t)4 * 4096 * 128 * 2;
constexpr size_t WS_VTP = WS_KBP + SZ_KBP;
static_assert(WS_VTP + SZ_KBP <= WS_BIG + SZ_BIG, "mixer scratch must fit in the act buffer");
constexpr size_t WS_SS = WS_BIG + SZ_BIG;
constexpr size_t WS_KBS = WS_SS + (size_t)MT * 16 * 4;
constexpr size_t SZ_KBS = (size_t)32 * 160 * 128 * 2;
constexpr size_t WS_VTS = WS_KBS + 2 * SZ_KBS;
constexpr size_t WS_SSUM = WS_VTS + 2 * SZ_KBS;
constexpr size_t WS_LSUM = WS_SSUM + (size_t)4 * 64 * 16 * 64 * 8;
constexpr size_t WS_SPAR = WS_LSUM + (size_t)4 * 64 * 2 * 256 * 4;
constexpr size_t SZ_SPAR = 16384 + 131072;
constexpr size_t WS_CC = WS_SPAR + 2 * SZ_SPAR;
constexpr size_t WS_WGLU = WS_CC + 2 * 65536;
constexpr size_t WS_WAX = WS_WGLU + 2 * 131072;
constexpr size_t WS_BAR = WS_WAX + 2 * 65536;
constexpr size_t WS_BBF = WS_BAR + (size_t)XCD_BAR_WORDS * 4;
constexpr size_t WS_END = WS_BBF + (size_t)2 * 16 * 128 * 32 * 2;
static_assert(WS_END <= (size_t)256 * 1024 * 1024, "workspace budget");

constexpr size_t O_YP = 0, O_YS = (size_t)MP * 1024, O_KP = O_YS + (size_t)MS * 1024, O_VP = O_KP + 131072, O_SREP = O_VP + 131072, O_SIMP = O_SREP + 8192,
                 O_CONVP = O_SIMP + 8192, O_LRUP = O_CONVP + 6144, O_KS = O_LRUP + 2048, O_VS = O_KS + 131072, O_SRES = O_VS + 131072, O_SIMS = O_SRES + 65536,
                 O_CONVS = O_SIMS + 65536, O_LRUS = O_CONVS + 49152, O_END = O_LRUS + 16384;

struct Params { const float* in[38]; float* out; unsigned char* ws; int ph_lo, ph_hi; };
typedef const Params __attribute__((address_space(4))) CParams;

DI float bf2f(bf16_t v) { return __uint_as_float(((unsigned)v) << 16); }
DI bf16_t f2bf(float f) { return (bf16_t)(cvt_pk_bf16(f, 0.f) & 0xffffu); }
DI float sigmoidf_(float x) { return __builtin_amdgcn_rcpf(1.f + __expf(-x)); }
DI float gelu_tanh(float x) { const float v = 1.5957691216057308f * (x + 0.044715f * x * x * x); return x * __builtin_amdgcn_rcpf(1.f + __expf(-v)); }
DI f32x4 mfma16(bf16x8 a, bf16x8 b, f32x4 c) { return __builtin_amdgcn_mfma_f32_16x16x32_bf16(a, b, c, 0, 0, 0); }
DI f32x2 cmul(f32x2 a, f32x2 b) { return (f32x2){a.x * b.x - a.y * b.y, a.x * b.y + a.y * b.x}; }
DI float row_rstd(const float* ss, int row, float invn) {
    const f32x4* p = (const f32x4*)(ss + (size_t)row * 16); const f32x4 a = p[0], b = p[1], c = p[2], d = p[3];
    const f32x4 t = (a + b) + (c + d); return rsqrtf(((t[0] + t[1]) + (t[2] + t[3])) * invn + EPS);
}
DI void lds_fence() { asm volatile("s_waitcnt lgkmcnt(0)" ::: "memory"); }

DI void unit_rstd8(const float* ss, int row0, int fq, float (&rs)[8]) {
    f32x4 q[8];
#pragma unroll
    for (int i = 0; i < 8; ++i) q[i] = *(const f32x4*)(ss + (size_t)(row0 + (i >> 2) * 128 + (i & 3) * 16) * 16 + fq * 4);
#pragma unroll
    for (int i = 0; i < 8; ++i) { float t = (q[i][0] + q[i][1]) + (q[i][2] + q[i][3]); t += __shfl_xor(t, 16); t += __shfl_xor(t, 32); rs[i] = rsqrtf(t * (1.f / 1024.f) + EPS); }
}
struct EpiGateUp {
    static constexpr bool PERM = true, AFTER_DRAIN = false;
    bf16_t* act; const float* ss;
    DI void operator()(const f32x4 (&acc)[2][2][4][2], const pg8::Unit& u, int wr, int wc, int fr, int fq) const {
        const int row0 = u.pm * 256 + wr * 64 + fr, col = u.pn * 128 + wc * 32 + 8 * fq;
        float rs8[8]; unit_rstd8(ss, row0, fq, rs8);
#pragma unroll
        for (int ai = 0; ai < 2; ++ai)
#pragma unroll
            for (int m = 0; m < 4; ++m) {
                const int row = row0 + ai * 128 + m * 16;
                const float rs = rs8[ai * 4 + m];
                f32x2 o2[4];
#pragma unroll
                for (int n = 0; n < 2; ++n)
#pragma unroll
                    for (int hh = 0; hh < 2; ++hh) {
                        const f32x2 g = (f32x2){acc[ai][0][m][n][2 * hh], acc[ai][0][m][n][2 * hh + 1]} * rs, up = (f32x2){acc[ai][1][m][n][2 * hh], acc[ai][1][m][n][2 * hh + 1]} * rs;
                        const f32x2 t = g * (-1.44269504089f);
                        f32x2 e; e.x = __builtin_amdgcn_exp2f(t.x); e.y = __builtin_amdgcn_exp2f(t.y);
                        const f32x2 d = e + 1.0f;
                        f32x2 r; r.x = __builtin_amdgcn_rcpf(d.x); r.y = __builtin_amdgcn_rcpf(d.y);
                        o2[n * 2 + hh] = (g * r) * up;
                    }
                u32x4 w; w.x = cvt_pk_bf16(o2[0].x, o2[0].y); w.y = cvt_pk_bf16(o2[1].x, o2[1].y); w.z = cvt_pk_bf16(o2[2].x, o2[2].y); w.w = cvt_pk_bf16(o2[3].x, o2[3].y);
                *(u32x4*)(act + (size_t)row * DFF + col) = w;
            }
    }
};
struct EpiResid {
    static constexpr bool PERM = true, AFTER_DRAIN = false;
    const float* xin_p; bf16_t* xb; float* ssout; float scale; bool first;
    DI void operator()(const f32x4 (&acc)[2][2][4][2], const pg8::Unit& u, int wr, int wc, int fr, int fq) const {
        const int row0 = u.pm * 256 + wr * 64 + fr, colb = u.pn * 256 + wc * 32 + 8 * fq;
#pragma unroll
        for (int ai = 0; ai < 2; ++ai)
#pragma unroll
            for (int m = 0; m < 4; ++m) {
                const int row = row0 + ai * 128 + m * 16;
                bf16_t* xbo = xb + (size_t)row * 1024;
                float s = 0.f;
#pragma unroll
                for (int bj = 0; bj < 2; ++bj) {
                    const int col = colb + bj * 128;
                    f32x4 a0, a1;
                    if (first) { const float* xi = xin_p + (size_t)row * 1024 + col; a0 = *(const f32x4*)xi; a1 = *(const f32x4*)(xi + 4); }
                    else { const u32x4 o = *(const u32x4*)(xbo + col);
                        a0[0] = __uint_as_float(o.x << 16); a0[1] = __uint_as_float(o.x & 0xffff0000u); a0[2] = __uint_as_float(o.y << 16); a0[3] = __uint_as_float(o.y & 0xffff0000u);
                        a1[0] = __uint_as_float(o.z << 16); a1[1] = __uint_as_float(o.z & 0xffff0000u); a1[2] = __uint_as_float(o.w << 16); a1[3] = __uint_as_float(o.w & 0xffff0000u); }
                    const f32x4 v0 = a0 + acc[ai][bj][m][0] * scale, v1 = a1 + acc[ai][bj][m][1] * scale;
                    u32x4 w; w.x = cvt_pk_bf16(v0[0], v0[1]); w.y = cvt_pk_bf16(v0[2], v0[3]); w.z = cvt_pk_bf16(v1[0], v1[1]); w.w = cvt_pk_bf16(v1[2], v1[3]);
                    *(u32x4*)(xbo + col) = w;
                    s += (v0[0] * v0[0] + v0[1] * v0[1]) + (v0[2] * v0[2] + v0[3] * v0[3]) + (v1[0] * v1[0] + v1[1] * v1[1]) + (v1[2] * v1[2] + v1[3] * v1[3]);
                }
                s += __shfl_xor(s, 16); s += __shfl_xor(s, 32);
                if (fq == 0) ssout[(size_t)row * 16 + u.pn * 4 + wc] = s;
                if (m == 3) asm volatile("" ::: "memory");
            }
    }
};
struct EpiProj {
    static constexpr bool PERM = true, AFTER_DRAIN = false;
    const float* ss; bf16_t* y; float* xl; bf16_t* kbp; bf16_t* vtp; bf16_t* kbs; bf16_t* vts; float* okp; float* ovp; float* oks; float* ovs;
    DI void operator()(const f32x4 (&acc)[2][2][4][2], const pg8::Unit& u, int wr, int wc, int fr, int fq) const {
        const int row0 = u.pm * 256 + wr * 64 + fr, cl = wc * 32 + 8 * fq;
        const int pn = u.pn;
        float rs8[8]; unit_rstd8(ss, row0, fq, rs8);
#pragma unroll
        for (int ai = 0; ai < 2; ++ai)
#pragma unroll
            for (int m = 0; m < 4; ++m) {
                const int row = row0 + ai * 128 + m * 16;
                float rs = rs8[ai * 4 + m];
                if (pn == 4) {
#pragma unroll
                    for (int bj = 0; bj < 2; ++bj) { float* d = xl + (size_t)row * 256 + bj * 128 + cl; *(f32x4*)d = acc[ai][bj][m][0] * rs; *(f32x4*)(d + 4) = acc[ai][bj][m][1] * rs; }
                } else if (pn == 3) {
                    const int kvh = cl >> 6, d0 = cl & 63;
                    const bool prm = row < MP;
                    const int b = prm ? (row >> 12) : ((row - MP) >> 4), pos = prm ? (row & 4095) : ((row - MP) & 15);
                    const bool wout = prm ? (pos >= 3968) : true;
                    const unsigned oo = prm ? (unsigned)((b * 128 + (pos - 3968)) * 128 + cl) : (unsigned)((b * 16 + pos) * 128 + cl);
                    {
                        const f32x4 v0 = acc[ai][0][m][0] * rs, v1 = acc[ai][0][m][1] * rs;
                        if (wout) { float* of = (prm ? okp : oks) + oo; *(f32x4*)of = v0; *(f32x4*)(of + 4) = v1; }
                        u32x4 w; w.x = cvt_pk_bf16(v0[0], v0[1]); w.y = cvt_pk_bf16(v0[2], v0[3]); w.z = cvt_pk_bf16(v1[0], v1[1]); w.w = cvt_pk_bf16(v1[2], v1[3]);
                        bf16_t* kd = prm ? kbp + (unsigned)(row * 128 + cl) : kbs + (unsigned)((b * 160 + 128 + pos) * 128 + cl);
                        *(u32x4*)kd = w;
                    }
                    {
                        const f32x4 v0 = acc[ai][1][m][0] * rs, v1 = acc[ai][1][m][1] * rs;
                        if (wout) { float* of = (prm ? ovp : ovs) + oo; *(f32x4*)of = v0; *(f32x4*)(of + 4) = v1; }
                        const unsigned vstride = prm ? 4096u : 160u;
                        bf16_t* vd = prm ? vtp + (unsigned)(((b * 2 + kvh) * 64 + d0) * 4096 + pos) : vts + (unsigned)(((b * 2 + kvh) * 64 + d0) * 160 + 128 + pos);
#pragma unroll
                        for (int jj = 0; jj < 4; ++jj) { vd[jj * vstride] = f2bf(v0[jj]); vd[(jj + 4) * vstride] = f2bf(v1[jj]); }
                    }
                } else {
                    const int cbase = (pn == 0) ? 0 : (pn == 5 ? 768 : 256 + (pn - 1) * 256);
                    if (pn == 1 || pn == 2) rs *= 0.125f;
#pragma unroll
                    for (int bj = 0; bj < 2; ++bj) {
                        const f32x4 v0 = acc[ai][bj][m][0] * rs, v1 = acc[ai][bj][m][1] * rs;
                        u32x4 w; w.x = cvt_pk_bf16(v0[0], v0[1]); w.y = cvt_pk_bf16(v0[2], v0[3]); w.z = cvt_pk_bf16(v1[0], v1[1]); w.w = cvt_pk_bf16(v1[2], v1[3]);
                        *(u32x4*)(y + (size_t)row * 1024 + cbase + bj * 128 + cl) = w;
                    }
                }
            }
    }
};
struct TileJob { const float* src; const float* gain; bf16_t* dst; int K, N, map, k0, n0; };
DI TileJob decode_tile(CParams& P, int tile) {
    unsigned char* ws = P.ws; TileJob J;
    const int l = tile / 2432, r = tile % 2432;
    int j, tl; if (r < 2112) { j = r / 352; tl = r % 352; } else if (r < 2304) { j = 6; tl = r - 2112; } else { j = 7; tl = r - 2304; }
    J.map = 0;
    if (j == 0 || j == 1 || j == 3 || j == 4) {
        const int f = j >= 3; const int which = (j == 1 || j == 4);
        J.src = P.in[(f ? 34 : 9) + which] + (size_t)l * 1024 * 2816; J.gain = P.in[f ? 33 : 8] + l * 1024; J.dst = (bf16_t*)(ws + WS_WGU + (size_t)(l * 2 + f) * SZ_WGU); J.K = 1024; J.N = 2816; J.map = 1 + which;
    } else if (j == 2 || j == 5) {
        const int f = j == 5; J.src = P.in[f ? 36 : 11] + (size_t)l * 2816 * 1024; J.gain = nullptr; J.dst = (bf16_t*)(ws + WS_WD + (size_t)(l * 2 + f) * SZ_WD); J.K = 2816; J.N = 1024;
    } else if (j == 6) { J.src = P.in[13] + (size_t)l * 1024 * 1536; J.gain = P.in[12] + l * 1024; J.dst = (bf16_t*)(ws + WS_WIN + (size_t)l * SZ_WIN); J.K = 1024; J.N = 1536; }
    else { J.src = P.in[32] + (size_t)l * 1024 * 1024; J.gain = P.in[31] + l * 1024; J.dst = (bf16_t*)(ws + WS_WOUT + (size_t)l * SZ_WOUT); J.K = 1024; J.N = 1024; }
    const int nkt = J.K / 128, kt = tl % nkt, nt = tl / nkt; J.k0 = kt * 128; J.n0 = nt * 64;
    return J;
}
DI void convert_tiles(CParams& P, LAS unsigned char* lds, const int tid, const int first, const int stride, const int tbeg, const int tend) {
    LAS bf16_t* T = (LAS bf16_t*)lds;
    {
        LAS bf16_t* T2_ = T + 64 * 136;
        int tA = tbeg + first, tB = tbeg + first + stride; const int NT = tend;
        f32x4 vA[4], vB[4]; float gA = 1.f, gB = 1.f;
        const int lk = tid >> 2, lns = (tid & 3) * 16;
#define T1_LOAD(tile, v, g) do { const TileJob J = decode_tile(P, tile); const float* sp = J.src + (size_t)(J.k0 + lk) * J.N + J.n0 + lns; g = J.gain ? J.gain[J.k0 + lk] : 1.f; \
            _Pragma("unroll") for (int i = 0; i < 4; ++i) v[i] = *(const f32x4*)(sp + 4 * i); } while (0)
#define T1_TOLDS(Tb, v, g) do { _Pragma("unroll") for (int i = 0; i < 4; ++i) _Pragma("unroll") for (int e = 0; e < 4; ++e) Tb[(lns + 4 * i + e) * 136 + lk] = f2bf(v[i][e] * g); } while (0)
#define T1_STORE(Tb, tile) do { const TileJob J = decode_tile(P, tile); const int n = tid >> 3, ks = (tid & 7) * 16; \
            const int ng = J.n0 + n; const int drow = (J.map == 0) ? ng : (256 * (ng >> 7) + (ng & 127) + (J.map == 2 ? 128 : 0)); \
            const u32x4 a = *(const LAS u32x4*)(Tb + n * 136 + ks), b = *(const LAS u32x4*)(Tb + n * 136 + ks + 8); \
            bf16_t* d = J.dst + (size_t)drow * J.K + J.k0 + ks; *(u32x4*)d = a; *(u32x4*)(d + 8) = b; } while (0)
        if (tA < NT) T1_LOAD(tA, vA, gA);
        if (tB < NT) T1_LOAD(tB, vB, gB);
        while (tA < NT) {
            T1_TOLDS(T, vA, gA);
            if (tB < NT) T1_TOLDS(T2_, vB, gB);
            __syncthreads();
            const int nA = tA + 2 * stride, nB = tB + 2 * stride;
            if (nA < NT) T1_LOAD(nA, vA, gA);
            if (nB < NT) T1_LOAD(nB, vB, gB);
            T1_STORE(T, tA);
            if (tB < NT) T1_STORE(T2_, tB);
            __syncthreads();
            tA = nA; tB = nB;
        }
#undef T1_LOAD
#undef T1_TOLDS
#undef T1_STORE
    }
}
DI void prep_phase(CParams& P, LAS unsigned char* lds, const int tid, const int bid, const int nb) {
    const int lane = tid & 63, wave = tid >> 6;
    unsigned char* ws = P.ws;
    convert_tiles(P, lds, tid, bid, nb, 0, 704);
    {
        bf16_t* xb = (bf16_t*)(ws + WS_XB); float* ss0 = (float*)(ws + WS_SS);
        for (int row = bid * 8 + wave; row < MT; row += nb * 8) {
            const float* x = (row < MP) ? P.in[0] + (size_t)row * 1024 : P.in[1] + (size_t)(row - MP) * 1024;
            float s = 0.f;
#pragma unroll
            for (int i = 0; i < 4; ++i) {
                const f32x4 v = *(const f32x4*)(x + i * 256 + lane * 4);
                s += v[0] * v[0] + v[1] * v[1] + v[2] * v[2] + v[3] * v[3];
                u32x2 w; w.x = cvt_pk_bf16(v[0], v[1]); w.y = cvt_pk_bf16(v[2], v[3]);
                *(u32x2*)(xb + (size_t)row * 1024 + i * 256 + lane * 4) = w;
            }
#pragma unroll
            for (int o = 1; o < 64; o <<= 1) s += __shfl_xor(s, o);
            if (lane < 16) ss0[(size_t)row * 16 + lane] = (lane == 0) ? s : 0.f;
        }
    }
    const int gt = bid * NTHR + tid, gs = nb * NTHR;
    for (int e = gt; e < 2 * 32 * 128 * 128; e += gs) {
        const int c = e & 127, r = (e >> 7) & 127, sb = (e >> 14) & 31, l = e >> 19;
        bf16_t* kbs = (bf16_t*)(ws + WS_KBS + (size_t)l * SZ_KBS); bf16_t* vts = (bf16_t*)(ws + WS_VTS + (size_t)l * SZ_KBS);
        kbs[((size_t)(sb * 160 + r)) * 128 + c] = f2bf(P.in[2][e]);
        vts[((size_t)((sb * 2 + (c >> 6)) * 64 + (c & 63))) * 160 + r] = f2bf(P.in[3][e]);
    }
    for (int e = gt; e < 2 * 32 * 16 * 128; e += gs) {
        const int c = e & 127, r = (e >> 7) & 15, sb = (e >> 11) & 31, l = e >> 16;
        bf16_t* kbs = (bf16_t*)(ws + WS_KBS + (size_t)l * SZ_KBS); bf16_t* vts = (bf16_t*)(ws + WS_VTS + (size_t)l * SZ_KBS);
        kbs[((size_t)(sb * 160 + 144 + r)) * 128 + c] = 0;
        vts[((size_t)((sb * 2 + (c >> 6)) * 64 + (c & 63))) * 160 + 144 + r] = 0;
    }
    for (int e = gt; e < 2 * 16 * 64; e += gs) {
        const int p = e & 63, g = (e >> 6) & 15, l = e >> 10;
        const float dt = expf(P.in[16][l * 16 + g]);
        const float are = P.in[14][e], aim = P.in[15][e];
        const float mag = expf(are * dt);
        const float lbr = mag * cosf(aim * dt), lbi = mag * sinf(aim * dt);
        const float den = are * are + aim * aim, nr = lbr - 1.f;
        const float kr = (nr * are + lbi * aim) / den, ki = (lbi * are - nr * aim) / den;
        f32x2 pw = (f32x2){lbr, lbi};
#pragma unroll
        for (int i = 0; i < 6; ++i) pw = cmul(pw, pw);
        float* lb = (float*)(ws + WS_SPAR + (size_t)l * SZ_SPAR) + (size_t)(g * 64 + p) * 4;
        lb[0] = lbr; lb[1] = lbi; lb[2] = pw.x; lb[3] = pw.y;
        float* bb = (float*)(ws + WS_SPAR + (size_t)l * SZ_SPAR + 16384) + (size_t)(g * 64 + p) * 32;
        const float* bre = P.in[17] + (size_t)e * 16; const float* bim = P.in[18] + (size_t)e * 16;
        bf16_t* bfr = (bf16_t*)(ws + WS_BBF) + ((size_t)((l * 16 + g) * 128 + p)) * 32; bf16_t* bfi = bfr + 64 * 32;
#pragma unroll
        for (int h = 0; h < 16; ++h) { const float br = bre[h], bi = bim[h]; const float xr = kr * br - ki * bi, xi = kr * bi + ki * br; bb[2 * h] = xr; bb[2 * h + 1] = xi;
            bfr[h] = f2bf(xr); bfi[h] = f2bf(xi); bfr[16 + h] = 0; bfi[16 + h] = 0; }
    }
    for (int e = gt; e < 2 * 16 * 16 * 128; e += gs) {
        const int k = e & 127, h = (e >> 7) & 15, g = (e >> 11) & 15, l = e >> 15;
        const size_t si = ((size_t)((l * 16 + g) * 16 + h)) * 64 + (k & 63);
        ((bf16_t*)(ws + WS_CC))[e] = f2bf(k < 64 ? P.in[19][si] : -P.in[20][si]);
    }
    for (int e = gt; e < 2 * 256 * 256; e += gs) {
        const int k = e & 255, n = (e >> 8) & 255, l = e >> 16;
        ((bf16_t*)(ws + WS_WGLU))[e] = f2bf(P.in[22][((size_t)(l * 256 + k)) * 256 + n]);
    }
    for (int e = gt; e < 2 * 2 * 4 * 64 * 64; e += gs) {
        const int i = e & 63, o = (e >> 6) & 63, blk = (e >> 12) & 3, which = (e >> 14) & 1, l = e >> 15;
        ((bf16_t*)(ws + WS_WAX))[e] = f2bf(P.in[which ? 28 : 26][((size_t)((l * 4 + blk) * 64 + i)) * 64 + o]);
    }
}

DI f32x2 ssm_x(const f32x2 (&bb)[16], const LAS float* ut) {
    const f32x4 u0 = *(const LAS f32x4*)ut, u1 = *(const LAS f32x4*)(ut + 4), u2 = *(const LAS f32x4*)(ut + 8), u3 = *(const LAS f32x4*)(ut + 12);
    f32x2 xa = bb[0] * u0[0], xb = bb[1] * u0[1], xc = bb[2] * u0[2], xd = bb[3] * u0[3];
    xa += bb[4] * u1[0]; xb += bb[5] * u1[1]; xc += bb[6] * u1[2]; xd += bb[7] * u1[3];
    xa += bb[8] * u2[0]; xb += bb[9] * u2[1]; xc += bb[10] * u2[2]; xd += bb[11] * u2[3];
    xa += bb[12] * u3[0]; xb += bb[13] * u3[1]; xc += bb[14] * u3[2]; xd += bb[15] * u3[3];
    return (xa + xb) + (xc + xd);
}
DI void stage_u(const bf16_t* y, int row0, int T, LAS float* U32, int tid) {
    for (int idx = tid; idx < T * 32; idx += NTHR) {
        const int t = idx >> 5, seg = idx & 31;
        const u32x4 v = *(const u32x4*)(y + (size_t)(row0 + t) * 1024 + seg * 8);
        f32x4 a, b;
        a[0] = __uint_as_float(v.x << 16); a[1] = __uint_as_float(v.x & 0xffff0000u); a[2] = __uint_as_float(v.y << 16); a[3] = __uint_as_float(v.y & 0xffff0000u);
        b[0] = __uint_as_float(v.z << 16); b[1] = __uint_as_float(v.z & 0xffff0000u); b[2] = __uint_as_float(v.w << 16); b[3] = __uint_as_float(v.w & 0xffff0000u);
        *(LAS f32x4*)(U32 + t * 256 + seg * 8) = a; *(LAS f32x4*)(U32 + t * 256 + seg * 8 + 4) = b;
    }
}

DI void attn_chunk_item(CParams& P, int l, int ci, LAS unsigned char* lds, int tid, bf16_t* Yw) {
    unsigned char* ws = P.ws;
    const bf16_t* Y = (const bf16_t*)(ws + WS_Y);
    const int wave = tid >> 6, lane = tid & 63, fr = lane & 15, fq = lane >> 4;
    const bool smp = ci >= 256;
    const bf16_t* kb; const bf16_t* vt; int lpad, nkeys, nvt, row0, nsub;
    if (!smp) {
        const int b = ci >> 6, c = ci & 63, c0 = c >= 2 ? c - 2 : 0, klo = c0 * 64;
        nkeys = (c + 1) * 64 - klo; nvt = nkeys >> 4; row0 = b * 4096 + c * 64; nsub = 4;
        kb = (const bf16_t*)(ws + WS_KBP) + ((size_t)(b * 4096 + klo)) * 128; vt = (const bf16_t*)(ws + WS_VTP) + (size_t)(b * 2) * 64 * 4096 + klo; lpad = 4096;
    } else {
        const int sb = ci - 256; nkeys = 160; nvt = 9; row0 = MP + sb * 16; nsub = 1;
        kb = (const bf16_t*)(ws + WS_KBS + (size_t)l * SZ_KBS) + (size_t)sb * 160 * 128; vt = (const bf16_t*)(ws + WS_VTS + (size_t)l * SZ_KBS) + (size_t)sb * 2 * 64 * 160; lpad = 160;
    }
    const int npair = nkeys >> 5;
    LAS unsigned char* KL = lds;
    LAS unsigned char* VL = lds + 192 * 272;
    LAS float* ssq = (LAS float*)(lds + 192 * 272 + 128 * 400);
    {
        const int ppr = nkeys >> 3, nk = nkeys * 16, nv = 128 * ppr;
        u32x4 kq[6], vq[6];
#pragma unroll
        for (int i = 0; i < 6; ++i) { const int idx = tid + i * NTHR; const int ic = idx < nk ? idx : 0; kq[i] = *(const u32x4*)(kb + (size_t)(ic >> 4) * 128 + (ic & 15) * 8); }
#pragma unroll
        for (int i = 0; i < 6; ++i) { const int idx = tid + i * NTHR; const int ic = idx < nv ? idx : 0; const int r = ic / ppr, sg = ic - r * ppr; vq[i] = *(const u32x4*)(vt + (size_t)r * lpad + sg * 8); }
#pragma unroll
        for (int i = 0; i < 6; ++i) { const int idx = tid + i * NTHR; if (idx < nk) *(LAS u32x4*)(KL + (idx >> 4) * 272 + (idx & 15) * 16) = kq[i]; }
#pragma unroll
        for (int i = 0; i < 6; ++i) { const int idx = tid + i * NTHR; if (idx < nv) { const int r = idx / ppr, sg = idx - r * ppr; *(LAS u32x4*)(VL + r * 400 + sg * 16) = vq[i]; } }
    }
    const int h = wave, kvh = h >> 2;
    bf16x8 qf[4][2];
#pragma unroll
    for (int sb_ = 0; sb_ < 4; ++sb_) {
        const int su = sb_ < nsub ? sb_ : 0;
        const bf16_t* yq = Y + (size_t)(row0 + su * 16 + fr) * 1024 + 256 + h * 64;
        qf[sb_][0] = *(const bf16x8*)(yq + fq * 8); qf[sb_][1] = *(const bf16x8*)(yq + 32 + fq * 8);
    }
    const float sink = P.in[23][l * 8 + h];
    __syncthreads();
    f32x4 O[4][4];
#pragma unroll
    for (int su = 0; su < 4; ++su) {
        if (su < nsub) {
            f32x4 s[12];
#pragma unroll
            for (int kt = 0; kt < 12; ++kt) {
                if (kt < nvt) {
                    const LAS unsigned char* kp = KL + (kt * 16 + fr) * 272 + kvh * 128 + fq * 16;
                    const bf16x8 k0 = *(const LAS bf16x8*)kp, k1 = *(const LAS bf16x8*)(kp + 64);
                    f32x4 a = (f32x4){0.f, 0.f, 0.f, 0.f};
                    a = mfma16(k0, qf[su][0], a); a = mfma16(k1, qf[su][1], a);
                    s[kt] = a;
                } else s[kt] = (f32x4){-1e30f, -1e30f, -1e30f, -1e30f};
            }
            float mx = sink;
#pragma unroll
            for (int kt = 0; kt < 12; ++kt)
#pragma unroll
                for (int jj = 0; jj < 4; ++jj) mx = fmaxf(mx, s[kt][jj]);
            mx = fmaxf(mx, __shfl_xor(mx, 16)); mx = fmaxf(mx, __shfl_xor(mx, 32));
            float sum = 0.f;
#pragma unroll
            for (int kt = 0; kt < 12; ++kt)
#pragma unroll
                for (int jj = 0; jj < 4; ++jj) { const float p = __expf(s[kt][jj] - mx); s[kt][jj] = p; sum += p; }
            sum += __shfl_xor(sum, 16); sum += __shfl_xor(sum, 32);
            const float inv = 1.f / (sum + __expf(sink - mx));
#pragma unroll
            for (int dt = 0; dt < 4; ++dt) O[su][dt] = (f32x4){0.f, 0.f, 0.f, 0.f};
#pragma unroll
            for (int i = 0; i < 6; ++i) {
                if (i < npair) {
                    u32x4 pw; pw.x = cvt_pk_bf16(s[2 * i][0], s[2 * i][1]); pw.y = cvt_pk_bf16(s[2 * i][2], s[2 * i][3]); pw.z = cvt_pk_bf16(s[2 * i + 1][0], s[2 * i + 1][1]); pw.w = cvt_pk_bf16(s[2 * i + 1][2], s[2 * i + 1][3]);
                    const bf16x8 pb = __builtin_bit_cast(bf16x8, pw);
#pragma unroll
                    for (int dt = 0; dt < 4; ++dt) {
                        const LAS unsigned char* vp = VL + (kvh * 64 + dt * 16 + fr) * 400 + i * 64 + fq * 8;
                        const s16x4 lo = *(const LAS s16x4*)vp, hi = *(const LAS s16x4*)(vp + 32);
                        const bf16x8 vf = __builtin_shufflevector(lo, hi, 0, 1, 2, 3, 4, 5, 6, 7);
                        O[su][dt] = mfma16(vf, pb, O[su][dt]);
                    }
                }
            }
            float sl = 0.f;
#pragma unroll
            for (int dt = 0; dt < 4; ++dt) { O[su][dt] = O[su][dt] * inv; sl += O[su][dt][0] * O[su][dt][0] + O[su][dt][1] * O[su][dt][1] + O[su][dt][2] * O[su][dt][2] + O[su][dt][3] * O[su][dt][3]; }
            sl += __shfl_xor(sl, 16); sl += __shfl_xor(sl, 32);
            if (fq == 0) ssq[(su * 8 + h) * 16 + fr] = sl;
        }
    }
    __syncthreads();
#pragma unroll
    for (int su = 0; su < 4; ++su) {
        if (su < nsub) {
            float tot = 0.f;
#pragma unroll
            for (int hh = 0; hh < 8; ++hh) tot += ssq[(su * 8 + hh) * 16 + fr];
            const float rs = rsqrtf(tot * (1.f / 512.f) + EPS);
            bf16_t* yo = Yw + (size_t)(row0 + su * 16 + fr) * 1024 + 256 + h * 64;
#pragma unroll
            for (int dt = 0; dt < 4; ++dt) {
                u32x2 w; w.x = cvt_pk_bf16(O[su][dt][0] * rs, O[su][dt][1] * rs); w.y = cvt_pk_bf16(O[su][dt][2] * rs, O[su][dt][3] * rs);
                *(u32x2*)(yo + dt * 16 + fq * 4) = w;
            }
        }
    }
    __syncthreads();
}

DI void lru_item(CParams& P, int l, int li, LAS unsigned char* lds, int tid) {
    unsigned char* ws = P.ws;
    const int wave = tid >> 6, lane = tid & 63, fr = lane & 15, fq = lane >> 4;
    const bool smp = li >= 256;
    const int b = smp ? li - 256 : li >> 6, c = smp ? 0 : li & 63;
    const int row0 = smp ? MP + b * 16 : b * 4096 + c * 64;
    const int T = smp ? 16 : 64, TH = smp ? 16 : 32, nh = smp ? 1 : 2;
    const float* XL = (const float*)(ws + WS_XL); float* HL = (float*)(ws + WS_HL); float* PC = (float*)(ws + WS_PC);
    LAS float* XC32 = (LAS float*)lds; LAS float* A32 = (LAS float*)(lds + 32768); LAS bf16_t* XCB = (LAS bf16_t*)(lds + 65536);
    const int ch = tid & 255, part = tid >> 8;
    const float cw0 = P.in[24][(l * 4 + 0) * 256 + ch], cw1 = P.in[24][(l * 4 + 1) * 256 + ch], cw2 = P.in[24][(l * 4 + 2) * 256 + ch], cw3 = P.in[24][(l * 4 + 3) * 256 + ch], cb = P.in[25][l * 256 + ch];
    const int blk = wave >> 1, ob = (wave & 1) * 32;
    const bf16_t* WAX = (const bf16_t*)(ws + WS_WAX) + (size_t)l * 2 * 4 * 64 * 64;
    bf16x8 Bw[2][2][2];
#pragma unroll
    for (int gq = 0; gq < 2; ++gq)
#pragma unroll
        for (int ot = 0; ot < 2; ++ot)
#pragma unroll
            for (int ks = 0; ks < 2; ++ks) Bw[gq][ot][ks] = *(const bf16x8*)(WAX + ((size_t)((gq * 4 + blk) * 64 + ob + ot * 16 + fr)) * 64 + ks * 32 + fq * 8);
    float ba[2], bx[2], ls[2];
#pragma unroll
    for (int ot = 0; ot < 2; ++ot) { const int cc = blk * 64 + ob + ot * 16 + fr; ba[ot] = P.in[27][l * 256 + cc]; bx[ot] = P.in[29][l * 256 + cc]; ls[ot] = -log1pf(expf(-P.in[30][l * 256 + cc])); }
    float hl = 0.f, pc = 1.f;
    for (int hf = 0; hf < nh; ++hf) {
        {
            const int tper = TH >> 1, tb = part * tper;
            const int pos0 = (smp ? 0 : c * 64) + hf * 32 + tb;
            const size_t rb = smp ? (size_t)MP + b * 16 : (size_t)b * 4096;
            float xw[19];
#pragma unroll
            for (int i = 0; i < 19; ++i) {
                const int pp = pos0 + i - 3;
                xw[i] = 0.f;
                if (i < tper + 3) {
                    if (pp >= 0) xw[i] = XL[(rb + pp) * 256 + ch];
                    else if (smp) xw[i] = P.in[6][((size_t)((l * 32 + b) * 3 + (pp + 3))) * 256 + ch];
                }
            }
#pragma unroll
            for (int tt = 0; tt < 16; ++tt) {
                if (tt < tper) {
                    const int t = tb + tt;
                    const float a = cb + cw0 * xw[tt] + cw1 * xw[tt + 1] + cw2 * xw[tt + 2] + cw3 * xw[tt + 3];
                    XC32[t * 256 + ch] = a; XCB[t * 264 + ch] = f2bf(a);
                }
            }
        }
        __syncthreads();
#pragma unroll
        for (int tt = 0; tt < 2; ++tt) {
            if (tt * 16 < TH) {
                bf16x8 A[2];
#pragma unroll
                for (int ks = 0; ks < 2; ++ks) A[ks] = *(const LAS bf16x8*)(XCB + (tt * 16 + fr) * 264 + blk * 64 + ks * 32 + fq * 8);
#pragma unroll
                for (int ot = 0; ot < 2; ++ot) {
                    f32x4 ga = (f32x4){0.f, 0.f, 0.f, 0.f}, gx = ga;
#pragma unroll
                    for (int ks = 0; ks < 2; ++ks) { ga = mfma16(A[ks], Bw[0][ot][ks], ga); gx = mfma16(A[ks], Bw[1][ot][ks], gx); }
                    const int cc = blk * 64 + ob + ot * 16 + fr;
#pragma unroll
                    for (int j = 0; j < 4; ++j) {
                        const int t = tt * 16 + fq * 4 + j;
                        const float r = sigmoidf_(ga[j] + ba[ot]), ig = sigmoidf_(gx[j] + bx[ot]);
                        const float la = 8.f * r * ls[ot];
                        const float av = __expf(la), mult = sqrtf(-expm1f(2.f * la));
                        const float xc = XC32[t * 256 + cc];
                        XC32[t * 256 + cc] = mult * ig * xc; A32[t * 256 + cc] = av;
                    }
                }
            }
        }
        __syncthreads();
        if (tid < 256) {
            for (int t = 0; t < TH; ++t) {
                const float av = A32[t * 256 + ch], bt = XC32[t * 256 + ch];
                hl = av * hl + bt; pc = av * pc;
                const size_t r = (size_t)(row0 + hf * 32 + t) * 256 + ch;
                HL[r] = hl; PC[r] = pc;
            }
        }
        __syncthreads();
    }
    if (tid < 256) {
        if (!smp) { float* ls_ = (float*)(ws + WS_LSUM) + ((size_t)(b * 64 + c) * 2) * 256; ls_[ch] = pc; ls_[256 + ch] = hl; }
        if (smp) { for (int i = 0; i < 3; ++i) P.out[O_CONVS + ((size_t)((l * 32 + b) * 3 + i)) * 256 + ch] = XL[((size_t)(MP + b * 16 + 13 + i)) * 256 + ch]; }
        else if (c == 63) { for (int i = 0; i < 3; ++i) P.out[O_CONVP + ((size_t)((l * 4 + b) * 3 + i)) * 256 + ch] = XL[((size_t)(b * 4096 + 4093 + i)) * 256 + ch]; }
    }
    (void)T;
}

DI void ssma_item(CParams& P, int l, int si, LAS unsigned char* lds, int tid) {
    unsigned char* ws = P.ws;
    const int wave = tid >> 6, lane = tid & 63, fr = lane & 15, fq = lane >> 4;
    const int b = si >> 6, c = si & 63, row0 = b * 4096 + c * 64;
    const bf16_t* Y = (const bf16_t*)(ws + WS_Y);
    LAS float* XW = (LAS float*)lds + wave * (32 * 132);
#pragma unroll 1
    for (int gi = 0; gi < 2; ++gi) {
        const int g = wave * 2 + gi;
        const f32x4 lb4 = *(const f32x4*)((const float*)(ws + WS_SPAR + (size_t)l * SZ_SPAR) + (size_t)(g * 64 + lane) * 4);
        const f32x2 lb = (f32x2){lb4[0], lb4[1]};
        bf16x8 Bf[8];
        const bf16_t* bbf = (const bf16_t*)(ws + WS_BBF) + ((size_t)((l * 16 + g) * 128 + fr)) * 32 + fq * 8;
#pragma unroll
        for (int nt = 0; nt < 8; ++nt) Bf[nt] = *(const bf16x8*)(bbf + (size_t)nt * 16 * 32);
        bf16x8 Af[4];
#pragma unroll
        for (int mt = 0; mt < 4; ++mt) { Af[mt] = (bf16x8){0, 0, 0, 0, 0, 0, 0, 0}; if (fq < 2) Af[mt] = *(const bf16x8*)(Y + (size_t)(row0 + mt * 16 + fr) * 1024 + g * 16 + fq * 8); }
        f32x2 H = (f32x2){0.f, 0.f};
#pragma unroll
        for (int hf = 0; hf < 2; ++hf) {
#pragma unroll
            for (int m2 = 0; m2 < 2; ++m2)
#pragma unroll
                for (int nt = 0; nt < 8; ++nt) {
                    const f32x4 a = mfma16(Af[hf * 2 + m2], Bf[nt], (f32x4){0.f, 0.f, 0.f, 0.f});
#pragma unroll
                    for (int jj = 0; jj < 4; ++jj) XW[(m2 * 16 + fq * 4 + jj) * 132 + nt * 16 + fr] = a[jj];
                }
            lds_fence();
#pragma unroll 8
            for (int t = 0; t < 32; ++t) { const f32x2 x = (f32x2){XW[t * 132 + lane], XW[t * 132 + 64 + lane]}; H = cmul(lb, H) + x; }
            lds_fence();
        }
        *(f32x2*)((float*)(ws + WS_SSUM) + ((size_t)((b * 64 + c) * 16 + g) * 64 + lane) * 2) = H;
    }
    __syncthreads();
}

DI void m1_phase(CParams& P, int l, LAS unsigned char* lds, const int tid, bf16_t* Yw, const int bid, const int nb, const int id_lo = 0, const int id_hi = 832) {
    const int wave = tid >> 6, lane = tid & 63;
    for (int id = id_lo + bid; id < id_hi; id += nb) {
        int t2 = tid; asm volatile("" : "+v"(t2));
        if (id < 256) ssma_item(P, l, id, lds, t2);
        else if (id < 544) lru_item(P, l, id - 256, lds, t2);
        else attn_chunk_item(P, l, id - 544, lds, t2, Yw);
    }
}
DI void lru_fix(const float* HL, const float* PC, const bf16_t* Y, bf16_t* Yw, const size_t rowbase, const int T, const f32x4 Hin, const int wave, const int lane, float* out_last) {
    for (int t0 = wave; t0 < T; t0 += 32) {
        f32x4 hl[4], pc[4]; u32x2 gw[4];
#pragma unroll
        for (int q = 0; q < 4; ++q) {
            const int t = (t0 + 8 * q < T) ? t0 + 8 * q : t0; const size_t row = rowbase + t;
            hl[q] = *(const f32x4*)(HL + row * 256 + lane * 4); pc[q] = *(const f32x4*)(PC + row * 256 + lane * 4);
            gw[q] = *(const u32x2*)(Y + row * 1024 + 768 + lane * 4);
        }
#pragma unroll
        for (int q = 0; q < 4; ++q) {
            const int t = t0 + 8 * q;
            if (t < T) {
                const size_t row = rowbase + t;
                const f32x4 h = hl[q] + pc[q] * Hin;
                f32x4 gl; gl[0] = __uint_as_float(gw[q].x << 16); gl[1] = __uint_as_float(gw[q].x & 0xffff0000u); gl[2] = __uint_as_float(gw[q].y << 16); gl[3] = __uint_as_float(gw[q].y & 0xffff0000u);
                f32x4 yl; float s = 0.f;
#pragma unroll
                for (int jj = 0; jj < 4; ++jj) { yl[jj] = gelu_tanh(gl[jj]) * h[jj]; s += yl[jj] * yl[jj]; }
#pragma unroll
                for (int o = 1; o < 64; o <<= 1) s += __shfl_xor(s, o);
                const float rs = rsqrtf(s * (1.f / 256.f) + EPS);
                u32x2 w; w.x = cvt_pk_bf16(yl[0] * rs, yl[1] * rs); w.y = cvt_pk_bf16(yl[2] * rs, yl[3] * rs);
                *(u32x2*)(Yw + row * 1024 + 768 + lane * 4) = w;
                if (out_last && t == T - 1) *(f32x4*)(out_last + lane * 4) = h;
            }
        }
    }
}
DI void m2_item(CParams& P, int l, int pid, int sid, LAS unsigned char* lds, int tid, bf16_t* Yw) {
    unsigned char* ws = P.ws;
    const int wave = tid >> 6, lane = tid & 63, fr = lane & 15, fq = lane >> 4;
    const bool hasp = pid >= 0, hass = sid >= 0;
    const int b = hasp ? pid >> 6 : 0, c = hasp ? pid & 63 : 0;
    const int row0 = b * 4096 + c * 64, rs0 = MP + (hass ? sid : 0) * 16;
    const int ntb = hasp ? 4 : 0;
    const bool lastc = hasp && c == 63;
    bf16_t* Y = (bf16_t*)(ws + WS_Y);
    LAS float* XW = (LAS float*)lds + wave * (16 * 132);
    LAS bf16_t* Z = (LAS bf16_t*)(lds + 67584);
    LAS bf16_t* HS = (LAS bf16_t*)(lds + 67584 + 42240) + wave * (16 * 136);
    LAS float* RED = (LAS float*)(lds + 67584 + 42240 + 34816);
#define M2_VALID(tb) (((tb) < ntb) || ((tb) == 4 && hass))
#define M2_ROW(tb) (((tb) < 4) ? row0 + (tb) * 16 : rs0)
    f32x2 Hc0, Hc1, Hs0 = (f32x2){0.f, 0.f}, Hs1 = Hs0; f32x4 lbq0, lbq1;
#pragma unroll
    for (int gi = 0; gi < 2; ++gi) {
        const int g = wave * 2 + gi;
        const f32x4 lb4 = *(const f32x4*)((const float*)(ws + WS_SPAR + (size_t)l * SZ_SPAR) + (unsigned)(g * 64 + lane) * 4u);
        if (gi) lbq1 = lb4; else lbq0 = lb4;
        const f32x2 lb64 = (f32x2){lb4[2], lb4[3]};
        f32x2 H = (f32x2){0.f, 0.f};
        if (hass) { const size_t si = ((size_t)((l * 32 + sid) * 16 + g)) * 64 + lane; const f32x2 hs = (f32x2){P.in[4][si], P.in[5][si]}; if (gi) Hs1 = hs; else Hs0 = hs; }
        if (hasp) {
            const float* sp = (const float*)(ws + WS_SSUM) + ((size_t)((b * 64) * 16 + g) * 64 + lane) * 2;
            for (int j0 = 0; j0 < c; j0 += 8) {
                f32x2 S[8];
#pragma unroll
                for (int k = 0; k < 8; ++k) { const int jj = (j0 + k < c) ? j0 + k : c - 1; S[k] = *(const f32x2*)(sp + (unsigned)jj * 2048u); }
#pragma unroll
                for (int k = 0; k < 8; ++k) if (j0 + k < c) H = cmul(lb64, H) + S[k];
            }
        }
        if (gi) Hc1 = H; else Hc0 = H;
    }
    {
        const float* HL = (const float*)(ws + WS_HL); const float* PC = (const float*)(ws + WS_PC);
        if (hasp) {
            f32x4 Hin = (f32x4){0.f, 0.f, 0.f, 0.f};
            const float* lsum = (const float*)(ws + WS_LSUM) + (size_t)(b * 64) * 2 * 256 + lane * 4;
            for (int j0 = 0; j0 < c; j0 += 4) {
                f32x4 A[4], S[4];
#pragma unroll
                for (int k = 0; k < 4; ++k) { const int jj = (j0 + k < c) ? j0 + k : c - 1; A[k] = *(const f32x4*)(lsum + (unsigned)jj * 512u); S[k] = *(const f32x4*)(lsum + (unsigned)jj * 512u + 256); }
#pragma unroll
                for (int k = 0; k < 4; ++k) if (j0 + k < c) Hin = A[k] * Hin + S[k];
            }
            lru_fix(HL, PC, Y, Yw, (size_t)row0, 64, Hin, wave, lane, lastc ? P.out + O_LRUP + (size_t)(l * 4 + b) * 256 : nullptr);
        }
        if (hass) {
            const f32x4 Hin = *(const f32x4*)(P.in[7] + (size_t)(l * 32 + sid) * 256 + lane * 4);
            lru_fix(HL, PC, Y, Yw, (size_t)rs0, 16, Hin, wave, lane, P.out + O_LRUS + (size_t)(l * 32 + sid) * 256);
        }
    }
    __syncthreads();
#pragma unroll 1
    for (int gi = 0; gi < 2; ++gi) {
        const int g = wave * 2 + gi;
        const f32x4 lb4 = gi ? lbq1 : lbq0;
        const f32x2 lb = (f32x2){lb4[0], lb4[1]};
        bf16x8 Bf[8];
        const bf16_t* bbf = (const bf16_t*)(ws + WS_BBF) + ((size_t)((l * 16 + g) * 128 + fr)) * 32 + fq * 8;
#pragma unroll
        for (int nt = 0; nt < 8; ++nt) Bf[nt] = *(const bf16x8*)(bbf + (size_t)nt * 16 * 32);
        bf16x8 Af[5];
#pragma unroll
        for (int mt = 0; mt < 5; ++mt) { Af[mt] = (bf16x8){0, 0, 0, 0, 0, 0, 0, 0}; if (fq < 2 && M2_VALID(mt)) Af[mt] = *(const bf16x8*)(Y + (size_t)(M2_ROW(mt) + fr) * 1024 + g * 16 + fq * 8); }
        float usk[5][4];
#pragma unroll
        for (int mt = 0; mt < 5; ++mt)
#pragma unroll
            for (int jj = 0; jj < 4; ++jj) usk[mt][jj] = M2_VALID(mt) ? bf2f(Y[(size_t)(M2_ROW(mt) + fq * 4 + jj) * 1024 + g * 16 + fr]) : 0.f;
        bf16x8 Cw[4];
        const bf16_t* ccp = (const bf16_t*)(ws + WS_CC) + ((size_t)((l * 16 + g) * 16 + fr)) * 128 + fq * 8;
#pragma unroll
        for (int ks = 0; ks < 4; ++ks) Cw[ks] = *(const bf16x8*)(ccp + ks * 32);
        const float dsk = P.in[21][l * 256 + g * 16 + fr];
        f32x2 H = gi ? Hc1 : Hc0;
#pragma unroll
        for (int tb = 0; tb < 5; ++tb) {
            if (tb == 4) {
                if (lastc) { const size_t so = ((size_t)((l * 4 + b) * 16 + g)) * 64 + lane; P.out[O_SREP + so] = H.x; P.out[O_SIMP + so] = H.y; }
                H = gi ? Hs1 : Hs0;
            }
            if (M2_VALID(tb)) {
#pragma unroll
                for (int nt = 0; nt < 8; ++nt) {
                    const f32x4 a = mfma16(Af[tb], Bf[nt], (f32x4){0.f, 0.f, 0.f, 0.f});
#pragma unroll
                    for (int jj = 0; jj < 4; ++jj) XW[(fq * 4 + jj) * 132 + nt * 16 + fr] = a[jj];
                }
                lds_fence();
#pragma unroll
                for (int tt = 0; tt < 16; ++tt) {
                    const f32x2 x = (f32x2){XW[tt * 132 + lane], XW[tt * 132 + 64 + lane]};
                    H = cmul(lb, H) + x;
                    const unsigned pk = cvt_pk_bf16(H.x, H.y);
                    HS[tt * 136 + lane] = (bf16_t)(pk & 0xffffu); HS[tt * 136 + 64 + lane] = (bf16_t)(pk >> 16);
                }
                lds_fence();
                f32x4 acc = (f32x4){0.f, 0.f, 0.f, 0.f};
#pragma unroll
                for (int ks = 0; ks < 4; ++ks) { const bf16x8 A = *(const LAS bf16x8*)(HS + fr * 136 + ks * 32 + fq * 8); acc = mfma16(A, Cw[ks], acc); }
#pragma unroll
                for (int jj = 0; jj < 4; ++jj) {
                    const int t = tb * 16 + fq * 4 + jj;
                    const float yv = acc[jj] + dsk * usk[tb][jj];
                    Z[t * 264 + g * 16 + fr] = f2bf(gelu_tanh(yv));
                }
                lds_fence();
            }
        }
        if (hass) { const size_t so = ((size_t)((l * 32 + sid) * 16 + g)) * 64 + lane; P.out[O_SRES + so] = H.x; P.out[O_SIMS + so] = H.y; }
    }
    __syncthreads();
    {
        const bf16_t* WG = (const bf16_t*)(ws + WS_WGLU) + (size_t)l * 65536;
        bf16x8 Bw[2][8];
#pragma unroll
        for (int i = 0; i < 2; ++i)
#pragma unroll
            for (int ks = 0; ks < 8; ++ks) Bw[i][ks] = *(const bf16x8*)(WG + ((size_t)((2 * wave + i) * 16 + fr)) * 256 + ks * 32 + fq * 8);
        float o[5][2][4];
#pragma unroll
        for (int tt = 0; tt < 5; ++tt) {
            if (M2_VALID(tt)) {
                f32x4 a0 = (f32x4){0.f, 0.f, 0.f, 0.f}, a1 = a0;
#pragma unroll
                for (int ks = 0; ks < 8; ++ks) { const bf16x8 A = *(const LAS bf16x8*)(Z + (tt * 16 + fr) * 264 + ks * 32 + fq * 8); a0 = mfma16(A, Bw[0][ks], a0); a1 = mfma16(A, Bw[1][ks], a1); }
#pragma unroll
                for (int j = 0; j < 4; ++j) {
                    const int t = tt * 16 + fq * 4 + j;
                    const float z0 = bf2f(Z[t * 264 + (2 * wave) * 16 + fr]), z1 = bf2f(Z[t * 264 + (2 * wave + 1) * 16 + fr]);
                    const float o0 = z0 * sigmoidf_(a0[j]), o1 = z1 * sigmoidf_(a1[j]);
                    o[tt][0][j] = o0; o[tt][1][j] = o1;
                    float s = o0 * o0 + o1 * o1;
                    s += __shfl_xor(s, 1); s += __shfl_xor(s, 2); s += __shfl_xor(s, 4); s += __shfl_xor(s, 8);
                    if (fr == 0) RED[wave * 80 + t] = s;
                }
            }
        }
        __syncthreads();
#pragma unroll
        for (int tt = 0; tt < 5; ++tt) {
            if (M2_VALID(tt)) {
#pragma unroll
                for (int j = 0; j < 4; ++j) {
                    const int t = tt * 16 + fq * 4 + j;
                    float tot = 0.f;
#pragma unroll
                    for (int w = 0; w < 8; ++w) tot += RED[w * 80 + t];
                    const float rs = rsqrtf(tot * (1.f / 256.f) + EPS);
                    bf16_t* yp = Yw + (size_t)(M2_ROW(tt) + fq * 4 + j) * 1024 + (2 * wave) * 16 + fr;
                    yp[0] = f2bf(o[tt][0][j] * rs); yp[16] = f2bf(o[tt][1][j] * rs);
                }
            }
        }
    }
    __syncthreads();
#undef M2_VALID
#undef M2_ROW
}
DI void m2_phase(CParams& P, int l, LAS unsigned char* lds, const int tid, bf16_t* Yw, const int bid, const int nb) {
    const int nit = (nb == 256) ? 256 : 288;
    for (int it = bid; it < nit; it += nb) {
        int t2 = tid; asm volatile("" : "+v"(t2));
        const int pid = it < 256 ? it : -1;
        const int sid = it >= 256 ? it - 256 : ((nb == 256 && (it & 63) < 8) ? (it >> 6) * 8 + (it & 7) : -1);
        m2_item(P, l, pid, sid, lds, t2, Yw);
    }
}

DI void final_phase(CParams& P, const int tid, const int bid, const int nb) {
    const int lane = tid & 63, wave = tid >> 6;
    const float* ss = (const float*)(P.ws + WS_SS);
    const float* g = P.in[37];
    f32x4 gv[4];
#pragma unroll
    for (int i = 0; i < 4; ++i) gv[i] = *(const f32x4*)(g + i * 256 + lane * 4);
    const bf16_t* xb = (const bf16_t*)(P.ws + WS_XB);
    for (int row = bid * 8 + wave; row < MT; row += nb * 8) {
        const float rs = row_rstd(ss, row, 1.f / 1024.f);
        float* x = P.out + (size_t)row * 1024;
        u32x2 w[4];
#pragma unroll
        for (int i = 0; i < 4; ++i) w[i] = *(const u32x2*)(xb + (size_t)row * 1024 + i * 256 + lane * 4);
#pragma unroll
        for (int i = 0; i < 4; ++i) { f32x4 v; v[0] = __uint_as_float(w[i].x << 16); v[1] = __uint_as_float(w[i].x & 0xffff0000u); v[2] = __uint_as_float(w[i].y << 16); v[3] = __uint_as_float(w[i].y & 0xffff0000u);
            v = v * rs * gv[i]; *(f32x4*)(x + i * 256 + lane * 4) = v; }
    }
}


template <int K>
DI void sgemm_resid(const bf16_t* A  , const bf16_t* Bt  , const float* xin  , bf16_t* xb, float* ss  , float scale, bool first,
                    LAS unsigned char* lds, const int tid, const int bid, const int nb) {
    const int wave = tid >> 6, lane = tid & 63, fr = lane & 15, fq = lane >> 4;
    constexpr int KW = K / 8, NS = KW / 32;
    LAS float* PART = (LAS float*)lds;
    for (int it = bid; it < 256; it += nb) {
        const int r0 = (it >> 4) * 32, c0 = (it & 15) * 64, k0 = wave * KW;
        f32x4 acc[2][4];
#pragma unroll
        for (int i = 0; i < 2; ++i)
#pragma unroll
            for (int j = 0; j < 4; ++j) acc[i][j] = (f32x4){0.f, 0.f, 0.f, 0.f};
        const bf16_t* ap = A + (size_t)(r0 + fr) * K + k0 + fq * 8;
        const bf16_t* bp = Bt + (size_t)(c0 + fr) * K + k0 + fq * 8;
#pragma unroll
        for (int kb = 0; kb < NS; kb += 4) {
            bf16x8 a[4][2], b[4][4];
#pragma unroll
            for (int s4 = 0; s4 < 4; ++s4) {
                if (kb + s4 < NS) {
#pragma unroll
                    for (int i = 0; i < 2; ++i) a[s4][i] = *(const bf16x8*)(ap + (size_t)i * 16 * K + (kb + s4) * 32);
#pragma unroll
                    for (int j = 0; j < 4; ++j) b[s4][j] = *(const bf16x8*)(bp + (size_t)j * 16 * K + (kb + s4) * 32);
                }
            }
            __builtin_amdgcn_sched_barrier(0);
#pragma unroll
            for (int s4 = 0; s4 < 4; ++s4) {
                if (kb + s4 < NS) {
#pragma unroll
                    for (int i = 0; i < 2; ++i)
#pragma unroll
                        for (int j = 0; j < 4; ++j) acc[i][j] = mfma16(b[s4][j], a[s4][i], acc[i][j]);
                }
            }
            __builtin_amdgcn_sched_barrier(0);
        }
#pragma unroll
        for (int i = 0; i < 2; ++i)
#pragma unroll
            for (int j = 0; j < 4; ++j) *(LAS f32x4*)(PART + wave * 2048 + (i * 16 + fr) * 64 + j * 16 + fq * 4) = acc[i][j];
        __syncthreads();
        {
            const int row = tid >> 4, c4 = (tid & 15) * 4;
            f32x4 sum = *(const LAS f32x4*)(PART + row * 64 + c4);
#pragma unroll
            for (int w = 1; w < 8; ++w) sum += *(const LAS f32x4*)(PART + w * 2048 + row * 64 + c4);
            const size_t off = (size_t)(r0 + row) * 1024 + c0 + c4;
            f32x4 xo;
            if (first) xo = *(const f32x4*)(xin + off);
            else { const u32x2 o = *(const u32x2*)(xb + off); xo[0] = __uint_as_float(o.x << 16); xo[1] = __uint_as_float(o.x & 0xffff0000u); xo[2] = __uint_as_float(o.y << 16); xo[3] = __uint_as_float(o.y & 0xffff0000u); }
            const f32x4 v = xo + sum * scale;
            u32x2 pk; pk.x = cvt_pk_bf16(v[0], v[1]); pk.y = cvt_pk_bf16(v[2], v[3]);
            *(u32x2*)(xb + off) = pk;
            float sq = (v[0] * v[0] + v[1] * v[1]) + (v[2] * v[2] + v[3] * v[3]);
            sq += __shfl_xor(sq, 1); sq += __shfl_xor(sq, 2); sq += __shfl_xor(sq, 4); sq += __shfl_xor(sq, 8);
            if ((tid & 15) == 0) ss[(size_t)(r0 + row) * 16 + (it & 15)] = sq;
        }
        __syncthreads();
    }
}

__global__ void __launch_bounds__(NTHR) hymba_fwd(Params Pa) {
    extern __shared__ __attribute__((aligned(16))) unsigned char lds_raw[];
    LAS unsigned char* lds = (LAS unsigned char*)lds_raw;
    cg::grid_group grid = cg::this_grid();
    volatile LAS unsigned* xb_st = (volatile LAS unsigned*)((LAS unsigned char*)lds_raw + LDS_BYTES - 16);
    const int wv = __builtin_amdgcn_readfirstlane((int)(threadIdx.x >> 6));
    if (threadIdx.x == 0) { xb_st[0] = 0u; xb_st[1] = 0u; }
    __syncthreads();
    const XcdBarrier xbar = xcd_barrier_post((unsigned*)(Pa.ws + WS_BAR), xb_st);
    const int ph_lo = Pa.ph_lo, ph_hi = Pa.ph_hi;
    for (int ph = ph_lo; ph < ph_hi; ++ph) {
        CParams* Pk = (CParams*)__builtin_amdgcn_kernarg_segment_ptr();
        asm volatile("" : "+s"(Pk));
        CParams& P = *Pk;
        int wvl_ = wv; asm volatile("" : "+s"(wvl_));
        int tid = wvl_ * 64 + (int)__builtin_amdgcn_mbcnt_hi(~0u, __builtin_amdgcn_mbcnt_lo(~0u, 0u)); asm volatile("" : "+v"(tid));
        int bid = blockIdx.x, nb = gridDim.x; asm volatile("" : "+s"(bid), "+s"(nb));
        unsigned char* ws = P.ws;
        bf16_t* XB = (bf16_t*)(ws + WS_XB); bf16_t* Y = (bf16_t*)(ws + WS_Y); bf16_t* ACT = (bf16_t*)(ws + WS_BIG);
        float* SS = (float*)(ws + WS_SS);
        if (ph == 0) { prep_phase(P, lds, tid, bid, nb); if (DUP & 1) { grid.sync(); prep_phase(P, lds, tid, bid, nb); } }
        else if (ph == 17) final_phase(P, tid, bid, nb);
        else {
            const int l = (ph - 1) >> 3, s = (ph - 1) & 7;
            if (s == 0 || s == 6) {
                const int f = s == 6;
                pg8::Gemm g{XB, (const bf16_t*)(ws + WS_WGU + (size_t)(l * 2 + f) * SZ_WGU), MT, 5632, 1024};
                pg8::StaticOrder S; S.init(MT, 5632, nb, bid);
                EpiGateUp E{ACT, SS};
                pg8::gemm_phase<EpiGateUp, pg8::StaticOrder, GEMM_ALIGN, GEMM_SP2>(lds, g, S, E, tid);
                if (l == 0) {
                    const int rounds = (1452 + nb - 1) / nb, b0 = 1452 - (rounds - 1) * nb;
                    const int t0 = f ? 2432 + 1216 : 704, t1 = f ? 4864 : 2432;
                    if (b0 < nb) { if (bid >= b0) convert_tiles(P, lds, tid, bid - b0, nb - b0, t0, t1); }
                    else convert_tiles(P, lds, tid, bid, nb, t0, t1);
                }
            } else if (s == 1 || s == 7) {
                const int f = s == 7;
                const bf16_t* Wd = (const bf16_t*)(ws + WS_WD + (size_t)(l * 2 + f) * SZ_WD);
                pg8::Gemm g{ACT, Wd, MP, 1024, 2816};
                pg8::StaticOrder S; S.init(MP, 1024, nb, bid);
                const bool first = (l == 0 && f == 0);
                EpiResid E{P.in[0], XB, SS, 0.5f, first};
                pg8::gemm_phase<EpiResid, pg8::StaticOrder, GEMM_ALIGN, GEMM_SP2>(lds, g, S, E, tid);
                sgemm_resid<2816>(ACT + (size_t)MP * DFF, Wd, P.in[1], XB + (size_t)MP * 1024, SS + (size_t)MP * 16, 0.5f, first, lds, tid, bid, nb);
            } else if (s == 2) {
                pg8::Gemm g{XB, (const bf16_t*)(ws + WS_WIN + (size_t)l * SZ_WIN), MT, 1536, 1024};
                pg8::StaticOrder S; S.init(MT, 1536, nb, bid);
                EpiProj E{SS, Y, (float*)(ws + WS_XL), (bf16_t*)(ws + WS_KBP), (bf16_t*)(ws + WS_VTP),
                          (bf16_t*)(ws + WS_KBS + (size_t)l * SZ_KBS), (bf16_t*)(ws + WS_VTS + (size_t)l * SZ_KBS),
                          P.out + O_KP + (size_t)l * 4 * 128 * 128, P.out + O_VP + (size_t)l * 4 * 128 * 128, P.out + O_KS + (size_t)l * 32 * 16 * 128, P.out + O_VS + (size_t)l * 32 * 16 * 128};
                pg8::gemm_phase<EpiProj, pg8::StaticOrder, GEMM_ALIGN, GEMM_SP2>(lds, g, S, E, tid);
                if (l == 0) {
                    const int rounds = (396 + nb - 1) / nb, b0 = 396 - (rounds - 1) * nb;
                    if (b0 < nb) { if (bid >= b0) convert_tiles(P, lds, tid, bid - b0, nb - b0, 2432, 2432 + 1216); }
                    else convert_tiles(P, lds, tid, bid, nb, 2432, 2432 + 1216);
                }
            } else if (s == 3) { if (DUP & (2 | 32 | 64 | 128)) { m1_phase(P, l, lds, tid, XB, bid, nb, (DUP & 2) ? 0 : (DUP & 32) ? 0 : (DUP & 64) ? 256 : 544, (DUP & 2) ? 832 : (DUP & 32) ? 256 : (DUP & 64) ? 544 : 832); grid.sync(); } m1_phase(P, l, lds, tid, Y, bid, nb); }
            else if (s == 4) { if (DUP & 4) { m2_phase(P, l, lds, tid, XB, bid, nb); grid.sync(); } m2_phase(P, l, lds, tid, Y, bid, nb); }
            else {
                const bf16_t* Wo = (const bf16_t*)(ws + WS_WOUT + (size_t)l * SZ_WOUT);
                pg8::Gemm g{Y, Wo, MP, 1024, 1024};
                pg8::StaticOrder S; S.init(MP, 1024, nb, bid);
                EpiResid E{P.in[0], XB, SS, 1.0f, false};
                pg8::gemm_phase<EpiResid, pg8::StaticOrder, GEMM_ALIGN, GEMM_SP2>(lds, g, S, E, tid);
                sgemm_resid<1024>(Y + (size_t)MP * 1024, Wo, P.in[1], XB + (size_t)MP * 1024, SS + (size_t)MP * 16, 1.0f, false, lds, tid, bid, nb);
            }
        }
        if (ph + 1 < ph_hi) { if (ph_hi == 0x7fff) grid.sync(); else xcd_barrier(xbar, tid == 0); }
    }
}

#ifndef DUP
#define DUP 0
#endif
#ifndef N_PHASE_LAUNCH
#define N_PHASE_LAUNCH 0
#endif
extern "C" void kernel_launch(void* const* d_in, const int* in_sizes, int n_in, void* d_out, int out_size, void* d_ws, size_t ws_size, hipStream_t stream) {
    static int grid_blocks = 0;
    if (!grid_blocks) {
        int dev = 0, cus = 0, per_cu = 0;
        hipGetDevice(&dev);
        hipDeviceGetAttribute(&cus, hipDeviceAttributeMultiprocessorCount, dev);
        if (hipFuncSetAttribute((const void*)hymba_fwd, hipFuncAttributeMaxDynamicSharedMemorySize, LDS_BYTES) != hipSuccess) fprintf(stderr, "hipFuncSetAttribute failed\n");
        if (hipOccupancyMaxActiveBlocksPerMultiprocessor(&per_cu, (const void*)hymba_fwd, NTHR, LDS_BYTES) != hipSuccess || per_cu < 1) { fprintf(stderr, "occupancy query: %d\n", per_cu); per_cu = 1; }
        (void)hipGetLastError();
        if (per_cu > 1) per_cu = 1;
        grid_blocks = cus * per_cu;
        if (n_in != 38 || (size_t)out_size != O_END || ws_size < WS_END) fprintf(stderr, "kernel_launch: unexpected sizes n_in %d out %d ws %zu\n", n_in, out_size, ws_size);
    }
    if (hipMemsetAsync((unsigned char*)d_ws + WS_BAR, 0, (size_t)XCD_BAR_WORDS * 4, stream) != hipSuccess) fprintf(stderr, "memset of barrier words failed\n");
    Params p{};
    for (int i = 0; i < 38; ++i) p.in[i] = (const float*)d_in[i];
    p.out = (float*)d_out; p.ws = (unsigned char*)d_ws;
#if N_PHASE_LAUNCH
    for (int ph = 0; ph < 18; ++ph) { p.ph_lo = ph; p.ph_hi = ph + 1; hipLaunchKernelGGL(hymba_fwd, dim3(grid_blocks), dim3(NTHR), LDS_BYTES, stream, p); }
#else
    p.ph_lo = 0; p.ph_hi = 18;
    void* args[] = {&p};
    hipError_t e = hipLaunchCooperativeKernel((const void*)hymba_fwd, dim3(grid_blocks), dim3(NTHR), args, LDS_BYTES, stream);
    if (e != hipSuccess) fprintf(stderr, "cooperative launch failed: %s (grid %d)\n", hipGetErrorString(e), grid_blocks);
#endif
}
```

```cpp
#include <hip/hip_runtime.h>
#include <hip/hip_cooperative_groups.h>
#include <cstdio>
namespace cg = cooperative_groups;
namespace pg8 {
#define PG8_LAS __attribute__((address_space(3)))
typedef unsigned short bf16_t;
typedef short bf16x8 __attribute__((ext_vector_type(8)));
typedef float f32x4 __attribute__((ext_vector_type(4)));
typedef unsigned u32x4 __attribute__((ext_vector_type(4)));
constexpr int BM = 256, BK = 64, HALF = 128, HTB = HALF * BK * 2  , STAGE_BYTES = 8 * HTB, NXCD = 8, WGM = 8;

__host__ __device__ __forceinline__ int lds_byte(int r, int c) { const int st = (r >> 4) * 2 + (c >> 5), rr = r & 15, cc = c & 31, ob = rr * 64 + cc * 2; return st * 1024 + (ob ^ (((ob >> 9) & 1) << 5)); }
__host__ __device__ __forceinline__ void stage_rc(int b, int& R, int& C) { const int st = b / 1024, sb = b % 1024, swz = sb ^ (((sb >> 9) & 1) << 5); R = (st >> 1) * 16 + swz / 64; C = (st & 1) * 32 + (swz % 64) / 2; }
__host__ __device__ __forceinline__ int perm32(int rho) { const int n = rho >> 4, i = rho & 15; return 8 * (i >> 2) + 4 * n + (i & 3); }

struct Unit { int pm, pn; };
struct Gemm { const bf16_t* A; const bf16_t* Bt; int M, N, K; };

struct StaticOrder {
    int nM, nN, nwg, G, c;
    __host__ __device__ void init(int M, int N, int G_, int c_) { nM = M / BM; nN = N / BM; nwg = nM * nN; G = G_; c = c_; }
    __host__ __device__ bool next(int i, Unit& u) const {
        const long L = (long)i * G + c; if (L >= nwg) return false;
        int wgid = (int)L; { const int q = nwg / NXCD, r = nwg % NXCD, xcd = wgid % NXCD, off = wgid / NXCD; wgid = (xcd < r ? xcd * (q + 1) : r * (q + 1) + (xcd - r) * q) + off; }
        const int nig = WGM * nN, gid = wgid / nig, fm = gid * WGM, gsz = (nM - fm) < WGM ? (nM - fm) : WGM;
        u.pm = fm + ((wgid % nig) % gsz); u.pn = (wgid % nig) / gsz; return true;
    }
    __device__ __forceinline__ void a_ready(const Unit&) const {}
    __device__ __forceinline__ void done(const Unit&) const {}
};
__device__ __forceinline__ unsigned cvt_pk_bf16(float lo, float hi) { unsigned r; asm volatile("v_cvt_pk_bf16_f32 %0, %1, %2" : "=v"(r) : "v"(lo), "v"(hi)); return r; }
typedef float f32x2 __attribute__((ext_vector_type(2)));
template <class Epi, class Sched, bool ALIGN_EPI = false, bool SP2 = false>
__device__ __forceinline__ void gemm_phase(PG8_LAS unsigned char* lds, const Gemm g, const Sched& S, const Epi& E, const int tid) {
    const int wid = __builtin_amdgcn_readfirstlane(tid >> 6), lane = tid & 63, wr = wid >> 2, wc = wid & 3, fr = lane & 15, fq = lane >> 4;
    const int K = g.K, nt = K / BK;
    unsigned voffA[2], voffB[2];
#pragma unroll
    for (int i = 0; i < 2; ++i) { int R, C; stage_rc(tid * 16 + i * 8192, R, C); const int Rb = Epi::PERM ? ((R & ~31) + perm32(R & 31)) : R;
        voffA[i] = (unsigned)(R * K + C) * 2u; voffB[i] = (unsigned)(Rb * K + C) * 2u; }
    const size_t kstep = (size_t)(BK * 2);
    const size_t hstep = (size_t)HALF * K * 2;
    const size_t tstep = 2 * hstep;
    const unsigned ldsw = (unsigned)wid * 1024u;
    const int aoff = lds_byte(wr * 64 + fr, fq * 8), boff = lds_byte(wc * 32 + fr, fq * 8);
#define PG8_SA(b, h) (((b) * 2 + (h)) * HTB)
#define PG8_SB(b, h) ((4 + (b) * 2 + (h)) * HTB)
#define PG8_STAGE(bufoff, gbase, voff) do { _Pragma("unroll") for (int _i = 0; _i < 2; ++_i) \
        __builtin_amdgcn_global_load_lds((const unsigned*)((const char*)(gbase) + (voff)[_i]), (PG8_LAS unsigned*)(lds + (bufoff) + ldsw + _i * 8192), 16, 0, 0); } while (0)
#define PG8_LDA(dst, b, h) do { _Pragma("unroll") for (int m = 0; m < 4; ++m) _Pragma("unroll") for (int k = 0; k < 2; ++k) dst[m][k] = *(const PG8_LAS bf16x8*)(lds + PG8_SA(b, h) + aoff + m * 2048 + k * 1024); } while (0)
#define PG8_LDB(dst, b, h) do { _Pragma("unroll") for (int n = 0; n < 2; ++n) _Pragma("unroll") for (int k = 0; k < 2; ++k) dst[n][k] = *(const PG8_LAS bf16x8*)(lds + PG8_SB(b, h) + boff + n * 2048 + k * 1024); } while (0)
#define PG8_MMA(ai, bj, At, Bt) do { __builtin_amdgcn_s_setprio(1); _Pragma("unroll") for (int m = 0; m < 4; ++m) _Pragma("unroll") for (int n = 0; n < 2; ++n) _Pragma("unroll") for (int k = 0; k < 2; ++k) \
        acc[ai][bj][m][n] = __builtin_amdgcn_mfma_f32_16x16x32_bf16(Bt[n][k], At[m][k], acc[ai][bj][m][n], 0, 0, 0); __builtin_amdgcn_s_setprio(0); } while (0)
#define PG8_WAIT_V(n) asm volatile("s_waitcnt vmcnt(" #n ")" ::: "memory")
#define PG8_WAIT_L(n) asm volatile("s_waitcnt lgkmcnt(" #n ")" ::: "memory")
#define PG8_BAR __builtin_amdgcn_s_barrier()
#define PG8_SCHED __builtin_amdgcn_sched_barrier(0)
    Unit cur, nxt; int ui = 0;
    if (!S.next(0, cur)) return;
    f32x4 acc[2][2][4][2];
#pragma unroll
    for (int a = 0; a < 2; ++a)
#pragma unroll
        for (int b = 0; b < 2; ++b)
#pragma unroll
            for (int m = 0; m < 4; ++m)
#pragma unroll
                for (int n = 0; n < 2; ++n) acc[a][b][m][n] = (f32x4){0.f, 0.f, 0.f, 0.f};
    bf16x8 At[4][2], B0[2][2], B1[2][2];
    const char* cA = (const char*)g.A + (size_t)cur.pm * tstep; const char* cB = (const char*)g.Bt + (size_t)cur.pn * tstep;
    S.a_ready(cur);
    if constexpr (SP2) {
        PG8_STAGE(PG8_SB(0, 0), cB, voffB); PG8_STAGE(PG8_SB(0, 1), cB + hstep, voffB); PG8_STAGE(PG8_SA(0, 0), cA, voffA); PG8_STAGE(PG8_SA(0, 1), cA + hstep, voffA);
        if (wr == 1) PG8_BAR;
        PG8_WAIT_V(2); PG8_BAR;
        PG8_STAGE(PG8_SB(1, 0), cB + kstep, voffB); PG8_STAGE(PG8_SA(1, 0), cA + kstep, voffA); PG8_STAGE(PG8_SB(1, 1), cB + hstep + kstep, voffB);
        PG8_WAIT_V(6); PG8_BAR;
    } else {
        PG8_STAGE(PG8_SB(0, 0), cB, voffB); PG8_STAGE(PG8_SA(0, 0), cA, voffA); PG8_STAGE(PG8_SB(0, 1), cB + hstep, voffB); PG8_STAGE(PG8_SA(0, 1), cA + hstep, voffA);
        if (wr == 1) PG8_BAR;
        PG8_WAIT_V(4); PG8_BAR;
        PG8_STAGE(PG8_SB(1, 0), cB + kstep, voffB); PG8_STAGE(PG8_SA(1, 0), cA + kstep, voffA); PG8_STAGE(PG8_SB(1, 1), cB + hstep + kstep, voffB);
        PG8_WAIT_V(6); PG8_BAR;
    }
    for (;;) {
        const bool has_next = S.next(ui + 1, nxt);
        const char* nA = has_next ? (const char*)g.A + (size_t)nxt.pm * tstep : cA; const char* nB = has_next ? (const char*)g.Bt + (size_t)nxt.pn * tstep : cB;
        for (int t = 0; t < nt; t += 2) {
            const bool last = (t == nt - 2);
            const char* a1 = cA + (size_t)(t + 1) * kstep;
            const char* a2 = last ? nA : cA + (size_t)(t + 2) * kstep; const char* b2 = last ? nB : cB + (size_t)(t + 2) * kstep;
            const char* a3 = a2 + kstep; const char* b3 = b2 + kstep;
            if (last && has_next) S.a_ready(nxt);
            if constexpr (SP2) {
            PG8_LDB(B0, 0, 0); PG8_LDB(B1, 0, 1); PG8_SCHED; PG8_LDA(At, 0, 0); PG8_STAGE(PG8_SA(1, 1), a1 + hstep, voffA);
            PG8_WAIT_V(8); PG8_WAIT_L(0); PG8_BAR; PG8_MMA(0, 0, At, B0); PG8_MMA(0, 1, At, B1); PG8_BAR; PG8_SCHED;
            PG8_LDA(At, 0, 1); PG8_STAGE(PG8_SB(0, 0), b2, voffB); PG8_STAGE(PG8_SB(0, 1), b2 + hstep, voffB); PG8_STAGE(PG8_SA(0, 0), a2, voffA);
            PG8_WAIT_V(8); PG8_WAIT_L(0); PG8_BAR; PG8_MMA(1, 0, At, B0); PG8_MMA(1, 1, At, B1); PG8_BAR; PG8_SCHED;
            PG8_LDB(B0, 1, 0); PG8_LDB(B1, 1, 1); PG8_SCHED; PG8_LDA(At, 1, 0); PG8_STAGE(PG8_SA(0, 1), a2 + hstep, voffA);
            PG8_WAIT_V(8); PG8_WAIT_L(0); PG8_BAR; PG8_MMA(0, 0, At, B0); PG8_MMA(0, 1, At, B1); PG8_BAR; PG8_SCHED;
            PG8_LDA(At, 1, 1); PG8_STAGE(PG8_SB(1, 0), b3, voffB); PG8_STAGE(PG8_SB(1, 1), b3 + hstep, voffB); PG8_STAGE(PG8_SA(1, 0), a3, voffA);
            PG8_WAIT_V(8); PG8_WAIT_L(0); PG8_BAR; PG8_MMA(1, 0, At, B0); PG8_MMA(1, 1, At, B1); PG8_BAR; PG8_SCHED;
            } else {
            PG8_LDB(B0, 0, 0); PG8_SCHED; PG8_LDA(At, 0, 0); PG8_STAGE(PG8_SA(1, 1), a1 + hstep, voffA);
            PG8_WAIT_L(8); PG8_BAR; PG8_WAIT_L(0); PG8_MMA(0, 0, At, B0); PG8_BAR; PG8_SCHED;
            PG8_LDB(B1, 0, 1); PG8_STAGE(PG8_SB(0, 0), b2, voffB);
            PG8_BAR; PG8_WAIT_L(0); PG8_MMA(0, 1, At, B1); PG8_BAR;
            PG8_LDA(At, 0, 1); PG8_STAGE(PG8_SA(0, 0), a2, voffA);
            PG8_BAR; PG8_WAIT_L(0); PG8_MMA(1, 0, At, B0); PG8_BAR; PG8_SCHED;
            PG8_STAGE(PG8_SB(0, 1), b2 + hstep, voffB);
            PG8_WAIT_V(6); PG8_BAR; PG8_MMA(1, 1, At, B1); PG8_BAR;
            PG8_LDB(B0, 1, 0); PG8_SCHED; PG8_LDA(At, 1, 0); PG8_STAGE(PG8_SA(0, 1), a2 + hstep, voffA);
            PG8_WAIT_L(8); PG8_BAR; PG8_WAIT_L(0); PG8_MMA(0, 0, At, B0); PG8_BAR; PG8_SCHED;
            PG8_LDB(B1, 1, 1); PG8_STAGE(PG8_SB(1, 0), b3, voffB);
            PG8_BAR; PG8_WAIT_L(0); PG8_MMA(0, 1, At, B1); PG8_BAR;
            PG8_LDA(At, 1, 1); PG8_STAGE(PG8_SA(1, 0), a3, voffA);
            PG8_BAR; PG8_WAIT_L(0); PG8_MMA(1, 0, At, B0); PG8_BAR; PG8_SCHED;
            PG8_STAGE(PG8_SB(1, 1), b3 + hstep, voffB);
            PG8_WAIT_V(6); PG8_BAR; PG8_MMA(1, 1, At, B1); PG8_BAR;
            }
        }
        if constexpr (ALIGN_EPI) { if (wr == 0) PG8_BAR; }
        if constexpr (!Epi::AFTER_DRAIN) { E(acc, cur, wr, wc, fr, fq); S.done(cur); }
        if (!has_next) break;
#pragma unroll
        for (int a = 0; a < 2; ++a)
#pragma unroll
            for (int b = 0; b < 2; ++b)
#pragma unroll
                for (int m = 0; m < 4; ++m)
#pragma unroll
                    for (int n = 0; n < 2; ++n) acc[a][b][m][n] = (f32x4){0.f, 0.f, 0.f, 0.f};
        cur = nxt; cA = nA; cB = nB; ++ui;
        if constexpr (ALIGN_EPI) { if (wr == 1) PG8_BAR; }
    }
    PG8_WAIT_V(0);
    if constexpr (!ALIGN_EPI) { if (wr == 0) PG8_BAR; }
    PG8_BAR;
    if constexpr (Epi::AFTER_DRAIN) { E.fused(acc, cur, wr, wc, fr, fq, lds, wid, lane); S.done(cur); }
#undef PG8_SA
#undef PG8_SB
#undef PG8_STAGE
#undef PG8_LDA
#undef PG8_LDB
#undef PG8_MMA
#undef PG8_WAIT_V
#undef PG8_WAIT_L
#undef PG8_BAR
#undef PG8_SCHED
}
}
using pg8::bf16_t; using pg8::bf16x8; using pg8::f32x4; using pg8::u32x4; using pg8::f32x2; using pg8::cvt_pk_bf16;
#define LAS __attribute__((address_space(3)))
#define XB_TMO      128
#define XB_XCNT(j)  (256  + 64 * (j))
#define XB_XSUB(j)  (1280 + 64 * (j))
#define XB_XGEN(j)  (2304 + 64 * (j))
#define XB_TOP      3328
#define XB_TOPGEN   3392
#define XCD_BAR_WORDS 3456
#define XB_SPIN_CAP (1u << 18)

__device__ __forceinline__ unsigned xb_ld(unsigned* p)              { return __hip_atomic_load(p, __ATOMIC_RELAXED, __HIP_MEMORY_SCOPE_AGENT); }
__device__ __forceinline__ unsigned xb_add(unsigned* p, unsigned v) { return __hip_atomic_fetch_add(p, v, __ATOMIC_RELAXED, __HIP_MEMORY_SCOPE_AGENT); }
__device__ __forceinline__ unsigned xb_xcc_id() { return (unsigned)__builtin_amdgcn_s_getreg((3 << 11) | 20) & 0xFu; }
#define XB_SPIN(cond, bar) do { unsigned _sp = 0; while (cond) { __builtin_amdgcn_s_sleep(1); \
    if ((++_sp & 255u) == 0u) { if (xb_ld(&(bar)[XB_TMO])) break; if (_sp > XB_SPIN_CAP) { atomicAdd(&(bar)[XB_TMO], 1u); break; } } } } while (0)

struct XcdBarrier {
    unsigned* bar; unsigned x;
    volatile LAS unsigned* st;
};

__device__ __forceinline__ XcdBarrier xcd_barrier_post(unsigned* bar, volatile LAS unsigned* st) {
    XcdBarrier b; b.bar = bar; b.x = xb_xcc_id(); b.st = st;
    if (threadIdx.x == 0) (void)xb_add(&bar[XB_XCNT(b.x)], 1u);
    return b;
}
__device__ __forceinline__ void xcd_barrier_complete(unsigned* bar, unsigned x, unsigned& nloc, unsigned& nx) {
    const unsigned G = gridDim.x * gridDim.y * gridDim.z;
    unsigned sum, cnt, mine, sp = 0u;
    for (;;) {
        sum = 0u; cnt = 0u; mine = 0u;
#pragma unroll
        for (unsigned j = 0; j < 16; ++j) { const unsigned c = xb_ld(&bar[XB_XCNT(j)]); sum += c; cnt += (c > 0u) ? 1u : 0u; mine = (j == x) ? c : mine; }
        if (sum == G) break;
        __builtin_amdgcn_s_sleep(1);
        if ((++sp & 255u) == 0u) { if (xb_ld(&bar[XB_TMO])) break; if (sp > XB_SPIN_CAP) { atomicAdd(&bar[XB_TMO], 1u); break; } }
    }
    nloc = mine > 0u ? mine : 1u; nx = cnt > 0u ? cnt : 1u;
}

__device__ __forceinline__ void xcd_barrier(const XcdBarrier& b, const bool leader_thread) {
    asm volatile("s_waitcnt vmcnt(0)" ::: "memory");
    __syncthreads();
    if (leader_thread) {
        unsigned* bar = b.bar;
        __builtin_amdgcn_s_waitcnt(0);
        unsigned nloc = b.st[0], nx = b.st[1];
        if (nloc == 0u) { xcd_barrier_complete(bar, b.x, nloc, nx); b.st[0] = nloc; b.st[1] = nx; }
        const unsigned old = xb_add(&bar[XB_XSUB(b.x)], 1u);
        const unsigned gen = old / nloc;
        if (old + 1u == (gen + 1u) * nloc) {
            __builtin_amdgcn_fence(__ATOMIC_RELEASE, "agent");
            asm volatile("s_waitcnt vmcnt(0)" ::: "memory");
            const unsigned og = xb_add(&bar[XB_TOP], 1u);
            const unsigned tg = og / nx;
            if (og + 1u == (tg + 1u) * nx) xb_add(&bar[XB_TOPGEN], 1u);
            else XB_SPIN(xb_ld(&bar[XB_TOPGEN]) == tg, bar);
            __builtin_amdgcn_fence(__ATOMIC_ACQUIRE, "agent");
            xb_add(&bar[XB_XGEN(b.x)], 1u);
            asm volatile("s_waitcnt vmcnt(0)" ::: "memory");
        } else {
            XB_SPIN(xb_ld(&bar[XB_XGEN(b.x)]) == gen, bar);
            __builtin_amdgcn_fence(__ATOMIC_ACQUIRE, "agent");
            asm volatile("s_waitcnt vmcnt(0)" ::: "memory");
        }
    }
    __syncthreads();
}

typedef unsigned u32x2 __attribute__((ext_vector_type(2)));
typedef short s16x4 __attribute__((ext_vector_type(4)));
#define DI __device__ __forceinline__
#ifndef GEMM_SP2
#define GEMM_SP2 true
#endif
#ifndef GEMM_ALIGN
#define GEMM_ALIGN true
#endif
#ifndef DUP
#define DUP 0
#endif

constexpr int DM = 1024, MP = 16384, MS = 512, MT = 16896, DFF = 2816, NIN = 1536;
constexpr float EPS = 1e-6f;
constexpr int NTHR = 512;
constexpr int LDS_BYTES = 152 * 1024;

constexpr size_t SZ_WGU = (size_t)5632 * 1024 * 2, SZ_WD = (size_t)1024 * 2816 * 2, SZ_WIN = (size_t)1536 * 1024 * 2, SZ_WOUT = (size_t)1024 * 1024 * 2;
constexpr size_t WS_WGU = 0;
constexpr size_t WS_WD = WS_WGU + 4 * SZ_WGU;
constexpr size_t WS_WIN = WS_WD + 4 * SZ_WD;
constexpr size_t WS_WOUT = WS_WIN + 2 * SZ_WIN;
constexpr size_t SZ_XB = (size_t)MT * 1024 * 2;
constexpr size_t WS_XB = WS_WOUT + 2 * SZ_WOUT;
constexpr size_t WS_Y = WS_XB + SZ_XB;
constexpr size_t WS_BIG = WS_Y + SZ_XB;
constexpr size_t SZ_BIG = (size_t)MT * DFF * 2;
constexpr size_t SZ_F256 = (size_t)MT * 256 * 4;
constexpr size_t WS_XL = WS_BIG, WS_HL = WS_XL + SZ_F256, WS_PC = WS_HL + SZ_F256, WS_KBP = WS_PC + SZ_F256;
constexpr size_t SZ_KBP = (size_t)4 * 4096 * 128 * 2;
constexpr size_t WS_VTP = WS_KBP + SZ_KBP;
static_assert(WS_VTP + SZ_KBP <= WS_BIG + SZ_BIG, "mixer scratch must fit in the act buffer");
constexpr size_t WS_SS = WS_BIG + SZ_BIG;
constexpr size_t WS_KBS = WS_SS + (size_t)MT * 16 * 4;
constexpr size_t SZ_KBS = (size_t)32 * 160 * 128 * 2;
constexpr size_t WS_VTS = WS_KBS + 2 * SZ_KBS;
constexpr size_t WS_SSUM = WS_VTS + 2 * SZ_KBS;
constexpr size_t WS_LSUM = WS_SSUM + (size_t)4 * 64 * 16 * 64 * 8;
constexpr size_t WS_SPAR = WS_LSUM + (size_t)4 * 64 * 2 * 256 * 4;
constexpr size_t SZ_SPAR = 16384 + 131072;
constexpr size_t WS_CC = WS_SPAR + 2 * SZ_SPAR;
constexpr size_t WS_WGLU = WS_CC + 2 * 65536;
constexpr size_t WS_WAX = WS_WGLU + 2 * 131072;
constexpr size_t WS_BAR = WS_WAX + 2 * 65536;
constexpr size_t WS_BBF = WS_BAR + (size_t)XCD_BAR_WORDS * 4;
constexpr size_t WS_END = WS_BBF + (size_t)2 * 16 * 128 * 32 * 2;
static_assert(WS_END <= (size_t)256 * 1024 * 1024, "workspace budget");

constexpr size_t O_YP = 0, O_YS = (size_t)MP * 1024, O_KP = O_YS + (size_t)MS * 1024, O_VP = O_KP + 131072, O_SREP = O_VP + 131072, O_SIMP = O_SREP + 8192,
                 O_CONVP = O_SIMP + 8192, O_LRUP = O_CONVP + 6144, O_KS = O_LRUP + 2048, O_VS = O_KS + 131072, O_SRES = O_VS + 131072, O_SIMS = O_SRES + 65536,
                 O_CONVS = O_SIMS + 65536, O_LRUS = O_CONVS + 49152, O_END = O_LRUS + 16384;

struct Params { const float* in[38]; float* out; unsigned char* ws; int ph_lo, ph_hi; };
typedef const Params __attribute__((address_space(4))) CParams;

DI float bf2f(bf16_t v) { return __uint_as_float(((unsigned)v) << 16); }
DI bf16_t f2bf(float f) { return (bf16_t)(cvt_pk_bf16(f, 0.f) & 0xffffu); }
DI float sigmoidf_(float x) { return __builtin_amdgcn_rcpf(1.f + __expf(-x)); }
DI float gelu_tanh(float x) { const float v = 1.5957691216057308f * (x + 0.044715f * x * x * x); return x * __builtin_amdgcn_rcpf(1.f + __expf(-v)); }
DI f32x4 mfma16(bf16x8 a, bf16x8 b, f32x4 c) { return __builtin_amdgcn_mfma_f32_16x16x32_bf16(a, b, c, 0, 0, 0); }
DI f32x2 cmul(f32x2 a, f32x2 b) { return (f32x2){a.x * b.x - a.y * b.y, a.x * b.y + a.y * b.x}; }
DI float row_rstd(const float* ss, int row, float invn) {
    const f32x4* p = (const f32x4*)(ss + (size_t)row * 16); const f32x4 a = p[0], b = p[1], c = p[2], d = p[3];
    const f32x4 t = (a + b) + (c + d); return rsqrtf(((t[0] + t[1]) + (t[2] + t[3])) * invn + EPS);
}
DI void lds_fence() { asm volatile("s_waitcnt lgkmcnt(0)" ::: "memory"); }

DI void unit_rstd8(const float* ss, int row0, int fq, float (&rs)[8]) {
    f32x4 q[8];
#pragma unroll
    for (int i = 0; i < 8; ++i) q[i] = *(const f32x4*)(ss + (size_t)(row0 + (i >> 2) * 128 + (i & 3) * 16) * 16 + fq * 4);
#pragma unroll
    for (int i = 0; i < 8; ++i) { float t = (q[i][0] + q[i][1]) + (q[i][2] + q[i][3]); t += __shfl_xor(t, 16); t += __shfl_xor(t, 32); rs[i] = rsqrtf(t * (1.f / 1024.f) + EPS); }
}
struct EpiGateUp {
    static constexpr bool PERM = true, AFTER_DRAIN = false;
    bf16_t* act; const float* ss;
    DI void operator()(const f32x4 (&acc)[2][2][4][2], const pg8::Unit& u, int wr, int wc, int fr, int fq) const {
        const int row0 = u.pm * 256 + wr * 64 + fr, col = u.pn * 128 + wc * 32 + 8 * fq;
        float rs8[8]; unit_rstd8(ss, row0, fq, rs8);
#pragma unroll
        for (int ai = 0; ai < 2; ++ai)
#pragma unroll
            for (int m = 0; m < 4; ++m) {
                const int row = row0 + ai * 128 + m * 16;
                const float rs = rs8[ai * 4 + m];
                f32x2 o2[4];
#pragma unroll
                for (int n = 0; n < 2; ++n)
#pragma unroll
                    for (int hh = 0; hh < 2; ++hh) {
                        const f32x2 g = (f32x2){acc[ai][0][m][n][2 * hh], acc[ai][0][m][n][2 * hh + 1]} * rs, up = (f32x2){acc[ai][1][m][n][2 * hh], acc[ai][1][m][n][2 * hh + 1]} * rs;
                        const f32x2 t = g * (-1.44269504089f);
                        f32x2 e; e.x = __builtin_amdgcn_exp2f(t.x); e.y = __builtin_amdgcn_exp2f(t.y);
                        const f32x2 d = e + 1.0f;
                        f32x2 r; r.x = __builtin_amdgcn_rcpf(d.x); r.y = __builtin_amdgcn_rcpf(d.y);
                        o2[n * 2 + hh] = (g * r) * up;
                    }
                u32x4 w; w.x = cvt_pk_bf16(o2[0].x, o2[0].y); w.y = cvt_pk_bf16(o2[1].x, o2[1].y); w.z = cvt_pk_bf16(o2[2].x, o2[2].y); w.w = cvt_pk_bf16(o2[3].x, o2[3].y);
                *(u32x4*)(act + (size_t)row * DFF + col) = w;
            }
    }
};
struct EpiResid {
    static constexpr bool PERM = true, AFTER_DRAIN = false;
    const float* xin_p; bf16_t* xb; float* ssout; float scale; bool first;
    DI void operator()(const f32x4 (&acc)[2][2][4][2], const pg8::Unit& u, int wr, int wc, int fr, int fq) const {
        const int row0 = u.pm * 256 + wr * 64 + fr, colb = u.pn * 256 + wc * 32 + 8 * fq;
#pragma unroll
        for (int ai = 0; ai < 2; ++ai)
#pragma unroll
            for (int m = 0; m < 4; ++m) {
                const int row = row0 + ai * 128 + m * 16;
                bf16_t* xbo = xb + (size_t)row * 1024;
                float s = 0.f;
#pragma unroll
                for (int bj = 0; bj < 2; ++bj) {
                    const int col = colb + bj * 128;
                    f32x4 a0, a1;
                    if (first) { const float* xi = xin_p + (size_t)row * 1024 + col; a0 = *(const f32x4*)xi; a1 = *(const f32x4*)(xi + 4); }
                    else { const u32x4 o = *(const u32x4*)(xbo + col);
                        a0[0] = __uint_as_float(o.x << 16); a0[1] = __uint_as_float(o.x & 0xffff0000u); a0[2] = __uint_as_float(o.y << 16); a0[3] = __uint_as_float(o.y & 0xffff0000u);
                        a1[0] = __uint_as_float(o.z << 16); a1[1] = __uint_as_float(o.z & 0xffff0000u); a1[2] = __uint_as_float(o.w << 16); a1[3] = __uint_as_float(o.w & 0xffff0000u); }
                    const f32x4 v0 = a0 + acc[ai][bj][m][0] * scale, v1 = a1 + acc[ai][bj][m][1] * scale;
                    u32x4 w; w.x = cvt_pk_bf16(v0[0], v0[1]); w.y = cvt_pk_bf16(v0[2], v0[3]); w.z = cvt_pk_bf16(v1[0], v1[1]); w.w = cvt_pk_bf16(v1[2], v1[3]);
                    *(u32x4*)(xbo + col) = w;
                    s += (v0[0] * v0[0] + v0[1] * v0[1]) + (v0[2] * v0[2] + v0[3] * v0[3]) + (v1[0] * v1[0] + v1[1] * v1[1]) + (v1[2] * v1[2] + v1[3] * v1[3]);
                }
                s += __shfl_xor(s, 16); s += __shfl_xor(s, 32);
                if (fq == 0) ssout[(size_t)row * 16 + u.pn * 4 + wc] = s;
                if (m == 3) asm volatile("" ::: "memory");
            }
    }
};
struct EpiProj {
    static constexpr bool PERM = true, AFTER_DRAIN = false;
    const float* ss; bf16_t* y; float* xl; bf16_t* kbp; bf16_t* vtp; bf16_t* kbs; bf16_t* vts; float* okp; float* ovp; float* oks; float* ovs;
    DI void operator()(const f32x4 (&acc)[2][2][4][2], const pg8::Unit& u, int wr, int wc, int fr, int fq) const {
        const int row0 = u.pm * 256 + wr * 64 + fr, cl = wc * 32 + 8 * fq;
        const int pn = u.pn;
        float rs8[8]; unit_rstd8(ss, row0, fq, rs8);
#pragma unroll
        for (int ai = 0; ai < 2; ++ai)
#pragma unroll
            for (int m = 0; m < 4; ++m) {
                const int row = row0 + ai * 128 + m * 16;
                float rs = rs8[ai * 4 + m];
                if (pn == 4) {
#pragma unroll
                    for (int bj = 0; bj < 2; ++bj) { float* d = xl + (size_t)row * 256 + bj * 128 + cl; *(f32x4*)d = acc[ai][bj][m][0] * rs; *(f32x4*)(d + 4) = acc[ai][bj][m][1] * rs; }
                } else if (pn == 3) {
                    const int kvh = cl >> 6, d0 = cl & 63;
                    const bool prm = row < MP;
                    const int b = prm ? (row >> 12) : ((row - MP) >> 4), pos = prm ? (row & 4095) : ((row - MP) & 15);
                    const bool wout = prm ? (pos >= 3968) : true;
                    const unsigned oo = prm ? (unsigned)((b * 128 + (pos - 3968)) * 128 + cl) : (unsigned)((b * 16 + pos) * 128 + cl);
                    {
                        const f32x4 v0 = acc[ai][0][m][0] * rs, v1 = acc[ai][0][m][1] * rs;
                        if (wout) { float* of = (prm ? okp : oks) + oo; *(f32x4*)of = v0; *(f32x4*)(of + 4) = v1; }
                        u32x4 w; w.x = cvt_pk_bf16(v0[0], v0[1]); w.y = cvt_pk_bf16(v0[2], v0[3]); w.z = cvt_pk_bf16(v1[0], v1[1]); w.w = cvt_pk_bf16(v1[2], v1[3]);
                        bf16_t* kd = prm ? kbp + (unsigned)(row * 128 + cl) : kbs + (unsigned)((b * 160 + 128 + pos) * 128 + cl);
                        *(u32x4*)kd = w;
                    }
                    {
                        const f32x4 v0 = acc[ai][1][m][0] * rs, v1 = acc[ai][1][m][1] * rs;
                        if (wout) { float* of = (prm ? ovp : ovs) + oo; *(f32x4*)of = v0; *(f32x4*)(of + 4) = v1; }
                        const unsigned vstride = prm ? 4096u : 160u;
                        bf16_t* vd = prm ? vtp + (unsigned)(((b * 2 + kvh) * 64 + d0) * 4096 + pos) : vts + (unsigned)(((b * 2 + kvh) * 64 + d0) * 160 + 128 + pos);
#pragma unroll
                        for (int jj = 0; jj < 4; ++jj) { vd[jj * vstride] = f2bf(v0[jj]); vd[(jj + 4) * vstride] = f2bf(v1[jj]); }
                    }
                } else {
                    const int cbase = (pn == 0) ? 0 : (pn == 5 ? 768 : 256 + (pn - 1) * 256);
                    if (pn == 1 || pn == 2) rs *= 0.125f;
#pragma unroll
                    for (int bj = 0; bj < 2; ++bj) {
                        const f32x4 v0 = acc[ai][bj][m][0] * rs, v1 = acc[ai][bj][m][1] * rs;
                        u32x4 w; w.x = cvt_pk_bf16(v0[0], v0[1]); w.y = cvt_pk_bf16(v0[2], v0[3]); w.z = cvt_pk_bf16(v1[0], v1[1]); w.w = cvt_pk_bf16(v1[2], v1[3]);
                        *(u32x4*)(y + (size_t)row * 1024 + cbase + bj * 128 + cl) = w;
                    }
                }
            }
    }
};
struct TileJob { const float* src; const float* gain; bf16_t* dst; int K, N, map, k0, n0; };
DI TileJob decode_tile(CParams& P, int tile) {
    unsigned char* ws = P.ws; TileJob J;
    const int l = tile / 2432, r = tile % 2432;
    int j, tl; if (r < 2112) { j = r / 352; tl = r % 352; } else if (r < 2304) { j = 6; tl = r - 2112; } else { j = 7; tl = r - 2304; }
    J.map = 0;
    if (j == 0 || j == 1 || j == 3 || j == 4) {
        const int f = j >= 3; const int which = (j == 1 || j == 4);
        J.src = P.in[(f ? 34 : 9) + which] + (size_t)l * 1024 * 2816; J.gain = P.in[f ? 33 : 8] + l * 1024; J.dst = (bf16_t*)(ws + WS_WGU + (size_t)(l * 2 + f) * SZ_WGU); J.K = 1024; J.N = 2816; J.map = 1 + which;
    } else if (j == 2 || j == 5) {
        const int f = j == 5; J.src = P.in[f ? 36 : 11] + (size_t)l * 2816 * 1024; J.gain = nullptr; J.dst = (bf16_t*)(ws + WS_WD + (size_t)(l * 2 + f) * SZ_WD); J.K = 2816; J.N = 1024;
    } else if (j == 6) { J.src = P.in[13] + (size_t)l * 1024 * 1536; J.gain = P.in[12] + l * 1024; J.dst = (bf16_t*)(ws + WS_WIN + (size_t)l * SZ_WIN); J.K = 1024; J.N = 1536; }
    else { J.src = P.in[32] + (size_t)l * 1024 * 1024; J.gain = P.in[31] + l * 1024; J.dst = (bf16_t*)(ws + WS_WOUT + (size_t)l * SZ_WOUT); J.K = 1024; J.N = 1024; }
    const int nkt = J.K / 128, kt = tl % nkt, nt = tl / nkt; J.k0 = kt * 128; J.n0 = nt * 64;
    return J;
}
DI void convert_tiles(CParams& P, LAS unsigned char* lds, const int tid, const int first, const int stride, const int tbeg, const int tend) {
    LAS bf16_t* T = (LAS bf16_t*)lds;
    {
        LAS bf16_t* T2_ = T + 64 * 136;
        int tA = tbeg + first, tB = tbeg + first + stride; const int NT = tend;
        f32x4 vA[4], vB[4]; float gA = 1.f, gB = 1.f;
        const int lk = tid >> 2, lns = (tid & 3) * 16;
#define T1_LOAD(tile, v, g) do { const TileJob J = decode_tile(P, tile); const float* sp = J.src + (size_t)(J.k0 + lk) * J.N + J.n0 + lns; g = J.gain ? J.gain[J.k0 + lk] : 1.f; \
            _Pragma("unroll") for (int i = 0; i < 4; ++i) v[i] = *(const f32x4*)(sp + 4 * i); } while (0)
#define T1_TOLDS(Tb, v, g) do { _Pragma("unroll") for (int i = 0; i < 4; ++i) _Pragma("unroll") for (int e = 0; e < 4; ++e) Tb[(lns + 4 * i + e) * 136 + lk] = f2bf(v[i][e] * g); } while (0)
#define T1_STORE(Tb, tile) do { const TileJob J = decode_tile(P, tile); const int n = tid >> 3, ks = (tid & 7) * 16; \
            const int ng = J.n0 + n; const int drow = (J.map == 0) ? ng : (256 * (ng >> 7) + (ng & 127) + (J.map == 2 ? 128 : 0)); \
            const u32x4 a = *(const LAS u32x4*)(Tb + n * 136 + ks), b = *(const LAS u32x4*)(Tb + n * 136 + ks + 8); \
            bf16_t* d = J.dst + (size_t)drow * J.K + J.k0 + ks; *(u32x4*)d = a; *(u32x4*)(d + 8) = b; } while (0)
        if (tA < NT) T1_LOAD(tA, vA, gA);
        if (tB < NT) T1_LOAD(tB, vB, gB);
        while (tA < NT) {
            T1_TOLDS(T, vA, gA);
            if (tB < NT) T1_TOLDS(T2_, vB, gB);
            __syncthreads();
            const int nA = tA + 2 * stride, nB = tB + 2 * stride;
            if (nA < NT) T1_LOAD(nA, vA, gA);
            if (nB < NT) T1_LOAD(nB, vB, gB);
            T1_STORE(T, tA);
            if (tB < NT) T1_STORE(T2_, tB);
            __syncthreads();
            tA = nA; tB = nB;
        }
#undef T1_LOAD
#undef T1_TOLDS
#undef T1_STORE
    }
}
DI void prep_phase(CParams& P, LAS unsigned char* lds, const int tid, const int bid, const int nb) {
    const int lane = tid & 63, wave = tid >> 6;
    unsigned char* ws = P.ws;
    convert_tiles(P, lds, tid, bid, nb, 0, 704);
    {
        bf16_t* xb = (bf16_t*)(ws + WS_XB); float* ss0 = (float*)(ws + WS_SS);
        for (int row = bid * 8 + wave; row < MT; row += nb * 8) {
            const float* x = (row < MP) ? P.in[0] + (size_t)row * 1024 : P.in[1] + (size_t)(row - MP) * 1024;
            float s = 0.f;
#pragma unroll
            for (int i = 0; i < 4; ++i) {
                const f32x4 v = *(const f32x4*)(x + i * 256 + lane * 4);
                s += v[0] * v[0] + v[1] * v[1] + v[2] * v[2] + v[3] * v[3];
                u32x2 w; w.x = cvt_pk_bf16(v[0], v[1]); w.y = cvt_pk_bf16(v[2], v[3]);
                *(u32x2*)(xb + (size_t)row * 1024 + i * 256 + lane * 4) = w;
            }
#pragma unroll
            for (int o = 1; o < 64; o <<= 1) s += __shfl_xor(s, o);
            if (lane < 16) ss0[(size_t)row * 16 + lane] = (lane == 0) ? s : 0.f;
        }
    }
    const int gt = bid * NTHR + tid, gs = nb * NTHR;
    for (int e = gt; e < 2 * 32 * 128 * 128; e += gs) {
        const int c = e & 127, r = (e >> 7) & 127, sb = (e >> 14) & 31, l = e >> 19;
        bf16_t* kbs = (bf16_t*)(ws + WS_KBS + (size_t)l * SZ_KBS); bf16_t* vts = (bf16_t*)(ws + WS_VTS + (size_t)l * SZ_KBS);
        kbs[((size_t)(sb * 160 + r)) * 128 + c] = f2bf(P.in[2][e]);
        vts[((size_t)((sb * 2 + (c >> 6)) * 64 + (c & 63))) * 160 + r] = f2bf(P.in[3][e]);
    }
    for (int e = gt; e < 2 * 32 * 16 * 128; e += gs) {
        const int c = e & 127, r = (e >> 7) & 15, sb = (e >> 11) & 31, l = e >> 16;
        bf16_t* kbs = (bf16_t*)(ws + WS_KBS + (size_t)l * SZ_KBS); bf16_t* vts = (bf16_t*)(ws + WS_VTS + (size_t)l * SZ_KBS);
        kbs[((size_t)(sb * 160 + 144 + r)) * 128 + c] = 0;
        vts[((size_t)((sb * 2 + (c >> 6)) * 64 + (c & 63))) * 160 + 144 + r] = 0;
    }
    for (int e = gt; e < 2 * 16 * 64; e += gs) {
        const int p = e & 63, g = (e >> 6) & 15, l = e >> 10;
        const float dt = expf(P.in[16][l * 16 + g]);
        const float are = P.in[14][e], aim = P.in[15][e];
        const float mag = expf(are * dt);
        const float lbr = mag * cosf(aim * dt), lbi = mag * sinf(aim * dt);
        const float den = are * are + aim * aim, nr = lbr - 1.f;
        const float kr = (nr * are + lbi * aim) / den, ki = (lbi * are - nr * aim) / den;
        f32x2 pw = (f32x2){lbr, lbi};
#pragma unroll
        for (int i = 0; i < 6; ++i) pw = cmul(pw, pw);
        float* lb = (float*)(ws + WS_SPAR + (size_t)l * SZ_SPAR) + (size_t)(g * 64 + p) * 4;
        lb[0] = lbr; lb[1] = lbi; lb[2] = pw.x; lb[3] = pw.y;
        float* bb = (float*)(ws + WS_SPAR + (size_t)l * SZ_SPAR + 16384) + (size_t)(g * 64 + p) * 32;
        const float* bre = P.in[17] + (size_t)e * 16; const float* bim = P.in[18] + (size_t)e * 16;
        bf16_t* bfr = (bf16_t*)(ws + WS_BBF) + ((size_t)((l * 16 + g) * 128 + p)) * 32; bf16_t* bfi = bfr + 64 * 32;
#pragma unroll
        for (int h = 0; h < 16; ++h) { const float br = bre[h], bi = bim[h]; const float xr = kr * br - ki * bi, xi = kr * bi + ki * br; bb[2 * h] = xr; bb[2 * h + 1] = xi;
            bfr[h] = f2bf(xr); bfi[h] = f2bf(xi); bfr[16 + h] = 0; bfi[16 + h] = 0; }
    }
    for (int e = gt; e < 2 * 16 * 16 * 128; e += gs) {
        const int k = e & 127, h = (e >> 7) & 15, g = (e >> 11) & 15, l = e >> 15;
        const size_t si = ((size_t)((l * 16 + g) * 16 + h)) * 64 + (k & 63);
        ((bf16_t*)(ws + WS_CC))[e] = f2bf(k < 64 ? P.in[19][si] : -P.in[20][si]);
    }
    for (int e = gt; e < 2 * 256 * 256; e += gs) {
        const int k = e & 255, n = (e >> 8) & 255, l = e >> 16;
        ((bf16_t*)(ws + WS_WGLU))[e] = f2bf(P.in[22][((size_t)(l * 256 + k)) * 256 + n]);
    }
    for (int e = gt; e < 2 * 2 * 4 * 64 * 64; e += gs) {
        const int i = e & 63, o = (e >> 6) & 63, blk = (e >> 12) & 3, which = (e >> 14) & 1, l = e >> 15;
        ((bf16_t*)(ws + WS_WAX))[e] = f2bf(P.in[which ? 28 : 26][((size_t)((l * 4 + blk) * 64 + i)) * 64 + o]);
    }
}

DI f32x2 ssm_x(const f32x2 (&bb)[16], const LAS float* ut) {
    const f32x4 u0 = *(const LAS f32x4*)ut, u1 = *(const LAS f32x4*)(ut + 4), u2 = *(const LAS f32x4*)(ut + 8), u3 = *(const LAS f32x4*)(ut + 12);
    f32x2 xa = bb[0] * u0[0], xb = bb[1] * u0[1], xc = bb[2] * u0[2], xd = bb[3] * u0[3];
    xa += bb[4] * u1[0]; xb += bb[5] * u1[1]; xc += bb[6] * u1[2]; xd += bb[7] * u1[3];
    xa += bb[8] * u2[0]; xb += bb[9] * u2[1]; xc += bb[10] * u2[2]; xd += bb[11] * u2[3];
    xa += bb[12] * u3[0]; xb += bb[13] * u3[1]; xc += bb[14] * u3[2]; xd += bb[15] * u3[3];
    return (xa + xb) + (xc + xd);
}
DI void stage_u(const bf16_t* y, int row0, int T, LAS float* U32, int tid) {
    for (int idx = tid; idx < T * 32; idx += NTHR) {
        const int t = idx >> 5, seg = idx & 31;
        const u32x4 v = *(const u32x4*)(y + (size_t)(row0 + t) * 1024 + seg * 8);
        f32x4 a, b;
        a[0] = __uint_as_float(v.x << 16); a[1] = __uint_as_float(v.x & 0xffff0000u); a[2] = __uint_as_float(v.y << 16); a[3] = __uint_as_float(v.y & 0xffff0000u);
        b[0] = __uint_as_float(v.z << 16); b[1] = __uint_as_float(v.z & 0xffff0000u); b[2] = __uint_as_float(v.w << 16); b[3] = __uint_as_float(v.w & 0xffff0000u);
        *(LAS f32x4*)(U32 + t * 256 + seg * 8) = a; *(LAS f32x4*)(U32 + t * 256 + seg * 8 + 4) = b;
    }
}

DI void attn_chunk_item(CParams& P, int l, int ci, LAS unsigned char* lds, int tid, bf16_t* Yw) {
    unsigned char* ws = P.ws;
    const bf16_t* Y = (const bf16_t*)(ws + WS_Y);
    const int wave = tid >> 6, lane = tid & 63, fr = lane & 15, fq = lane >> 4;
    const bool smp = ci >= 256;
    const bf16_t* kb; const bf16_t* vt; int lpad, nkeys, nvt, row0, nsub;
    if (!smp) {
        const int b = ci >> 6, c = ci & 63, c0 = c >= 2 ? c - 2 : 0, klo = c0 * 64;
        nkeys = (c + 1) * 64 - klo; nvt = nkeys >> 4; row0 = b * 4096 + c * 64; nsub = 4;
        kb = (const bf16_t*)(ws + WS_KBP) + ((size_t)(b * 4096 + klo)) * 128; vt = (const bf16_t*)(ws + WS_VTP) + (size_t)(b * 2) * 64 * 4096 + klo; lpad = 4096;
    } else {
        const int sb = ci - 256; nkeys = 160; nvt = 9; row0 = MP + sb * 16; nsub = 1;
        kb = (const bf16_t*)(ws + WS_KBS + (size_t)l * SZ_KBS) + (size_t)sb * 160 * 128; vt = (const bf16_t*)(ws + WS_VTS + (size_t)l * SZ_KBS) + (size_t)sb * 2 * 64 * 160; lpad = 160;
    }
    const int npair = nkeys >> 5;
    LAS unsigned char* KL = lds;
    LAS unsigned char* VL = lds + 192 * 272;
    LAS float* ssq = (LAS float*)(lds + 192 * 272 + 128 * 400);
    {
        const int ppr = nkeys >> 3, nk = nkeys * 16, nv = 128 * ppr;
        u32x4 kq[6], vq[6];
#pragma unroll
        for (int i = 0; i < 6; ++i) { const int idx = tid + i * NTHR; const int ic = idx < nk ? idx : 0; kq[i] = *(const u32x4*)(kb + (size_t)(ic >> 4) * 128 + (ic & 15) * 8); }
#pragma unroll
        for (int i = 0; i < 6; ++i) { const int idx = tid + i * NTHR; const int ic = idx < nv ? idx : 0; const int r = ic / ppr, sg = ic - r * ppr; vq[i] = *(const u32x4*)(vt + (size_t)r * lpad + sg * 8); }
#pragma unroll
        for (int i = 0; i < 6; ++i) { const int idx = tid + i * NTHR; if (idx < nk) *(LAS u32x4*)(KL + (idx >> 4) * 272 + (idx & 15) * 16) = kq[i]; }
#pragma unroll
        for (int i = 0; i < 6; ++i) { const int idx = tid + i * NTHR; if (idx < nv) { const int r = idx / ppr, sg = idx - r * ppr; *(LAS u32x4*)(VL + r * 400 + sg * 16) = vq[i]; } }
    }
    const int h = wave, kvh = h >> 2;
    bf16x8 qf[4][2];
#pragma unroll
    for (int sb_ = 0; sb_ < 4; ++sb_) {
        const int su = sb_ < nsub ? sb_ : 0;
        const bf16_t* yq = Y + (size_t)(row0 + su * 16 + fr) * 1024 + 256 + h * 64;
        qf[sb_][0] = *(const bf16x8*)(yq + fq * 8); qf[sb_][1] = *(const bf16x8*)(yq + 32 + fq * 8);
    }
    const float sink = P.in[23][l * 8 + h];
    __syncthreads();
    f32x4 O[4][4];
#pragma unroll
    for (int su = 0; su < 4; ++su) {
        if (su < nsub) {
            f32x4 s[12];
#pragma unroll
            for (int kt = 0; kt < 12; ++kt) {
                if (kt < nvt) {
                    const LAS unsigned char* kp = KL + (kt * 16 + fr) * 272 + kvh * 128 + fq * 16;
                    const bf16x8 k0 = *(const LAS bf16x8*)kp, k1 = *(const LAS bf16x8*)(kp + 64);
                    f32x4 a = (f32x4){0.f, 0.f, 0.f, 0.f};
                    a = mfma16(k0, qf[su][0], a); a = mfma16(k1, qf[su][1], a);
                    s[kt] = a;
                } else s[kt] = (f32x4){-1e30f, -1e30f, -1e30f, -1e30f};
            }
            float mx = sink;
#pragma unroll
            for (int kt = 0; kt < 12; ++kt)
#pragma unroll
                for (int jj = 0; jj < 4; ++jj) mx = fmaxf(mx, s[kt][jj]);
            mx = fmaxf(mx, __shfl_xor(mx, 16)); mx = fmaxf(mx, __shfl_xor(mx, 32));
            float sum = 0.f;
#pragma unroll
            for (int kt = 0; kt < 12; ++kt)
#pragma unroll
                for (int jj = 0; jj < 4; ++jj) { const float p = __expf(s[kt][jj] - mx); s[kt][jj] = p; sum += p; }
            sum += __shfl_xor(sum, 16); sum += __shfl_xor(sum, 32);
            const float inv = 1.f / (sum + __expf(sink - mx));
#pragma unroll
            for (int dt = 0; dt < 4; ++dt) O[su][dt] = (f32x4){0.f, 0.f, 0.f, 0.f};
#pragma unroll
            for (int i = 0; i < 6; ++i) {
                if (i < npair) {
                    u32x4 pw; pw.x = cvt_pk_bf16(s[2 * i][0], s[2 * i][1]); pw.y = cvt_pk_bf16(s[2 * i][2], s[2 * i][3]); pw.z = cvt_pk_bf16(s[2 * i + 1][0], s[2 * i + 1][1]); pw.w = cvt_pk_bf16(s[2 * i + 1][2], s[2 * i + 1][3]);
                    const bf16x8 pb = __builtin_bit_cast(bf16x8, pw);
#pragma unroll
                    for (int dt = 0; dt < 4; ++dt) {
                        const LAS unsigned char* vp = VL + (kvh * 64 + dt * 16 + fr) * 400 + i * 64 + fq * 8;
                        const s16x4 lo = *(const LAS s16x4*)vp, hi = *(const LAS s16x4*)(vp + 32);
                        const bf16x8 vf = __builtin_shufflevector(lo, hi, 0, 1, 2, 3, 4, 5, 6, 7);
                        O[su][dt] = mfma16(vf, pb, O[su][dt]);
                    }
                }
            }
            float sl = 0.f;
#pragma unroll
            for (int dt = 0; dt < 4; ++dt) { O[su][dt] = O[su][dt] * inv; sl += O[su][dt][0] * O[su][dt][0] + O[su][dt][1] * O[su][dt][1] + O[su][dt][2] * O[su][dt][2] + O[su][dt][3] * O[su][dt][3]; }
            sl += __shfl_xor(sl, 16); sl += __shfl_xor(sl, 32);
            if (fq == 0) ssq[(su * 8 + h) * 16 + fr] = sl;
        }
    }
    __syncthreads();
#pragma unroll
    for (int su = 0; su < 4; ++su) {
        if (su < nsub) {
            float tot = 0.f;
#pragma unroll
            for (int hh = 0; hh < 8; ++hh) tot += ssq[(su * 8 + hh) * 16 + fr];
            const float rs = rsqrtf(tot * (1.f / 512.f) + EPS);
            bf16_t* yo = Yw + (size_t)(row0 + su * 16 + fr) * 1024 + 256 + h * 64;
#pragma unroll
            for (int dt = 0; dt < 4; ++dt) {
                u32x2 w; w.x = cvt_pk_bf16(O[su][dt][0] * rs, O[su][dt][1] * rs); w.y = cvt_pk_bf16(O[su][dt][2] * rs, O[su][dt][3] * rs);
                *(u32x2*)(yo + dt * 16 + fq * 4) = w;
            }
        }
    }
    __syncthreads();
}

DI void lru_item(CParams& P, int l, int li, LAS unsigned char* lds, int tid) {
    unsigned char* ws = P.ws;
    const int wave = tid >> 6, lane = tid & 63, fr = lane & 15, fq = lane >> 4;
    const bool smp = li >= 256;
    const int b = smp ? li - 256 : li >> 6, c = smp ? 0 : li & 63;
    const int row0 = smp ? MP + b * 16 : b * 4096 + c * 64;
    const int T = smp ? 16 : 64, TH = smp ? 16 : 32, nh = smp ? 1 : 2;
    const float* XL = (const float*)(ws + WS_XL); bf16_t* HL = (bf16_t*)(ws + WS_HL); bf16_t* PC = (bf16_t*)(ws + WS_PC);
    LAS float* XC32 = (LAS float*)lds; LAS float* A32 = (LAS float*)(lds + 32768); LAS bf16_t* XCB = (LAS bf16_t*)(lds + 65536);
    const int ch = tid & 255, part = tid >> 8;
    const float cw0 = P.in[24][(l * 4 + 0) * 256 + ch], cw1 = P.in[24][(l * 4 + 1) * 256 + ch], cw2 = P.in[24][(l * 4 + 2) * 256 + ch], cw3 = P.in[24][(l * 4 + 3) * 256 + ch], cb = P.in[25][l * 256 + ch];
    const int blk = wave >> 1, ob = (wave & 1) * 32;
    const bf16_t* WAX = (const bf16_t*)(ws + WS_WAX) + (size_t)l * 2 * 4 * 64 * 64;
    bf16x8 Bw[2][2][2];
#pragma unroll
    for (int gq = 0; gq < 2; ++gq)
#pragma unroll
        for (int ot = 0; ot < 2; ++ot)
#pragma unroll
            for (int ks = 0; ks < 2; ++ks) Bw[gq][ot][ks] = *(const bf16x8*)(WAX + ((size_t)((gq * 4 + blk) * 64 + ob + ot * 16 + fr)) * 64 + ks * 32 + fq * 8);
    float ba[2], bx[2], ls[2];
#pragma unroll
    for (int ot = 0; ot < 2; ++ot) { const int cc = blk * 64 + ob + ot * 16 + fr; ba[ot] = P.in[27][l * 256 + cc]; bx[ot] = P.in[29][l * 256 + cc]; ls[ot] = -log1pf(expf(-P.in[30][l * 256 + cc])); }
    float hl = 0.f, pc = 1.f;
    for (int hf = 0; hf < nh; ++hf) {
        {
            const int tper = TH >> 1, tb = part * tper;
            const int pos0 = (smp ? 0 : c * 64) + hf * 32 + tb;
            const size_t rb = smp ? (size_t)MP + b * 16 : (size_t)b * 4096;
            float xw[19];
#pragma unroll
            for (int i = 0; i < 19; ++i) {
                const int pp = pos0 + i - 3;
                xw[i] = 0.f;
                if (i < tper + 3) {
                    if (pp >= 0) xw[i] = XL[(rb + pp) * 256 + ch];
                    else if (smp) xw[i] = P.in[6][((size_t)((l * 32 + b) * 3 + (pp + 3))) * 256 + ch];
                }
            }
#pragma unroll
            for (int tt = 0; tt < 16; ++tt) {
                if (tt < tper) {
                    const int t = tb + tt;
                    const float a = cb + cw0 * xw[tt] + cw1 * xw[tt + 1] + cw2 * xw[tt + 2] + cw3 * xw[tt + 3];
                    XC32[t * 256 + ch] = a; XCB[t * 264 + ch] = f2bf(a);
                }
            }
        }
        __syncthreads();
#pragma unroll
        for (int tt = 0; tt < 2; ++tt) {
            if (tt * 16 < TH) {
                bf16x8 A[2];
#pragma unroll
                for (int ks = 0; ks < 2; ++ks) A[ks] = *(const LAS bf16x8*)(XCB + (tt * 16 + fr) * 264 + blk * 64 + ks * 32 + fq * 8);
#pragma unroll
                for (int ot = 0; ot < 2; ++ot) {
                    f32x4 ga = (f32x4){0.f, 0.f, 0.f, 0.f}, gx = ga;
#pragma unroll
                    for (int ks = 0; ks < 2; ++ks) { ga = mfma16(A[ks], Bw[0][ot][ks], ga); gx = mfma16(A[ks], Bw[1][ot][ks], gx); }
                    const int cc = blk * 64 + ob + ot * 16 + fr;
#pragma unroll
                    for (int j = 0; j < 4; ++j) {
                        const int t = tt * 16 + fq * 4 + j;
                        const float r = sigmoidf_(ga[j] + ba[ot]), ig = sigmoidf_(gx[j] + bx[ot]);
                        const float la = 8.f * r * ls[ot];
                        const float av = __expf(la), mult = sqrtf(-expm1f(2.f * la));
                        const float xc = XC32[t * 256 + cc];
                        XC32[t * 256 + cc] = mult * ig * xc; A32[t * 256 + cc] = av;
                    }
                }
            }
        }
        __syncthreads();
        if (tid < 256) {
            for (int t = 0; t < TH; ++t) {
                const float av = A32[t * 256 + ch], bt = XC32[t * 256 + ch];
                hl = av * hl + bt; pc = av * pc;
                const size_t r = (size_t)(row0 + hf * 32 + t) * 256 + ch;
                HL[r] = f2bf(hl); PC[r] = f2bf(pc);
            }
        }
        __syncthreads();
    }
    if (tid < 256) {
        if (!smp) { float* ls_ = (float*)(ws + WS_LSUM) + ((size_t)(b * 64 + c) * 2) * 256; ls_[ch] = pc; ls_[256 + ch] = hl; }
        if (smp) { for (int i = 0; i < 3; ++i) P.out[O_CONVS + ((size_t)((l * 32 + b) * 3 + i)) * 256 + ch] = XL[((size_t)(MP + b * 16 + 13 + i)) * 256 + ch]; }
        else if (c == 63) { for (int i = 0; i < 3; ++i) P.out[O_CONVP + ((size_t)((l * 4 + b) * 3 + i)) * 256 + ch] = XL[((size_t)(b * 4096 + 4093 + i)) * 256 + ch]; }
    }
    (void)T;
}

DI void ssma_item(CParams& P, int l, int si, LAS unsigned char* lds, int tid) {
    unsigned char* ws = P.ws;
    const int wave = tid >> 6, lane = tid & 63, fr = lane & 15, fq = lane >> 4;
    const int b = si >> 6, c = si & 63, row0 = b * 4096 + c * 64;
    const bf16_t* Y = (const bf16_t*)(ws + WS_Y);
    LAS float* XW = (LAS float*)lds + wave * (32 * 132);
#pragma unroll 1
    for (int gi = 0; gi < 2; ++gi) {
        const int g = wave * 2 + gi;
        const f32x4 lb4 = *(const f32x4*)((const float*)(ws + WS_SPAR + (size_t)l * SZ_SPAR) + (size_t)(g * 64 + lane) * 4);
        const f32x2 lb = (f32x2){lb4[0], lb4[1]};
        bf16x8 Bf[8];
        const bf16_t* bbf = (const bf16_t*)(ws + WS_BBF) + ((size_t)((l * 16 + g) * 128 + fr)) * 32 + fq * 8;
#pragma unroll
        for (int nt = 0; nt < 8; ++nt) Bf[nt] = *(const bf16x8*)(bbf + (size_t)nt * 16 * 32);
        bf16x8 Af[4];
#pragma unroll
        for (int mt = 0; mt < 4; ++mt) { Af[mt] = (bf16x8){0, 0, 0, 0, 0, 0, 0, 0}; if (fq < 2) Af[mt] = *(const bf16x8*)(Y + (size_t)(row0 + mt * 16 + fr) * 1024 + g * 16 + fq * 8); }
        f32x2 H = (f32x2){0.f, 0.f};
#pragma unroll
        for (int hf = 0; hf < 2; ++hf) {
#pragma unroll
            for (int m2 = 0; m2 < 2; ++m2)
#pragma unroll
                for (int nt = 0; nt < 8; ++nt) {
                    const f32x4 a = mfma16(Af[hf * 2 + m2], Bf[nt], (f32x4){0.f, 0.f, 0.f, 0.f});
#pragma unroll
                    for (int jj = 0; jj < 4; ++jj) XW[(m2 * 16 + fq * 4 + jj) * 132 + nt * 16 + fr] = a[jj];
                }
            lds_fence();
#pragma unroll 8
            for (int t = 0; t < 32; ++t) { const f32x2 x = (f32x2){XW[t * 132 + lane], XW[t * 132 + 64 + lane]}; H = cmul(lb, H) + x; }
            lds_fence();
        }
        *(f32x2*)((float*)(ws + WS_SSUM) + ((size_t)((b * 64 + c) * 16 + g) * 64 + lane) * 2) = H;
    }
    __syncthreads();
}

DI void m1_phase(CParams& P, int l, LAS unsigned char* lds, const int tid, bf16_t* Yw, const int bid, const int nb, const int id_lo = 0, const int id_hi = 832) {
    const int wave = tid >> 6, lane = tid & 63;
    for (int id = id_lo + bid; id < id_hi; id += nb) {
        int t2 = tid; asm volatile("" : "+v"(t2));
        if (id < 256) ssma_item(P, l, id, lds, t2);
        else if (id < 544) lru_item(P, l, id - 256, lds, t2);
        else attn_chunk_item(P, l, id - 544, lds, t2, Yw);
    }
}
DI void m2_item(CParams& P, int l, int id, LAS unsigned char* lds, int tid, bf16_t* Yw) {
    unsigned char* ws = P.ws;
    const int wave = tid >> 6, lane = tid & 63, fr = lane & 15, fq = lane >> 4;
    const bool smp = id >= 256;
    const int b = smp ? id - 256 : id >> 6, c = smp ? 0 : id & 63;
    const int row0 = smp ? MP + b * 16 : b * 4096 + c * 64;
    const int T = smp ? 16 : 64, ntb = T >> 4;
    const bool lastc = smp || c == 63;
    bf16_t* Y = (bf16_t*)(ws + WS_Y);
    LAS float* XW = (LAS float*)lds + wave * (16 * 132);
    LAS bf16_t* Z = (LAS bf16_t*)(lds + 67584);
    LAS bf16_t* HS = (LAS bf16_t*)(lds + 67584 + 33792) + wave * (16 * 136);
    LAS float* RED = (LAS float*)(lds + 67584 + 33792 + 34816);
    f32x2 Hc0, Hc1; f32x4 lbq0, lbq1;
#pragma unroll
    for (int gi = 0; gi < 2; ++gi) {
        const int g = wave * 2 + gi;
        const f32x4 lb4 = *(const f32x4*)((const float*)(ws + WS_SPAR + (size_t)l * SZ_SPAR) + (unsigned)(g * 64 + lane) * 4u);
        if (gi) lbq1 = lb4; else lbq0 = lb4;
        const f32x2 lb64 = (f32x2){lb4[2], lb4[3]};
        f32x2 H = (f32x2){0.f, 0.f};
        if (smp) { const size_t si = ((size_t)((l * 32 + b) * 16 + g)) * 64 + lane; H = (f32x2){P.in[4][si], P.in[5][si]}; }
        else {
            const float* sp = (const float*)(ws + WS_SSUM) + ((size_t)((b * 64) * 16 + g) * 64 + lane) * 2;
            for (int j0 = 0; j0 < c; j0 += 8) {
                f32x2 S[8];
#pragma unroll
                for (int k = 0; k < 8; ++k) { const int jj = (j0 + k < c) ? j0 + k : c - 1; S[k] = *(const f32x2*)(sp + (unsigned)jj * 2048u); }
#pragma unroll
                for (int k = 0; k < 8; ++k) if (j0 + k < c) H = cmul(lb64, H) + S[k];
            }
        }
        if (gi) Hc1 = H; else Hc0 = H;
    }
    {
        const bf16_t* HL = (const bf16_t*)(ws + WS_HL); const bf16_t* PC = (const bf16_t*)(ws + WS_PC);
        f32x4 Hin = (f32x4){0.f, 0.f, 0.f, 0.f};
        if (smp) Hin = *(const f32x4*)(P.in[7] + (size_t)(l * 32 + b) * 256 + lane * 4);
        else {
            const float* lsum = (const float*)(ws + WS_LSUM) + (size_t)(b * 64) * 2 * 256 + lane * 4;
            for (int j0 = 0; j0 < c; j0 += 4) {
                f32x4 A[4], S[4];
#pragma unroll
                for (int k = 0; k < 4; ++k) { const int jj = (j0 + k < c) ? j0 + k : c - 1; A[k] = *(const f32x4*)(lsum + (unsigned)jj * 512u); S[k] = *(const f32x4*)(lsum + (unsigned)jj * 512u + 256); }
#pragma unroll
                for (int k = 0; k < 4; ++k) if (j0 + k < c) Hin = A[k] * Hin + S[k];
            }
        }
        for (int t0 = wave; t0 < T; t0 += 32) {
            f32x4 hl[4], pc[4]; u32x2 gw[4];
#pragma unroll
            for (int q = 0; q < 4; ++q) {
                const int t = (t0 + 8 * q < T) ? t0 + 8 * q : t0; const size_t row = row0 + t;
                const u32x2 hw = *(const u32x2*)(HL + row * 256 + lane * 4), pw = *(const u32x2*)(PC + row * 256 + lane * 4);
                hl[q][0] = __uint_as_float(hw.x << 16); hl[q][1] = __uint_as_float(hw.x & 0xffff0000u); hl[q][2] = __uint_as_float(hw.y << 16); hl[q][3] = __uint_as_float(hw.y & 0xffff0000u);
                pc[q][0] = __uint_as_float(pw.x << 16); pc[q][1] = __uint_as_float(pw.x & 0xffff0000u); pc[q][2] = __uint_as_float(pw.y << 16); pc[q][3] = __uint_as_float(pw.y & 0xffff0000u);
                gw[q] = *(const u32x2*)(Y + row * 1024 + 768 + lane * 4);
            }
#pragma unroll
            for (int q = 0; q < 4; ++q) {
                const int t = t0 + 8 * q;
                if (t < T) {
                    const size_t row = row0 + t;
                    const f32x4 h = hl[q] + pc[q] * Hin;
                    f32x4 gl; gl[0] = __uint_as_float(gw[q].x << 16); gl[1] = __uint_as_float(gw[q].x & 0xffff0000u); gl[2] = __uint_as_float(gw[q].y << 16); gl[3] = __uint_as_float(gw[q].y & 0xffff0000u);
                    f32x4 yl; float s = 0.f;
#pragma unroll
                    for (int jj = 0; jj < 4; ++jj) { yl[jj] = gelu_tanh(gl[jj]) * h[jj]; s += yl[jj] * yl[jj]; }
#pragma unroll
                    for (int o = 1; o < 64; o <<= 1) s += __shfl_xor(s, o);
                    const float rs = rsqrtf(s * (1.f / 256.f) + EPS);
                    u32x2 w; w.x = cvt_pk_bf16(yl[0] * rs, yl[1] * rs); w.y = cvt_pk_bf16(yl[2] * rs, yl[3] * rs);
                    *(u32x2*)(Yw + row * 1024 + 768 + lane * 4) = w;
                    if (lastc && t == T - 1) *(f32x4*)(P.out + (smp ? O_LRUS + (size_t)(l * 32 + b) * 256 : O_LRUP + (size_t)(l * 4 + b) * 256) + lane * 4) = h;
                }
            }
        }
    }
    __syncthreads();
#pragma unroll 1
    for (int gi = 0; gi < 2; ++gi) {
        const int g = wave * 2 + gi;
        const f32x4 lb4 = gi ? lbq1 : lbq0;
        const f32x2 lb = (f32x2){lb4[0], lb4[1]};
        bf16x8 Bf[8];
        const bf16_t* bbf = (const bf16_t*)(ws + WS_BBF) + ((size_t)((l * 16 + g) * 128 + fr)) * 32 + fq * 8;
#pragma unroll
        for (int nt = 0; nt < 8; ++nt) Bf[nt] = *(const bf16x8*)(bbf + (size_t)nt * 16 * 32);
        bf16x8 Af[4];
#pragma unroll
        for (int mt = 0; mt < 4; ++mt) { Af[mt] = (bf16x8){0, 0, 0, 0, 0, 0, 0, 0}; if (fq < 2 && mt < ntb) Af[mt] = *(const bf16x8*)(Y + (size_t)(row0 + mt * 16 + fr) * 1024 + g * 16 + fq * 8); }
        float usk[4][4];
#pragma unroll
        for (int mt = 0; mt < 4; ++mt)
#pragma unroll
            for (int jj = 0; jj < 4; ++jj) usk[mt][jj] = (mt < ntb) ? bf2f(Y[(size_t)(row0 + mt * 16 + fq * 4 + jj) * 1024 + g * 16 + fr]) : 0.f;
        bf16x8 Cw[4];
        const bf16_t* ccp = (const bf16_t*)(ws + WS_CC) + ((size_t)((l * 16 + g) * 16 + fr)) * 128 + fq * 8;
#pragma unroll
        for (int ks = 0; ks < 4; ++ks) Cw[ks] = *(const bf16x8*)(ccp + ks * 32);
        const float dsk = P.in[21][l * 256 + g * 16 + fr];
        f32x2 H = gi ? Hc1 : Hc0;
#pragma unroll
        for (int tb = 0; tb < 4; ++tb) {
            if (tb < ntb) {
#pragma unroll
                for (int nt = 0; nt < 8; ++nt) {
                    const f32x4 a = mfma16(Af[tb], Bf[nt], (f32x4){0.f, 0.f, 0.f, 0.f});
#pragma unroll
                    for (int jj = 0; jj < 4; ++jj) XW[(fq * 4 + jj) * 132 + nt * 16 + fr] = a[jj];
                }
                lds_fence();
#pragma unroll
                for (int tt = 0; tt < 16; ++tt) {
                    const f32x2 x = (f32x2){XW[tt * 132 + lane], XW[tt * 132 + 64 + lane]};
                    H = cmul(lb, H) + x;
                    const unsigned pk = cvt_pk_bf16(H.x, H.y);
                    HS[tt * 136 + lane] = (bf16_t)(pk & 0xffffu); HS[tt * 136 + 64 + lane] = (bf16_t)(pk >> 16);
                }
                lds_fence();
                f32x4 acc = (f32x4){0.f, 0.f, 0.f, 0.f};
#pragma unroll
                for (int ks = 0; ks < 4; ++ks) { const bf16x8 A = *(const LAS bf16x8*)(HS + fr * 136 + ks * 32 + fq * 8); acc = mfma16(A, Cw[ks], acc); }
#pragma unroll
                for (int jj = 0; jj < 4; ++jj) {
                    const int t = tb * 16 + fq * 4 + jj;
                    const float yv = acc[jj] + dsk * usk[tb][jj];
                    Z[t * 264 + g * 16 + fr] = f2bf(gelu_tanh(yv));
                }
                lds_fence();
            }
        }
        if (lastc) {
            const size_t so = smp ? ((size_t)((l * 32 + b) * 16 + g)) * 64 + lane : ((size_t)((l * 4 + b) * 16 + g)) * 64 + lane;
            P.out[(smp ? O_SRES : O_SREP) + so] = H.x; P.out[(smp ? O_SIMS : O_SIMP) + so] = H.y;
        }
    }
    __syncthreads();
    {
        const bf16_t* WG = (const bf16_t*)(ws + WS_WGLU) + (size_t)l * 65536;
        bf16x8 Bw[2][8];
#pragma unroll
        for (int i = 0; i < 2; ++i)
#pragma unroll
            for (int ks = 0; ks < 8; ++ks) Bw[i][ks] = *(const bf16x8*)(WG + ((size_t)((2 * wave + i) * 16 + fr)) * 256 + ks * 32 + fq * 8);
        float o[4][2][4];
#pragma unroll
        for (int tt = 0; tt < 4; ++tt) {
            if (tt < ntb) {
                f32x4 a0 = (f32x4){0.f, 0.f, 0.f, 0.f}, a1 = a0;
#pragma unroll
                for (int ks = 0; ks < 8; ++ks) { const bf16x8 A = *(const LAS bf16x8*)(Z + (tt * 16 + fr) * 264 + ks * 32 + fq * 8); a0 = mfma16(A, Bw[0][ks], a0); a1 = mfma16(A, Bw[1][ks], a1); }
#pragma unroll
                for (int j = 0; j < 4; ++j) {
                    const int t = tt * 16 + fq * 4 + j;
                    const float z0 = bf2f(Z[t * 264 + (2 * wave) * 16 + fr]), z1 = bf2f(Z[t * 264 + (2 * wave + 1) * 16 + fr]);
                    const float o0 = z0 * sigmoidf_(a0[j]), o1 = z1 * sigmoidf_(a1[j]);
                    o[tt][0][j] = o0; o[tt][1][j] = o1;
                    float s = o0 * o0 + o1 * o1;
                    s += __shfl_xor(s, 1); s += __shfl_xor(s, 2); s += __shfl_xor(s, 4); s += __shfl_xor(s, 8);
                    if (fr == 0) RED[wave * 64 + t] = s;
                }
            }
        }
        __syncthreads();
#pragma unroll
        for (int tt = 0; tt < 4; ++tt) {
            if (tt < ntb) {
#pragma unroll
                for (int j = 0; j < 4; ++j) {
                    const int t = tt * 16 + fq * 4 + j;
                    float tot = 0.f;
#pragma unroll
                    for (int w = 0; w < 8; ++w) tot += RED[w * 64 + t];
                    const float rs = rsqrtf(tot * (1.f / 256.f) + EPS);
                    bf16_t* yp = Yw + (size_t)(row0 + t) * 1024 + (2 * wave) * 16 + fr;
                    yp[0] = f2bf(o[tt][0][j] * rs); yp[16] = f2bf(o[tt][1][j] * rs);
                }
            }
        }
    }
    __syncthreads();
}
DI void m2_phase(CParams& P, int l, LAS unsigned char* lds, const int tid, bf16_t* Yw, const int bid, const int nb) {
    if (nb == 256) {
        { int t2 = tid; asm volatile("" : "+v"(t2)); m2_item(P, l, bid, lds, t2, Yw); }
        if ((bid & 63) < 8) { int t2 = tid; asm volatile("" : "+v"(t2)); m2_item(P, l, 256 + (bid >> 6) * 8 + (bid & 7), lds, t2, Yw); }
    } else
    for (int id = bid; id < 288; id += nb) { int t2 = tid; asm volatile("" : "+v"(t2)); m2_item(P, l, id, lds, t2, Yw); }
}

DI void final_phase(CParams& P, const int tid, const int bid, const int nb) {
    const int lane = tid & 63, wave = tid >> 6;
    const float* ss = (const float*)(P.ws + WS_SS);
    const float* g = P.in[37];
    f32x4 gv[4];
#pragma unroll
    for (int i = 0; i < 4; ++i) gv[i] = *(const f32x4*)(g + i * 256 + lane * 4);
    const bf16_t* xb = (const bf16_t*)(P.ws + WS_XB);
    for (int row = bid * 8 + wave; row < MT; row += nb * 8) {
        const float rs = row_rstd(ss, row, 1.f / 1024.f);
        float* x = P.out + (size_t)row * 1024;
        u32x2 w[4];
#pragma unroll
        for (int i = 0; i < 4; ++i) w[i] = *(const u32x2*)(xb + (size_t)row * 1024 + i * 256 + lane * 4);
#pragma unroll
        for (int i = 0; i < 4; ++i) { f32x4 v; v[0] = __uint_as_float(w[i].x << 16); v[1] = __uint_as_float(w[i].x & 0xffff0000u); v[2] = __uint_as_float(w[i].y << 16); v[3] = __uint_as_float(w[i].y & 0xffff0000u);
            v = v * rs * gv[i]; *(f32x4*)(x + i * 256 + lane * 4) = v; }
    }
}


template <int K>
DI void sgemm_resid(const bf16_t* A  , const bf16_t* Bt  , const float* xin  , bf16_t* xb, float* ss  , float scale, bool first,
                    LAS unsigned char* lds, const int tid, const int bid, const int nb) {
    const int wave = tid >> 6, lane = tid & 63, fr = lane & 15, fq = lane >> 4;
    constexpr int KW = K / 8, NS = KW / 32;
    LAS float* PART = (LAS float*)lds;
    for (int it = bid; it < 256; it += nb) {
        const int r0 = (it >> 4) * 32, c0 = (it & 15) * 64, k0 = wave * KW;
        f32x4 acc[2][4];
#pragma unroll
        for (int i = 0; i < 2; ++i)
#pragma unroll
            for (int j = 0; j < 4; ++j) acc[i][j] = (f32x4){0.f, 0.f, 0.f, 0.f};
        const bf16_t* ap = A + (size_t)(r0 + fr) * K + k0 + fq * 8;
        const bf16_t* bp = Bt + (size_t)(c0 + fr) * K + k0 + fq * 8;
#pragma unroll
        for (int kb = 0; kb < NS; kb += 4) {
            bf16x8 a[4][2], b[4][4];
#pragma unroll
            for (int s4 = 0; s4 < 4; ++s4) {
                if (kb + s4 < NS) {
#pragma unroll
                    for (int i = 0; i < 2; ++i) a[s4][i] = *(const bf16x8*)(ap + (size_t)i * 16 * K + (kb + s4) * 32);
#pragma unroll
                    for (int j = 0; j < 4; ++j) b[s4][j] = *(const bf16x8*)(bp + (size_t)j * 16 * K + (kb + s4) * 32);
                }
            }
            __builtin_amdgcn_sched_barrier(0);
#pragma unroll
            for (int s4 = 0; s4 < 4; ++s4) {
                if (kb + s4 < NS) {
#pragma unroll
                    for (int i = 0; i < 2; ++i)
#pragma unroll
                        for (int j = 0; j < 4; ++j) acc[i][j] = mfma16(b[s4][j], a[s4][i], acc[i][j]);
                }
            }
            __builtin_amdgcn_sched_barrier(0);
        }
#pragma unroll
        for (int i = 0; i < 2; ++i)
#pragma unroll
            for (int j = 0; j < 4; ++j) *(LAS f32x4*)(PART + wave * 2048 + (i * 16 + fr) * 64 + j * 16 + fq * 4) = acc[i][j];
        __syncthreads();
        {
            const int row = tid >> 4, c4 = (tid & 15) * 4;
            f32x4 sum = *(const LAS f32x4*)(PART + row * 64 + c4);
#pragma unroll
            for (int w = 1; w < 8; ++w) sum += *(const LAS f32x4*)(PART + w * 2048 + row * 64 + c4);
            const size_t off = (size_t)(r0 + row) * 1024 + c0 + c4;
            f32x4 xo;
            if (first) xo = *(const f32x4*)(xin + off);
            else { const u32x2 o = *(const u32x2*)(xb + off); xo[0] = __uint_as_float(o.x << 16); xo[1] = __uint_as_float(o.x & 0xffff0000u); xo[2] = __uint_as_float(o.y << 16); xo[3] = __uint_as_float(o.y & 0xffff0000u); }
            const f32x4 v = xo + sum * scale;
            u32x2 pk; pk.x = cvt_pk_bf16(v[0], v[1]); pk.y = cvt_pk_bf16(v[2], v[3]);
            *(u32x2*)(xb + off) = pk;
            float sq = (v[0] * v[0] + v[1] * v[1]) + (v[2] * v[2] + v[3] * v[3]);
            sq += __shfl_xor(sq, 1); sq += __shfl_xor(sq, 2); sq += __shfl_xor(sq, 4); sq += __shfl_xor(sq, 8);
            if ((tid & 15) == 0) ss[(size_t)(r0 + row) * 16 + (it & 15)] = sq;
        }
        __syncthreads();
    }
}

__global__ void __launch_bounds__(NTHR) hymba_fwd(Params Pa) {
    extern __shared__ __attribute__((aligned(16))) unsigned char lds_raw[];
    LAS unsigned char* lds = (LAS unsigned char*)lds_raw;
    cg::grid_group grid = cg::this_grid();
    volatile LAS unsigned* xb_st = (volatile LAS unsigned*)((LAS unsigned char*)lds_raw + LDS_BYTES - 16);
    const int wv = __builtin_amdgcn_readfirstlane((int)(threadIdx.x >> 6));
    if (threadIdx.x == 0) { xb_st[0] = 0u; xb_st[1] = 0u; }
    __syncthreads();
    const XcdBarrier xbar = xcd_barrier_post((unsigned*)(Pa.ws + WS_BAR), xb_st);
    const int ph_lo = Pa.ph_lo, ph_hi = Pa.ph_hi;
    for (int ph = ph_lo; ph < ph_hi; ++ph) {
        CParams* Pk = (CParams*)__builtin_amdgcn_kernarg_segment_ptr();
        asm volatile("" : "+s"(Pk));
        CParams& P = *Pk;
        int wvl_ = wv; asm volatile("" : "+s"(wvl_));
        int tid = wvl_ * 64 + (int)__builtin_amdgcn_mbcnt_hi(~0u, __builtin_amdgcn_mbcnt_lo(~0u, 0u)); asm volatile("" : "+v"(tid));
        int bid = blockIdx.x, nb = gridDim.x; asm volatile("" : "+s"(bid), "+s"(nb));
        unsigned char* ws = P.ws;
        bf16_t* XB = (bf16_t*)(ws + WS_XB); bf16_t* Y = (bf16_t*)(ws + WS_Y); bf16_t* ACT = (bf16_t*)(ws + WS_BIG);
        float* SS = (float*)(ws + WS_SS);
        if (ph == 0) { prep_phase(P, lds, tid, bid, nb); if (DUP & 1) { grid.sync(); prep_phase(P, lds, tid, bid, nb); } }
        else if (ph == 17) final_phase(P, tid, bid, nb);
        else {
            const int l = (ph - 1) >> 3, s = (ph - 1) & 7;
            if (s == 0 || s == 6) {
                const int f = s == 6;
                pg8::Gemm g{XB, (const bf16_t*)(ws + WS_WGU + (size_t)(l * 2 + f) * SZ_WGU), MT, 5632, 1024};
                pg8::StaticOrder S; S.init(MT, 5632, nb, bid);
                EpiGateUp E{ACT, SS};
                pg8::gemm_phase<EpiGateUp, pg8::StaticOrder, GEMM_ALIGN, GEMM_SP2>(lds, g, S, E, tid);
                if (l == 0) {
                    const int rounds = (1452 + nb - 1) / nb, b0 = 1452 - (rounds - 1) * nb;
                    const int t0 = f ? 2432 + 1216 : 704, t1 = f ? 4864 : 2432;
                    if (b0 < nb) { if (bid >= b0) convert_tiles(P, lds, tid, bid - b0, nb - b0, t0, t1); }
                    else convert_tiles(P, lds, tid, bid, nb, t0, t1);
                }
            } else if (s == 1 || s == 7) {
                const int f = s == 7;
                const bf16_t* Wd = (const bf16_t*)(ws + WS_WD + (size_t)(l * 2 + f) * SZ_WD);
                pg8::Gemm g{ACT, Wd, MP, 1024, 2816};
                pg8::StaticOrder S; S.init(MP, 1024, nb, bid);
                const bool first = false;
                EpiResid E{P.in[0], XB, SS, 0.5f, first};
                pg8::gemm_phase<EpiResid, pg8::StaticOrder, GEMM_ALIGN, GEMM_SP2>(lds, g, S, E, tid);
                sgemm_resid<2816>(ACT + (size_t)MP * DFF, Wd, P.in[1], XB + (size_t)MP * 1024, SS + (size_t)MP * 16, 0.5f, first, lds, tid, bid, nb);
            } else if (s == 2) {
                pg8::Gemm g{XB, (const bf16_t*)(ws + WS_WIN + (size_t)l * SZ_WIN), MT, 1536, 1024};
                pg8::StaticOrder S; S.init(MT, 1536, nb, bid);
                EpiProj E{SS, Y, (float*)(ws + WS_XL), (bf16_t*)(ws + WS_KBP), (bf16_t*)(ws + WS_VTP),
                          (bf16_t*)(ws + WS_KBS + (size_t)l * SZ_KBS), (bf16_t*)(ws + WS_VTS + (size_t)l * SZ_KBS),
                          P.out + O_KP + (size_t)l * 4 * 128 * 128, P.out + O_VP + (size_t)l * 4 * 128 * 128, P.out + O_KS + (size_t)l * 32 * 16 * 128, P.out + O_VS + (size_t)l * 32 * 16 * 128};
                pg8::gemm_phase<EpiProj, pg8::StaticOrder, GEMM_ALIGN, GEMM_SP2>(lds, g, S, E, tid);
                if (l == 0) {
                    const int rounds = (396 + nb - 1) / nb, b0 = 396 - (rounds - 1) * nb;
                    if (b0 < nb) { if (bid >= b0) convert_tiles(P, lds, tid, bid - b0, nb - b0, 2432, 2432 + 1216); }
                    else convert_tiles(P, lds, tid, bid, nb, 2432, 2432 + 1216);
                }
            } else if (s == 3) { if (DUP & (2 | 32 | 64 | 128)) { m1_phase(P, l, lds, tid, XB, bid, nb, (DUP & 2) ? 0 : (DUP & 32) ? 0 : (DUP & 64) ? 256 : 544, (DUP & 2) ? 832 : (DUP & 32) ? 256 : (DUP & 64) ? 544 : 832); grid.sync(); } m1_phase(P, l, lds, tid, Y, bid, nb); }
            else if (s == 4) { if (DUP & 4) { m2_phase(P, l, lds, tid, XB, bid, nb); grid.sync(); } m2_phase(P, l, lds, tid, Y, bid, nb); }
            else {
                const bf16_t* Wo = (const bf16_t*)(ws + WS_WOUT + (size_t)l * SZ_WOUT);
                pg8::Gemm g{Y, Wo, MP, 1024, 1024};
                pg8::StaticOrder S; S.init(MP, 1024, nb, bid);
                EpiResid E{P.in[0], XB, SS, 1.0f, false};
                pg8::gemm_phase<EpiResid, pg8::StaticOrder, GEMM_ALIGN, GEMM_SP2>(lds, g, S, E, tid);
                sgemm_resid<1024>(Y + (size_t)MP * 1024, Wo, P.in[1], XB + (size_t)MP * 1024, SS + (size_t)MP * 16, 1.0f, false, lds, tid, bid, nb);
            }
        }
        if (ph + 1 < ph_hi) { if (ph_hi == 0x7fff) grid.sync(); else xcd_barrier(xbar, tid == 0); }
    }
}

#ifndef DUP
#define DUP 0
#endif
#ifndef N_PHASE_LAUNCH
#define N_PHASE_LAUNCH 0
#endif
extern "C" void kernel_launch(void* const* d_in, const int* in_sizes, int n_in, void* d_out, int out_size, void* d_ws, size_t ws_size, hipStream_t stream) {
    static int grid_blocks = 0;
    if (!grid_blocks) {
        int dev = 0, cus = 0, per_cu = 0;
        hipGetDevice(&dev);
        hipDeviceGetAttribute(&cus, hipDeviceAttributeMultiprocessorCount, dev);
        if (hipFuncSetAttribute((const void*)hymba_fwd, hipFuncAttributeMaxDynamicSharedMemorySize, LDS_BYTES) != hipSuccess) fprintf(stderr, "hipFuncSetAttribute failed\n");
        if (hipOccupancyMaxActiveBlocksPerMultiprocessor(&per_cu, (const void*)hymba_fwd, NTHR, LDS_BYTES) != hipSuccess || per_cu < 1) { fprintf(stderr, "occupancy query: %d\n", per_cu); per_cu = 1; }
        (void)hipGetLastError();
        if (per_cu > 1) per_cu = 1;
        grid_blocks = cus * per_cu;
        if (n_in != 38 || (size_t)out_size != O_END || ws_size < WS_END) fprintf(stderr, "kernel_launch: unexpected sizes n_in %d out %d ws %zu\n", n_in, out_size, ws_size);
    }
    if (hipMemsetAsync((unsigned char*)d_ws + WS_BAR, 0, (size_t)XCD_BAR_WORDS * 4, stream) != hipSuccess) fprintf(stderr, "memset of barrier words failed\n");
    Params p{};
    for (int i = 0; i < 38; ++i) p.in[i] = (const float*)d_in[i];
    p.out = (float*)d_out; p.ws = (unsigned char*)d_ws;
#if N_PHASE_LAUNCH
    for (int ph = 0; ph < 18; ++ph) { p.ph_lo = ph; p.ph_hi = ph + 1; hipLaunchKernelGGL(hymba_fwd, dim3(grid_blocks), dim3(NTHR), LDS_BYTES, stream, p); }
#else
    p.ph_lo = 0; p.ph_hi = 18;
    void* args[] = {&p};
    hipError_t e = hipLaunchCooperativeKernel((const void*)hymba_fwd, dim3(grid_blocks), dim3(NTHR), args, LDS_BYTES, stream);
    if (e != hipSuccess) fprintf(stderr, "cooperative launch failed: %s (grid %d)\n", hipGetErrorString(e), grid_blocks);
#endif
}
```

```cpp
#include <hip/hip_runtime.h>
#include <hip/hip_cooperative_groups.h>
#include <cstdio>
namespace cg = cooperative_groups;
namespace pg8 {
#define PG8_LAS __attribute__((address_space(3)))
typedef unsigned short bf16_t;
typedef short bf16x8 __attribute__((ext_vector_type(8)));
typedef float f32x4 __attribute__((ext_vector_type(4)));
typedef unsigned u32x4 __attribute__((ext_vector_type(4)));
constexpr int BM = 256, BK = 64, HALF = 128, HTB = HALF * BK * 2  , STAGE_BYTES = 8 * HTB, NXCD = 8, WGM = 8;

__host__ __device__ __forceinline__ int lds_byte(int r, int c) { const int st = (r >> 4) * 2 + (c >> 5), rr = r & 15, cc = c & 31, ob = rr * 64 + cc * 2; return st * 1024 + (ob ^ (((ob >> 9) & 1) << 5)); }
__host__ __device__ __forceinline__ void stage_rc(int b, int& R, int& C) { const int st = b / 1024, sb = b % 1024, swz = sb ^ (((sb >> 9) & 1) << 5); R = (st >> 1) * 16 + swz / 64; C = (st & 1) * 32 + (swz % 64) / 2; }
__host__ __device__ __forceinline__ int perm32(int rho) { const int n = rho >> 4, i = rho & 15; return 8 * (i >> 2) + 4 * n + (i & 3); }

struct Unit { int pm, pn; };
struct Gemm { const bf16_t* A; const bf16_t* Bt; int M, N, K; };

struct StaticOrder {
    int nM, nN, nwg, G, c;
    __host__ __device__ void init(int M, int N, int G_, int c_) { nM = M / BM; nN = N / BM; nwg = nM * nN; G = G_; c = c_; }
    __host__ __device__ bool next(int i, Unit& u) const {
        const long L = (long)i * G + c; if (L >= nwg) return false;
        int wgid = (int)L; { const int q = nwg / NXCD, r = nwg % NXCD, xcd = wgid % NXCD, off = wgid / NXCD; wgid = (xcd < r ? xcd * (q + 1) : r * (q + 1) + (xcd - r) * q) + off; }
        const int nig = WGM * nN, gid = wgid / nig, fm = gid * WGM, gsz = (nM - fm) < WGM ? (nM - fm) : WGM;
        u.pm = fm + ((wgid % nig) % gsz); u.pn = (wgid % nig) / gsz; return true;
    }
    __device__ __forceinline__ void a_ready(const Unit&) const {}
    __device__ __forceinline__ void done(const Unit&) const {}
};
__device__ __forceinline__ unsigned cvt_pk_bf16(float lo, float hi) { unsigned r; asm volatile("v_cvt_pk_bf16_f32 %0, %1, %2" : "=v"(r) : "v"(lo), "v"(hi)); return r; }
typedef float f32x2 __attribute__((ext_vector_type(2)));
template <class Epi, class Sched, bool ALIGN_EPI = false, bool SP2 = false>
__device__ __forceinline__ void gemm_phase(PG8_LAS unsigned char* lds, const Gemm g, const Sched& S, const Epi& E, const int tid) {
    const int wid = __builtin_amdgcn_readfirstlane(tid >> 6), lane = tid & 63, wr = wid >> 2, wc = wid & 3, fr = lane & 15, fq = lane >> 4;
    const int K = g.K, nt = K / BK;
    unsigned voffA[2], voffB[2];
#pragma unroll
    for (int i = 0; i < 2; ++i) { int R, C; stage_rc(tid * 16 + i * 8192, R, C); const int Rb = Epi::PERM ? ((R & ~31) + perm32(R & 31)) : R;
        voffA[i] = (unsigned)(R * K + C) * 2u; voffB[i] = (unsigned)(Rb * K + C) * 2u; }
    const size_t kstep = (size_t)(BK * 2);
    const size_t hstep = (size_t)HALF * K * 2;
    const size_t tstep = 2 * hstep;
    const unsigned ldsw = (unsigned)wid * 1024u;
    const int aoff = lds_byte(wr * 64 + fr, fq * 8), boff = lds_byte(wc * 32 + fr, fq * 8);
#define PG8_SA(b, h) (((b) * 2 + (h)) * HTB)
#define PG8_SB(b, h) ((4 + (b) * 2 + (h)) * HTB)
#define PG8_STAGE(bufoff, gbase, voff) do { _Pragma("unroll") for (int _i = 0; _i < 2; ++_i) \
        __builtin_amdgcn_global_load_lds((const unsigned*)((const char*)(gbase) + (voff)[_i]), (PG8_LAS unsigned*)(lds + (bufoff) + ldsw + _i * 8192), 16, 0, 0); } while (0)
#define PG8_LDA(dst, b, h) do { _Pragma("unroll") for (int m = 0; m < 4; ++m) _Pragma("unroll") for (int k = 0; k < 2; ++k) dst[m][k] = *(const PG8_LAS bf16x8*)(lds + PG8_SA(b, h) + aoff + m * 2048 + k * 1024); } while (0)
#define PG8_LDB(dst, b, h) do { _Pragma("unroll") for (int n = 0; n < 2; ++n) _Pragma("unroll") for (int k = 0; k < 2; ++k) dst[n][k] = *(const PG8_LAS bf16x8*)(lds + PG8_SB(b, h) + boff + n * 2048 + k * 1024); } while (0)
#define PG8_MMA(ai, bj, At, Bt) do { __builtin_amdgcn_s_setprio(1); _Pragma("unroll") for (int m = 0; m < 4; ++m) _Pragma("unroll") for (int n = 0; n < 2; ++n) _Pragma("unroll") for (int k = 0; k < 2; ++k) \
        acc[ai][bj][m][n] = __builtin_amdgcn_mfma_f32_16x16x32_bf16(Bt[n][k], At[m][k], acc[ai][bj][m][n], 0, 0, 0); __builtin_amdgcn_s_setprio(0); } while (0)
#define PG8_WAIT_V(n) asm volatile("s_waitcnt vmcnt(" #n ")" ::: "memory")
#define PG8_WAIT_L(n) asm volatile("s_waitcnt lgkmcnt(" #n ")" ::: "memory")
#define PG8_BAR __builtin_amdgcn_s_barrier()
#define PG8_SCHED __builtin_amdgcn_sched_barrier(0)
    Unit cur, nxt; int ui = 0;
    if (!S.next(0, cur)) return;
    f32x4 acc[2][2][4][2];
#pragma unroll
    for (int a = 0; a < 2; ++a)
#pragma unroll
        for (int b = 0; b < 2; ++b)
#pragma unroll
            for (int m = 0; m < 4; ++m)
#pragma unroll
                for (int n = 0; n < 2; ++n) acc[a][b][m][n] = (f32x4){0.f, 0.f, 0.f, 0.f};
    bf16x8 At[4][2], B0[2][2], B1[2][2];
    const char* cA = (const char*)g.A + (size_t)cur.pm * tstep; const char* cB = (const char*)g.Bt + (size_t)cur.pn * tstep;
    S.a_ready(cur);
    if constexpr (SP2) {
        PG8_STAGE(PG8_SB(0, 0), cB, voffB); PG8_STAGE(PG8_SB(0, 1), cB + hstep, voffB); PG8_STAGE(PG8_SA(0, 0), cA, voffA); PG8_STAGE(PG8_SA(0, 1), cA + hstep, voffA);
        if (wr == 1) PG8_BAR;
        PG8_WAIT_V(2); PG8_BAR;
        PG8_STAGE(PG8_SB(1, 0), cB + kstep, voffB); PG8_STAGE(PG8_SA(1, 0), cA + kstep, voffA); PG8_STAGE(PG8_SB(1, 1), cB + hstep + kstep, voffB);
        PG8_WAIT_V(6); PG8_BAR;
    } else {
        PG8_STAGE(PG8_SB(0, 0), cB, voffB); PG8_STAGE(PG8_SA(0, 0), cA, voffA); PG8_STAGE(PG8_SB(0, 1), cB + hstep, voffB); PG8_STAGE(PG8_SA(0, 1), cA + hstep, voffA);
        if (wr == 1) PG8_BAR;
        PG8_WAIT_V(4); PG8_BAR;
        PG8_STAGE(PG8_SB(1, 0), cB + kstep, voffB); PG8_STAGE(PG8_SA(1, 0), cA + kstep, voffA); PG8_STAGE(PG8_SB(1, 1), cB + hstep + kstep, voffB);
        PG8_WAIT_V(6); PG8_BAR;
    }
    for (;;) {
        const bool has_next = S.next(ui + 1, nxt);
        const char* nA = has_next ? (const char*)g.A + (size_t)nxt.pm * tstep : cA; const char* nB = has_next ? (const char*)g.Bt + (size_t)nxt.pn * tstep : cB;
        for (int t = 0; t < nt; t += 2) {
            const bool last = (t == nt - 2);
            const char* a1 = cA + (size_t)(t + 1) * kstep;
            const char* a2 = last ? nA : cA + (size_t)(t + 2) * kstep; const char* b2 = last ? nB : cB + (size_t)(t + 2) * kstep;
            const char* a3 = a2 + kstep; const char* b3 = b2 + kstep;
            if (last && has_next) S.a_ready(nxt);
            if constexpr (SP2) {
            PG8_LDB(B0, 0, 0); PG8_LDB(B1, 0, 1); PG8_SCHED; PG8_LDA(At, 0, 0); PG8_STAGE(PG8_SA(1, 1), a1 + hstep, voffA);
            PG8_WAIT_V(8); PG8_WAIT_L(0); PG8_BAR; PG8_MMA(0, 0, At, B0); PG8_MMA(0, 1, At, B1); PG8_BAR; PG8_SCHED;
            PG8_LDA(At, 0, 1); PG8_STAGE(PG8_SB(0, 0), b2, voffB); PG8_STAGE(PG8_SB(0, 1), b2 + hstep, voffB); PG8_STAGE(PG8_SA(0, 0), a2, voffA);
            PG8_WAIT_V(8); PG8_WAIT_L(0); PG8_BAR; PG8_MMA(1, 0, At, B0); PG8_MMA(1, 1, At, B1); PG8_BAR; PG8_SCHED;
            PG8_LDB(B0, 1, 0); PG8_LDB(B1, 1, 1); PG8_SCHED; PG8_LDA(At, 1, 0); PG8_STAGE(PG8_SA(0, 1), a2 + hstep, voffA);
            PG8_WAIT_V(8); PG8_WAIT_L(0); PG8_BAR; PG8_MMA(0, 0, At, B0); PG8_MMA(0, 1, At, B1); PG8_BAR; PG8_SCHED;
            PG8_LDA(At, 1, 1); PG8_STAGE(PG8_SB(1, 0), b3, voffB); PG8_STAGE(PG8_SB(1, 1), b3 + hstep, voffB); PG8_STAGE(PG8_SA(1, 0), a3, voffA);
            PG8_WAIT_V(8); PG8_WAIT_L(0); PG8_BAR; PG8_MMA(1, 0, At, B0); PG8_MMA(1, 1, At, B1); PG8_BAR; PG8_SCHED;
            } else {
            PG8_LDB(B0, 0, 0); PG8_SCHED; PG8_LDA(At, 0, 0); PG8_STAGE(PG8_SA(1, 1), a1 + hstep, voffA);
            PG8_WAIT_L(8); PG8_BAR; PG8_WAIT_L(0); PG8_MMA(0, 0, At, B0); PG8_BAR; PG8_SCHED;
            PG8_LDB(B1, 0, 1); PG8_STAGE(PG8_SB(0, 0), b2, voffB);
            PG8_BAR; PG8_WAIT_L(0); PG8_MMA(0, 1, At, B1); PG8_BAR;
            PG8_LDA(At, 0, 1); PG8_STAGE(PG8_SA(0, 0), a2, voffA);
            PG8_BAR; PG8_WAIT_L(0); PG8_MMA(1, 0, At, B0); PG8_BAR; PG8_SCHED;
            PG8_STAGE(PG8_SB(0, 1), b2 + hstep, voffB);
            PG8_WAIT_V(6); PG8_BAR; PG8_MMA(1, 1, At, B1); PG8_BAR;
            PG8_LDB(B0, 1, 0); PG8_SCHED; PG8_LDA(At, 1, 0); PG8_STAGE(PG8_SA(0, 1), a2 + hstep, voffA);
            PG8_WAIT_L(8); PG8_BAR; PG8_WAIT_L(0); PG8_MMA(0, 0, At, B0); PG8_BAR; PG8_SCHED;
            PG8_LDB(B1, 1, 1); PG8_STAGE(PG8_SB(1, 0), b3, voffB);
            PG8_BAR; PG8_WAIT_L(0); PG8_MMA(0, 1, At, B1); PG8_BAR;
            PG8_LDA(At, 1, 1); PG8_STAGE(PG8_SA(1, 0), a3, voffA);
            PG8_BAR; PG8_WAIT_L(0); PG8_MMA(1, 0, At, B0); PG8_BAR; PG8_SCHED;
            PG8_STAGE(PG8_SB(1, 1), b3 + hstep, voffB);
            PG8_WAIT_V(6); PG8_BAR; PG8_MMA(1, 1, At, B1); PG8_BAR;
            }
        }
        if constexpr (ALIGN_EPI) { if (wr == 0) PG8_BAR; }
        if constexpr (!Epi::AFTER_DRAIN) { E(acc, cur, wr, wc, fr, fq); S.done(cur); }
        if (!has_next) break;
#pragma unroll
        for (int a = 0; a < 2; ++a)
#pragma unroll
            for (int b = 0; b < 2; ++b)
#pragma unroll
                for (int m = 0; m < 4; ++m)
#pragma unroll
                    for (int n = 0; n < 2; ++n) acc[a][b][m][n] = (f32x4){0.f, 0.f, 0.f, 0.f};
        cur = nxt; cA = nA; cB = nB; ++ui;
        if constexpr (ALIGN_EPI) { if (wr == 1) PG8_BAR; }
    }
    PG8_WAIT_V(0);
    if constexpr (!ALIGN_EPI) { if (wr == 0) PG8_BAR; }
    PG8_BAR;
    if constexpr (Epi::AFTER_DRAIN) { E.fused(acc, cur, wr, wc, fr, fq, lds, wid, lane); S.done(cur); }
#undef PG8_SA
#undef PG8_SB
#undef PG8_STAGE
#undef PG8_LDA
#undef PG8_LDB
#undef PG8_MMA
#undef PG8_WAIT_V
#undef PG8_WAIT_L
#undef PG8_BAR
#undef PG8_SCHED
}
}
using pg8::bf16_t; using pg8::bf16x8; using pg8::f32x4; using pg8::u32x4; using pg8::f32x2; using pg8::cvt_pk_bf16;
#define LAS __attribute__((address_space(3)))
#define XB_TMO      128
#define XB_XCNT(j)  (256  + 64 * (j))
#define XB_XSUB(j)  (1280 + 64 * (j))
#define XB_XGEN(j)  (2304 + 64 * (j))
#define XB_TOP      3328
#define XB_TOPGEN   3392
#define XCD_BAR_WORDS 3456
#define XB_SPIN_CAP (1u << 18)

__device__ __forceinline__ unsigned xb_ld(unsigned* p)              { return __hip_atomic_load(p, __ATOMIC_RELAXED, __HIP_MEMORY_SCOPE_AGENT); }
__device__ __forceinline__ unsigned xb_add(unsigned* p, unsigned v) { return __hip_atomic_fetch_add(p, v, __ATOMIC_RELAXED, __HIP_MEMORY_SCOPE_AGENT); }
__device__ __forceinline__ unsigned xb_xcc_id() { return (unsigned)__builtin_amdgcn_s_getreg((3 << 11) | 20) & 0xFu; }
#define XB_SPIN(cond, bar) do { unsigned _sp = 0; while (cond) { __builtin_amdgcn_s_sleep(1); \
    if ((++_sp & 255u) == 0u) { if (xb_ld(&(bar)[XB_TMO])) break; if (_sp > XB_SPIN_CAP) { atomicAdd(&(bar)[XB_TMO], 1u); break; } } } } while (0)

struct XcdBarrier {
    unsigned* bar; unsigned x;
    volatile LAS unsigned* st;
};

__device__ __forceinline__ XcdBarrier xcd_barrier_post(unsigned* bar, volatile LAS unsigned* st) {
    XcdBarrier b; b.bar = bar; b.x = xb_xcc_id(); b.st = st;
    if (threadIdx.x == 0) (void)xb_add(&bar[XB_XCNT(b.x)], 1u);
    return b;
}
__device__ __forceinline__ void xcd_barrier_complete(unsigned* bar, unsigned x, unsigned& nloc, unsigned& nx) {
    const unsigned G = gridDim.x * gridDim.y * gridDim.z;
    unsigned sum, cnt, mine, sp = 0u;
    for (;;) {
        sum = 0u; cnt = 0u; mine = 0u;
#pragma unroll
        for (unsigned j = 0; j < 16; ++j) { const unsigned c = xb_ld(&bar[XB_XCNT(j)]); sum += c; cnt += (c > 0u) ? 1u : 0u; mine = (j == x) ? c : mine; }
        if (sum == G) break;
        __builtin_amdgcn_s_sleep(1);
        if ((++sp & 255u) == 0u) { if (xb_ld(&bar[XB_TMO])) break; if (sp > XB_SPIN_CAP) { atomicAdd(&bar[XB_TMO], 1u); break; } }
    }
    nloc = mine > 0u ? mine : 1u; nx = cnt > 0u ? cnt : 1u;
}

__device__ __forceinline__ void xcd_barrier(const XcdBarrier& b, const bool leader_thread) {
    asm volatile("s_waitcnt vmcnt(0)" ::: "memory");
    __syncthreads();
    if (leader_thread) {
        unsigned* bar = b.bar;
        __builtin_amdgcn_s_waitcnt(0);
        unsigned nloc = b.st[0], nx = b.st[1];
        if (nloc == 0u) { xcd_barrier_complete(bar, b.x, nloc, nx); b.st[0] = nloc; b.st[1] = nx; }
        const unsigned old = xb_add(&bar[XB_XSUB(b.x)], 1u);
        const unsigned gen = old / nloc;
        if (old + 1u == (gen + 1u) * nloc) {
            __builtin_amdgcn_fence(__ATOMIC_RELEASE, "agent");
            asm volatile("s_waitcnt vmcnt(0)" ::: "memory");
            const unsigned og = xb_add(&bar[XB_TOP], 1u);
            const unsigned tg = og / nx;
            if (og + 1u == (tg + 1u) * nx) xb_add(&bar[XB_TOPGEN], 1u);
            else XB_SPIN(xb_ld(&bar[XB_TOPGEN]) == tg, bar);
            __builtin_amdgcn_fence(__ATOMIC_ACQUIRE, "agent");
            xb_add(&bar[XB_XGEN(b.x)], 1u);
            asm volatile("s_waitcnt vmcnt(0)" ::: "memory");
        } else {
            XB_SPIN(xb_ld(&bar[XB_XGEN(b.x)]) == gen, bar);
            __builtin_amdgcn_fence(__ATOMIC_ACQUIRE, "agent");
            asm volatile("s_waitcnt vmcnt(0)" ::: "memory");
        }
    }
    __syncthreads();
}

typedef unsigned u32x2 __attribute__((ext_vector_type(2)));
typedef short s16x4 __attribute__((ext_vector_type(4)));
#define DI __device__ __forceinline__
#ifndef GEMM_SP2
#define GEMM_SP2 true
#endif
#ifndef GEMM_ALIGN
#define GEMM_ALIGN true
#endif
#ifndef DUP
#define DUP 0
#endif

constexpr int DM = 1024, MP = 16384, MS = 512, MT = 16896, DFF = 2816, NIN = 1536;
constexpr float EPS = 1e-6f;
constexpr int NTHR = 512;
constexpr int LDS_BYTES = 152 * 1024;

constexpr size_t SZ_WGU = (size_t)5632 * 1024 * 2, SZ_WD = (size_t)1024 * 2816 * 2, SZ_WIN = (size_t)1536 * 1024 * 2, SZ_WOUT = (size_t)1024 * 1024 * 2;
constexpr size_t WS_WGU = 0;
constexpr size_t WS_WD = WS_WGU + 4 * SZ_WGU;
constexpr size_t WS_WIN = WS_WD + 4 * SZ_WD;
constexpr size_t WS_WOUT = WS_WIN + 2 * SZ_WIN;
constexpr size_t SZ_XB = (size_t)MT * 1024 * 2;
constexpr size_t WS_XB = WS_WOUT + 2 * SZ_WOUT;
constexpr size_t WS_Y = WS_XB + SZ_XB;
constexpr size_t WS_BIG = WS_Y + SZ_XB;
constexpr size_t SZ_BIG = (size_t)MT * DFF * 2;
constexpr size_t SZ_F256 = (size_t)MT * 256 * 4;
constexpr size_t WS_XL = WS_BIG, WS_HL = WS_XL + SZ_F256, WS_PC = WS_HL + SZ_F256, WS_KBP = WS_PC + SZ_F256;
constexpr size_t SZ_KBP = (size_t)4 * 4096 * 128 * 2;
constexpr size_t WS_VTP = WS_KBP + SZ_KBP;
static_assert(WS_VTP + SZ_KBP <= WS_BIG + SZ_BIG, "mixer scratch must fit in the act buffer");
constexpr size_t WS_SS = WS_BIG + SZ_BIG;
constexpr size_t WS_KBS = WS_SS + (size_t)MT * 16 * 4;
constexpr size_t SZ_KBS = (size_t)32 * 160 * 128 * 2;
constexpr size_t WS_VTS = WS_KBS + 2 * SZ_KBS;
constexpr size_t WS_SSUM = WS_VTS + 2 * SZ_KBS;
constexpr size_t WS_LSUM = WS_SSUM + (size_t)4 * 64 * 16 * 64 * 8;
constexpr size_t WS_SPAR = WS_LSUM + (size_t)4 * 64 * 2 * 256 * 4;
constexpr size_t SZ_SPAR = 16384 + 131072;
constexpr size_t WS_CC = WS_SPAR + 2 * SZ_SPAR;
constexpr size_t WS_WGLU = WS_CC + 2 * 65536;
constexpr size_t WS_WAX = WS_WGLU + 2 * 131072;
constexpr size_t WS_BAR = WS_WAX + 2 * 65536;
constexpr size_t WS_BBF = WS_BAR + (size_t)XCD_BAR_WORDS * 4;
constexpr size_t WS_END = WS_BBF + (size_t)2 * 16 * 128 * 32 * 2;
static_assert(WS_END <= (size_t)256 * 1024 * 1024, "workspace budget");

constexpr size_t O_YP = 0, O_YS = (size_t)MP * 1024, O_KP = O_YS + (size_t)MS * 1024, O_VP = O_KP + 131072, O_SREP = O_VP + 131072, O_SIMP = O_SREP + 8192,
                 O_CONVP = O_SIMP + 8192, O_LRUP = O_CONVP + 6144, O_KS = O_LRUP + 2048, O_VS = O_KS + 131072, O_SRES = O_VS + 131072, O_SIMS = O_SRES + 65536,
                 O_CONVS = O_SIMS + 65536, O_LRUS = O_CONVS + 49152, O_END = O_LRUS + 16384;

struct Params { const float* in[38]; float* out; unsigned char* ws; int ph_lo, ph_hi; };
typedef const Params __attribute__((address_space(4))) CParams;

DI float bf2f(bf16_t v) { return __uint_as_float(((unsigned)v) << 16); }
DI bf16_t f2bf(float f) { return (bf16_t)(cvt_pk_bf16(f, 0.f) & 0xffffu); }
DI float sigmoidf_(float x) { return __builtin_amdgcn_rcpf(1.f + __expf(-x)); }
DI float gelu_tanh(float x) { const float v = 1.5957691216057308f * (x + 0.044715f * x * x * x); return x * __builtin_amdgcn_rcpf(1.f + __expf(-v)); }
DI f32x4 mfma16(bf16x8 a, bf16x8 b, f32x4 c) { return __builtin_amdgcn_mfma_f32_16x16x32_bf16(a, b, c, 0, 0, 0); }
DI f32x2 cmul(f32x2 a, f32x2 b) { return (f32x2){a.x * b.x - a.y * b.y, a.x * b.y + a.y * b.x}; }
DI float row_rstd(const float* ss, int row, float invn) {
    const f32x4* p = (const f32x4*)(ss + (size_t)row * 16); const f32x4 a = p[0], b = p[1], c = p[2], d = p[3];
    const f32x4 t = (a + b) + (c + d); return rsqrtf(((t[0] + t[1]) + (t[2] + t[3])) * invn + EPS);
}
DI void lds_fence() { asm volatile("s_waitcnt lgkmcnt(0)" ::: "memory"); }

DI void unit_rstd8(const float* ss, int row0, int fq, float (&rs)[8]) {
    f32x4 q[8];
#pragma unroll
    for (int i = 0; i < 8; ++i) q[i] = *(const f32x4*)(ss + (size_t)(row0 + (i >> 2) * 128 + (i & 3) * 16) * 16 + fq * 4);
#pragma unroll
    for (int i = 0; i < 8; ++i) { float t = (q[i][0] + q[i][1]) + (q[i][2] + q[i][3]); t += __shfl_xor(t, 16); t += __shfl_xor(t, 32); rs[i] = rsqrtf(t * (1.f / 1024.f) + EPS); }
}
struct EpiGateUp {
    static constexpr bool PERM = true, AFTER_DRAIN = false;
    bf16_t* act; const float* ss;
    DI void operator()(const f32x4 (&acc)[2][2][4][2], const pg8::Unit& u, int wr, int wc, int fr, int fq) const {
        const int row0 = u.pm * 256 + wr * 64 + fr, col = u.pn * 128 + wc * 32 + 8 * fq;
        float rs8[8]; unit_rstd8(ss, row0, fq, rs8);
#pragma unroll
        for (int ai = 0; ai < 2; ++ai)
#pragma unroll
            for (int m = 0; m < 4; ++m) {
                const int row = row0 + ai * 128 + m * 16;
                const float rs = rs8[ai * 4 + m];
                f32x2 o2[4];
#pragma unroll
                for (int n = 0; n < 2; ++n)
#pragma unroll
                    for (int hh = 0; hh < 2; ++hh) {
                        const f32x2 g = (f32x2){acc[ai][0][m][n][2 * hh], acc[ai][0][m][n][2 * hh + 1]} * rs, up = (f32x2){acc[ai][1][m][n][2 * hh], acc[ai][1][m][n][2 * hh + 1]} * rs;
                        const f32x2 t = g * (-1.44269504089f);
                        f32x2 e; e.x = __builtin_amdgcn_exp2f(t.x); e.y = __builtin_amdgcn_exp2f(t.y);
                        const f32x2 d = e + 1.0f;
                        f32x2 r; r.x = __builtin_amdgcn_rcpf(d.x); r.y = __builtin_amdgcn_rcpf(d.y);
                        o2[n * 2 + hh] = (g * r) * up;
                    }
                u32x4 w; w.x = cvt_pk_bf16(o2[0].x, o2[0].y); w.y = cvt_pk_bf16(o2[1].x, o2[1].y); w.z = cvt_pk_bf16(o2[2].x, o2[2].y); w.w = cvt_pk_bf16(o2[3].x, o2[3].y);
                *(u32x4*)(act + (size_t)row * DFF + col) = w;
            }
    }
};
struct EpiResid {
    static constexpr bool PERM = true, AFTER_DRAIN = false;
    const float* xin_p; bf16_t* xb; float* ssout; float scale; bool first;
    DI void operator()(const f32x4 (&acc)[2][2][4][2], const pg8::Unit& u, int wr, int wc, int fr, int fq) const {
        const int row0 = u.pm * 256 + wr * 64 + fr, colb = u.pn * 256 + wc * 32 + 8 * fq;
#pragma unroll
        for (int ai = 0; ai < 2; ++ai)
#pragma unroll
            for (int m = 0; m < 4; ++m) {
                const int row = row0 + ai * 128 + m * 16;
                bf16_t* xbo = xb + (size_t)row * 1024;
                float s = 0.f;
#pragma unroll
                for (int bj = 0; bj < 2; ++bj) {
                    const int col = colb + bj * 128;
                    f32x4 a0, a1;
                    if (first) { const float* xi = xin_p + (size_t)row * 1024 + col; a0 = *(const f32x4*)xi; a1 = *(const f32x4*)(xi + 4); }
                    else { const u32x4 o = *(const u32x4*)(xbo + col);
                        a0[0] = __uint_as_float(o.x << 16); a0[1] = __uint_as_float(o.x & 0xffff0000u); a0[2] = __uint_as_float(o.y << 16); a0[3] = __uint_as_float(o.y & 0xffff0000u);
                        a1[0] = __uint_as_float(o.z << 16); a1[1] = __uint_as_float(o.z & 0xffff0000u); a1[2] = __uint_as_float(o.w << 16); a1[3] = __uint_as_float(o.w & 0xffff0000u); }
                    const f32x4 v0 = a0 + acc[ai][bj][m][0] * scale, v1 = a1 + acc[ai][bj][m][1] * scale;
                    u32x4 w; w.x = cvt_pk_bf16(v0[0], v0[1]); w.y = cvt_pk_bf16(v0[2], v0[3]); w.z = cvt_pk_bf16(v1[0], v1[1]); w.w = cvt_pk_bf16(v1[2], v1[3]);
                    *(u32x4*)(xbo + col) = w;
                    s += (v0[0] * v0[0] + v0[1] * v0[1]) + (v0[2] * v0[2] + v0[3] * v0[3]) + (v1[0] * v1[0] + v1[1] * v1[1]) + (v1[2] * v1[2] + v1[3] * v1[3]);
                }
                s += __shfl_xor(s, 16); s += __shfl_xor(s, 32);
                if (fq == 0) ssout[(size_t)row * 16 + u.pn * 4 + wc] = s;
                if (m == 3) asm volatile("" ::: "memory");
            }
    }
};
struct EpiProj {
    static constexpr bool PERM = true, AFTER_DRAIN = false;
    const float* ss; bf16_t* y; float* xl; bf16_t* kbp; bf16_t* vtp; bf16_t* kbs; bf16_t* vts; float* okp; float* ovp; float* oks; float* ovs;
    DI void operator()(const f32x4 (&acc)[2][2][4][2], const pg8::Unit& u, int wr, int wc, int fr, int fq) const {
        const int row0 = u.pm * 256 + wr * 64 + fr, cl = wc * 32 + 8 * fq;
        const int pn = u.pn;
        float rs8[8]; unit_rstd8(ss, row0, fq, rs8);
#pragma unroll
        for (int ai = 0; ai < 2; ++ai)
#pragma unroll
            for (int m = 0; m < 4; ++m) {
                const int row = row0 + ai * 128 + m * 16;
                float rs = rs8[ai * 4 + m];
                if (pn == 4) {
#pragma unroll
                    for (int bj = 0; bj < 2; ++bj) { float* d = xl + (size_t)row * 256 + bj * 128 + cl; *(f32x4*)d = acc[ai][bj][m][0] * rs; *(f32x4*)(d + 4) = acc[ai][bj][m][1] * rs; }
                } else if (pn == 3) {
                    const int kvh = cl >> 6, d0 = cl & 63;
                    const bool prm = row < MP;
                    const int b = prm ? (row >> 12) : ((row - MP) >> 4), pos = prm ? (row & 4095) : ((row - MP) & 15);
                    const bool wout = prm ? (pos >= 3968) : true;
                    const unsigned oo = prm ? (unsigned)((b * 128 + (pos - 3968)) * 128 + cl) : (unsigned)((b * 16 + pos) * 128 + cl);
                    {
                        const f32x4 v0 = acc[ai][0][m][0] * rs, v1 = acc[ai][0][m][1] * rs;
                        if (wout) { float* of = (prm ? okp : oks) + oo; *(f32x4*)of = v0; *(f32x4*)(of + 4) = v1; }
                        u32x4 w; w.x = cvt_pk_bf16(v0[0], v0[1]); w.y = cvt_pk_bf16(v0[2], v0[3]); w.z = cvt_pk_bf16(v1[0], v1[1]); w.w = cvt_pk_bf16(v1[2], v1[3]);
                        bf16_t* kd = prm ? kbp + (unsigned)(row * 128 + cl) : kbs + (unsigned)((b * 160 + 128 + pos) * 128 + cl);
                        *(u32x4*)kd = w;
                    }
                    {
                        const f32x4 v0 = acc[ai][1][m][0] * rs, v1 = acc[ai][1][m][1] * rs;
                        if (wout) { float* of = (prm ? ovp : ovs) + oo; *(f32x4*)of = v0; *(f32x4*)(of + 4) = v1; }
                        const unsigned vstride = prm ? 4096u : 160u;
                        bf16_t* vd = prm ? vtp + (unsigned)(((b * 2 + kvh) * 64 + d0) * 4096 + pos) : vts + (unsigned)(((b * 2 + kvh) * 64 + d0) * 160 + 128 + pos);
#pragma unroll
                        for (int jj = 0; jj < 4; ++jj) { vd[jj * vstride] = f2bf(v0[jj]); vd[(jj + 4) * vstride] = f2bf(v1[jj]); }
                    }
                } else {
                    const int cbase = (pn == 0) ? 0 : (pn == 5 ? 768 : 256 + (pn - 1) * 256);
                    if (pn == 1 || pn == 2) rs *= 0.125f;
#pragma unroll
                    for (int bj = 0; bj < 2; ++bj) {
                        const f32x4 v0 = acc[ai][bj][m][0] * rs, v1 = acc[ai][bj][m][1] * rs;
                        u32x4 w; w.x = cvt_pk_bf16(v0[0], v0[1]); w.y = cvt_pk_bf16(v0[2], v0[3]); w.z = cvt_pk_bf16(v1[0], v1[1]); w.w = cvt_pk_bf16(v1[2], v1[3]);
                        *(u32x4*)(y + (size_t)row * 1024 + cbase + bj * 128 + cl) = w;
                    }
                }
            }
    }
};
struct TileJob { const float* src; const float* gain; bf16_t* dst; int K, N, map, k0, n0; };
DI TileJob decode_tile(CParams& P, int tile) {
    unsigned char* ws = P.ws; TileJob J;
    const int l = tile / 2432, r = tile % 2432;
    int j, tl; if (r < 2112) { j = r / 352; tl = r % 352; } else if (r < 2304) { j = 6; tl = r - 2112; } else { j = 7; tl = r - 2304; }
    J.map = 0;
    if (j == 0 || j == 1 || j == 3 || j == 4) {
        const int f = j >= 3; const int which = (j == 1 || j == 4);
        J.src = P.in[(f ? 34 : 9) + which] + (size_t)l * 1024 * 2816; J.gain = P.in[f ? 33 : 8] + l * 1024; J.dst = (bf16_t*)(ws + WS_WGU + (size_t)(l * 2 + f) * SZ_WGU); J.K = 1024; J.N = 2816; J.map = 1 + which;
    } else if (j == 2 || j == 5) {
        const int f = j == 5; J.src = P.in[f ? 36 : 11] + (size_t)l * 2816 * 1024; J.gain = nullptr; J.dst = (bf16_t*)(ws + WS_WD + (size_t)(l * 2 + f) * SZ_WD); J.K = 2816; J.N = 1024;
    } else if (j == 6) { J.src = P.in[13] + (size_t)l * 1024 * 1536; J.gain = P.in[12] + l * 1024; J.dst = (bf16_t*)(ws + WS_WIN + (size_t)l * SZ_WIN); J.K = 1024; J.N = 1536; }
    else { J.src = P.in[32] + (size_t)l * 1024 * 1024; J.gain = P.in[31] + l * 1024; J.dst = (bf16_t*)(ws + WS_WOUT + (size_t)l * SZ_WOUT); J.K = 1024; J.N = 1024; }
    const int nkt = J.K / 128, kt = tl % nkt, nt = tl / nkt; J.k0 = kt * 128; J.n0 = nt * 64;
    return J;
}
DI void convert_tiles(CParams& P, LAS unsigned char* lds, const int tid, const int first, const int stride, const int tbeg, const int tend) {
    LAS bf16_t* T = (LAS bf16_t*)lds;
    {
        LAS bf16_t* T2_ = T + 64 * 136;
        int tA = tbeg + first, tB = tbeg + first + stride; const int NT = tend;
        f32x4 vA[4], vB[4]; float gA = 1.f, gB = 1.f;
        const int lk = tid >> 2, lns = (tid & 3) * 16;
#define T1_LOAD(tile, v, g) do { const TileJob J = decode_tile(P, tile); const float* sp = J.src + (size_t)(J.k0 + lk) * J.N + J.n0 + lns; g = J.gain ? J.gain[J.k0 + lk] : 1.f; \
            _Pragma("unroll") for (int i = 0; i < 4; ++i) v[i] = *(const f32x4*)(sp + 4 * i); } while (0)
#define T1_TOLDS(Tb, v, g) do { _Pragma("unroll") for (int i = 0; i < 4; ++i) _Pragma("unroll") for (int e = 0; e < 4; ++e) Tb[(lns + 4 * i + e) * 136 + lk] = f2bf(v[i][e] * g); } while (0)
#define T1_STORE(Tb, tile) do { const TileJob J = decode_tile(P, tile); const int n = tid >> 3, ks = (tid & 7) * 16; \
            const int ng = J.n0 + n; const int drow = (J.map == 0) ? ng : (256 * (ng >> 7) + (ng & 127) + (J.map == 2 ? 128 : 0)); \
            const u32x4 a = *(const LAS u32x4*)(Tb + n * 136 + ks), b = *(const LAS u32x4*)(Tb + n * 136 + ks + 8); \
            bf16_t* d = J.dst + (size_t)drow * J.K + J.k0 + ks; *(u32x4*)d = a; *(u32x4*)(d + 8) = b; } while (0)
        if (tA < NT) T1_LOAD(tA, vA, gA);
        if (tB < NT) T1_LOAD(tB, vB, gB);
        while (tA < NT) {
            T1_TOLDS(T, vA, gA);
            if (tB < NT) T1_TOLDS(T2_, vB, gB);
            __syncthreads();
            const int nA = tA + 2 * stride, nB = tB + 2 * stride;
            if (nA < NT) T1_LOAD(nA, vA, gA);
            if (nB < NT) T1_LOAD(nB, vB, gB);
            T1_STORE(T, tA);
            if (tB < NT) T1_STORE(T2_, tB);
            __syncthreads();
            tA = nA; tB = nB;
        }
#undef T1_LOAD
#undef T1_TOLDS
#undef T1_STORE
    }
}
DI void prep_phase(CParams& P, LAS unsigned char* lds, const int tid, const int bid, const int nb) {
    const int lane = tid & 63, wave = tid >> 6;
    unsigned char* ws = P.ws;
    convert_tiles(P, lds, tid, bid, nb, 0, 704);
    {
        bf16_t* xb = (bf16_t*)(ws + WS_XB); float* ss0 = (float*)(ws + WS_SS);
        for (int row = bid * 8 + wave; row < MT; row += nb * 8) {
            const float* x = (row < MP) ? P.in[0] + (size_t)row * 1024 : P.in[1] + (size_t)(row - MP) * 1024;
            float s = 0.f;
#pragma unroll
            for (int i = 0; i < 4; ++i) {
                const f32x4 v = *(const f32x4*)(x + i * 256 + lane * 4);
                s += v[0] * v[0] + v[1] * v[1] + v[2] * v[2] + v[3] * v[3];
                u32x2 w; w.x = cvt_pk_bf16(v[0], v[1]); w.y = cvt_pk_bf16(v[2], v[3]);
                *(u32x2*)(xb + (size_t)row * 1024 + i * 256 + lane * 4) = w;
            }
#pragma unroll
            for (int o = 1; o < 64; o <<= 1) s += __shfl_xor(s, o);
            if (lane < 16) ss0[(size_t)row * 16 + lane] = (lane == 0) ? s : 0.f;
        }
    }
    const int gt = bid * NTHR + tid, gs = nb * NTHR;
    for (int e = gt; e < 2 * 32 * 128 * 128; e += gs) {
        const int c = e & 127, r = (e >> 7) & 127, sb = (e >> 14) & 31, l = e >> 19;
        bf16_t* kbs = (bf16_t*)(ws + WS_KBS + (size_t)l * SZ_KBS); bf16_t* vts = (bf16_t*)(ws + WS_VTS + (size_t)l * SZ_KBS);
        kbs[((size_t)(sb * 160 + r)) * 128 + c] = f2bf(P.in[2][e]);
        vts[((size_t)((sb * 2 + (c >> 6)) * 64 + (c & 63))) * 160 + r] = f2bf(P.in[3][e]);
    }
    for (int e = gt; e < 2 * 32 * 16 * 128; e += gs) {
        const int c = e & 127, r = (e >> 7) & 15, sb = (e >> 11) & 31, l = e >> 16;
        bf16_t* kbs = (bf16_t*)(ws + WS_KBS + (size_t)l * SZ_KBS); bf16_t* vts = (bf16_t*)(ws + WS_VTS + (size_t)l * SZ_KBS);
        kbs[((size_t)(sb * 160 + 144 + r)) * 128 + c] = 0;
        vts[((size_t)((sb * 2 + (c >> 6)) * 64 + (c & 63))) * 160 + 144 + r] = 0;
    }
    for (int e = gt >> 4; e < 2 * 16 * 64; e += gs >> 4) {
        const int h = gt & 15;
        const int p = e & 63, g = (e >> 6) & 15, l = e >> 10;
        const float dt = expf(P.in[16][l * 16 + g]);
        const float are = P.in[14][e], aim = P.in[15][e];
        const float mag = expf(are * dt);
        const float lbr = mag * cosf(aim * dt), lbi = mag * sinf(aim * dt);
        const float den = are * are + aim * aim, nr = lbr - 1.f;
        const float kr = (nr * are + lbi * aim) / den, ki = (lbi * are - nr * aim) / den;
        if (h == 0) {
            f32x2 pw = (f32x2){lbr, lbi};
#pragma unroll
            for (int i = 0; i < 6; ++i) pw = cmul(pw, pw);
            float* lb = (float*)(ws + WS_SPAR + (size_t)l * SZ_SPAR) + (size_t)(g * 64 + p) * 4;
            lb[0] = lbr; lb[1] = lbi; lb[2] = pw.x; lb[3] = pw.y;
        }
        float* bb = (float*)(ws + WS_SPAR + (size_t)l * SZ_SPAR + 16384) + (size_t)(g * 64 + p) * 32;
        bf16_t* bfr = (bf16_t*)(ws + WS_BBF) + ((size_t)((l * 16 + g) * 128 + p)) * 32; bf16_t* bfi = bfr + 64 * 32;
        const float br = P.in[17][(size_t)e * 16 + h], bi = P.in[18][(size_t)e * 16 + h];
        const float xr = kr * br - ki * bi, xi = kr * bi + ki * br;
        bb[2 * h] = xr; bb[2 * h + 1] = xi;
        bfr[h] = f2bf(xr); bfi[h] = f2bf(xi); bfr[16 + h] = 0; bfi[16 + h] = 0;
    }
    for (int e = gt; e < 2 * 16 * 16 * 128; e += gs) {
        const int k = e & 127, h = (e >> 7) & 15, g = (e >> 11) & 15, l = e >> 15;
        const size_t si = ((size_t)((l * 16 + g) * 16 + h)) * 64 + (k & 63);
        ((bf16_t*)(ws + WS_CC))[e] = f2bf(k < 64 ? P.in[19][si] : -P.in[20][si]);
    }
    for (int e = gt; e < 2 * 256 * 256; e += gs) {
        const int k = e & 255, n = (e >> 8) & 255, l = e >> 16;
        ((bf16_t*)(ws + WS_WGLU))[e] = f2bf(P.in[22][((size_t)(l * 256 + k)) * 256 + n]);
    }
    for (int e = gt; e < 2 * 2 * 4 * 64 * 64; e += gs) {
        const int i = e & 63, o = (e >> 6) & 63, blk = (e >> 12) & 3, which = (e >> 14) & 1, l = e >> 15;
        ((bf16_t*)(ws + WS_WAX))[e] = f2bf(P.in[which ? 28 : 26][((size_t)((l * 4 + blk) * 64 + i)) * 64 + o]);
    }
}

DI f32x2 ssm_x(const f32x2 (&bb)[16], const LAS float* ut) {
    const f32x4 u0 = *(const LAS f32x4*)ut, u1 = *(const LAS f32x4*)(ut + 4), u2 = *(const LAS f32x4*)(ut + 8), u3 = *(const LAS f32x4*)(ut + 12);
    f32x2 xa = bb[0] * u0[0], xb = bb[1] * u0[1], xc = bb[2] * u0[2], xd = bb[3] * u0[3];
    xa += bb[4] * u1[0]; xb += bb[5] * u1[1]; xc += bb[6] * u1[2]; xd += bb[7] * u1[3];
    xa += bb[8] * u2[0]; xb += bb[9] * u2[1]; xc += bb[10] * u2[2]; xd += bb[11] * u2[3];
    xa += bb[12] * u3[0]; xb += bb[13] * u3[1]; xc += bb[14] * u3[2]; xd += bb[15] * u3[3];
    return (xa + xb) + (xc + xd);
}
DI void stage_u(const bf16_t* y, int row0, int T, LAS float* U32, int tid) {
    for (int idx = tid; idx < T * 32; idx += NTHR) {
        const int t = idx >> 5, seg = idx & 31;
        const u32x4 v = *(const u32x4*)(y + (size_t)(row0 + t) * 1024 + seg * 8);
        f32x4 a, b;
        a[0] = __uint_as_float(v.x << 16); a[1] = __uint_as_float(v.x & 0xffff0000u); a[2] = __uint_as_float(v.y << 16); a[3] = __uint_as_float(v.y & 0xffff0000u);
        b[0] = __uint_as_float(v.z << 16); b[1] = __uint_as_float(v.z & 0xffff0000u); b[2] = __uint_as_float(v.w << 16); b[3] = __uint_as_float(v.w & 0xffff0000u);
        *(LAS f32x4*)(U32 + t * 256 + seg * 8) = a; *(LAS f32x4*)(U32 + t * 256 + seg * 8 + 4) = b;
    }
}

DI void attn_chunk_item(CParams& P, int l, int ci, LAS unsigned char* lds, int tid, bf16_t* Yw) {
    unsigned char* ws = P.ws;
    const bf16_t* Y = (const bf16_t*)(ws + WS_Y);
    const int wave = tid >> 6, lane = tid & 63, fr = lane & 15, fq = lane >> 4;
    const bool smp = ci >= 256;
    const bf16_t* kb; const bf16_t* vt; int lpad, nkeys, nvt, row0, nsub;
    if (!smp) {
        const int b = ci >> 6, c = ci & 63, c0 = c >= 2 ? c - 2 : 0, klo = c0 * 64;
        nkeys = (c + 1) * 64 - klo; nvt = nkeys >> 4; row0 = b * 4096 + c * 64; nsub = 4;
        kb = (const bf16_t*)(ws + WS_KBP) + ((size_t)(b * 4096 + klo)) * 128; vt = (const bf16_t*)(ws + WS_VTP) + (size_t)(b * 2) * 64 * 4096 + klo; lpad = 4096;
    } else {
        const int sb = ci - 256; nkeys = 160; nvt = 9; row0 = MP + sb * 16; nsub = 1;
        kb = (const bf16_t*)(ws + WS_KBS + (size_t)l * SZ_KBS) + (size_t)sb * 160 * 128; vt = (const bf16_t*)(ws + WS_VTS + (size_t)l * SZ_KBS) + (size_t)sb * 2 * 64 * 160; lpad = 160;
    }
    const int npair = nkeys >> 5;
    LAS unsigned char* KL = lds;
    LAS unsigned char* VL = lds + 192 * 272;
    LAS float* ssq = (LAS float*)(lds + 192 * 272 + 128 * 400);
    {
        const int ppr = nkeys >> 3, nk = nkeys * 16, nv = 128 * ppr;
        u32x4 kq[6], vq[6];
#pragma unroll
        for (int i = 0; i < 6; ++i) { const int idx = tid + i * NTHR; const int ic = idx < nk ? idx : 0; kq[i] = *(const u32x4*)(kb + (size_t)(ic >> 4) * 128 + (ic & 15) * 8); }
#pragma unroll
        for (int i = 0; i < 6; ++i) { const int idx = tid + i * NTHR; const int ic = idx < nv ? idx : 0; const int r = ic / ppr, sg = ic - r * ppr; vq[i] = *(const u32x4*)(vt + (size_t)r * lpad + sg * 8); }
#pragma unroll
        for (int i = 0; i < 6; ++i) { const int idx = tid + i * NTHR; if (idx < nk) *(LAS u32x4*)(KL + (idx >> 4) * 272 + (idx & 15) * 16) = kq[i]; }
#pragma unroll
        for (int i = 0; i < 6; ++i) { const int idx = tid + i * NTHR; if (idx < nv) { const int r = idx / ppr, sg = idx - r * ppr; *(LAS u32x4*)(VL + r * 400 + sg * 16) = vq[i]; } }
    }
    const int h = wave, kvh = h >> 2;
    bf16x8 qf[4][2];
#pragma unroll
    for (int sb_ = 0; sb_ < 4; ++sb_) {
        const int su = sb_ < nsub ? sb_ : 0;
        const bf16_t* yq = Y + (size_t)(row0 + su * 16 + fr) * 1024 + 256 + h * 64;
        qf[sb_][0] = *(const bf16x8*)(yq + fq * 8); qf[sb_][1] = *(const bf16x8*)(yq + 32 + fq * 8);
    }
    const float sink = P.in[23][l * 8 + h];
    __syncthreads();
    f32x4 O[4][4];
#pragma unroll
    for (int su = 0; su < 4; ++su) {
        if (su < nsub) {
            f32x4 s[12];
#pragma unroll
            for (int kt = 0; kt < 12; ++kt) {
                if (kt < nvt) {
                    const LAS unsigned char* kp = KL + (kt * 16 + fr) * 272 + kvh * 128 + fq * 16;
                    const bf16x8 k0 = *(const LAS bf16x8*)kp, k1 = *(const LAS bf16x8*)(kp + 64);
                    f32x4 a = (f32x4){0.f, 0.f, 0.f, 0.f};
                    a = mfma16(k0, qf[su][0], a); a = mfma16(k1, qf[su][1], a);
                    s[kt] = a;
                } else s[kt] = (f32x4){-1e30f, -1e30f, -1e30f, -1e30f};
            }
            float mx = sink;
#pragma unroll
            for (int kt = 0; kt < 12; ++kt)
#pragma unroll
                for (int jj = 0; jj < 4; ++jj) mx = fmaxf(mx, s[kt][jj]);
            mx = fmaxf(mx, __shfl_xor(mx, 16)); mx = fmaxf(mx, __shfl_xor(mx, 32));
            float sum = 0.f;
#pragma unroll
            for (int kt = 0; kt < 12; ++kt)
#pragma unroll
                for (int jj = 0; jj < 4; ++jj) { const float p = __expf(s[kt][jj] - mx); s[kt][jj] = p; sum += p; }
            sum += __shfl_xor(sum, 16); sum += __shfl_xor(sum, 32);
            const float inv = 1.f / (sum + __expf(sink - mx));
#pragma unroll
            for (int dt = 0; dt < 4; ++dt) O[su][dt] = (f32x4){0.f, 0.f, 0.f, 0.f};
#pragma unroll
            for (int i = 0; i < 6; ++i) {
                if (i < npair) {
                    u32x4 pw; pw.x = cvt_pk_bf16(s[2 * i][0], s[2 * i][1]); pw.y = cvt_pk_bf16(s[2 * i][2], s[2 * i][3]); pw.z = cvt_pk_bf16(s[2 * i + 1][0], s[2 * i + 1][1]); pw.w = cvt_pk_bf16(s[2 * i + 1][2], s[2 * i + 1][3]);
                    const bf16x8 pb = __builtin_bit_cast(bf16x8, pw);
#pragma unroll
                    for (int dt = 0; dt < 4; ++dt) {
                        const LAS unsigned char* vp = VL + (kvh * 64 + dt * 16 + fr) * 400 + i * 64 + fq * 8;
                        const s16x4 lo = *(const LAS s16x4*)vp, hi = *(const LAS s16x4*)(vp + 32);
                        const bf16x8 vf = __builtin_shufflevector(lo, hi, 0, 1, 2, 3, 4, 5, 6, 7);
                        O[su][dt] = mfma16(vf, pb, O[su][dt]);
                    }
                }
            }
            float sl = 0.f;
#pragma unroll
            for (int dt = 0; dt < 4; ++dt) { O[su][dt] = O[su][dt] * inv; sl += O[su][dt][0] * O[su][dt][0] + O[su][dt][1] * O[su][dt][1] + O[su][dt][2] * O[su][dt][2] + O[su][dt][3] * O[su][dt][3]; }
            sl += __shfl_xor(sl, 16); sl += __shfl_xor(sl, 32);
            if (fq == 0) ssq[(su * 8 + h) * 16 + fr] = sl;
        }
    }
    __syncthreads();
#pragma unroll
    for (int su = 0; su < 4; ++su) {
        if (su < nsub) {
            float tot = 0.f;
#pragma unroll
            for (int hh = 0; hh < 8; ++hh) tot += ssq[(su * 8 + hh) * 16 + fr];
            const float rs = rsqrtf(tot * (1.f / 512.f) + EPS);
            bf16_t* yo = Yw + (size_t)(row0 + su * 16 + fr) * 1024 + 256 + h * 64;
#pragma unroll
            for (int dt = 0; dt < 4; ++dt) {
                u32x2 w; w.x = cvt_pk_bf16(O[su][dt][0] * rs, O[su][dt][1] * rs); w.y = cvt_pk_bf16(O[su][dt][2] * rs, O[su][dt][3] * rs);
                *(u32x2*)(yo + dt * 16 + fq * 4) = w;
            }
        }
    }
    __syncthreads();
}

DI void lru_item(CParams& P, int l, int li, LAS unsigned char* lds, int tid) {
    unsigned char* ws = P.ws;
    const int wave = tid >> 6, lane = tid & 63, fr = lane & 15, fq = lane >> 4;
    const bool smp = li >= 256;
    const int b = smp ? li - 256 : li >> 6, c = smp ? 0 : li & 63;
    const int row0 = smp ? MP + b * 16 : b * 4096 + c * 64;
    const int T = smp ? 16 : 64, TH = smp ? 16 : 32, nh = smp ? 1 : 2;
    const float* XL = (const float*)(ws + WS_XL); bf16_t* HL = (bf16_t*)(ws + WS_HL); bf16_t* PC = (bf16_t*)(ws + WS_PC);
    LAS float* XC32 = (LAS float*)lds; LAS float* A32 = (LAS float*)(lds + 32768); LAS bf16_t* XCB = (LAS bf16_t*)(lds + 65536);
    const int ch = tid & 255, part = tid >> 8;
    const float cw0 = P.in[24][(l * 4 + 0) * 256 + ch], cw1 = P.in[24][(l * 4 + 1) * 256 + ch], cw2 = P.in[24][(l * 4 + 2) * 256 + ch], cw3 = P.in[24][(l * 4 + 3) * 256 + ch], cb = P.in[25][l * 256 + ch];
    const int blk = wave >> 1, ob = (wave & 1) * 32;
    const bf16_t* WAX = (const bf16_t*)(ws + WS_WAX) + (size_t)l * 2 * 4 * 64 * 64;
    bf16x8 Bw[2][2][2];
#pragma unroll
    for (int gq = 0; gq < 2; ++gq)
#pragma unroll
        for (int ot = 0; ot < 2; ++ot)
#pragma unroll
            for (int ks = 0; ks < 2; ++ks) Bw[gq][ot][ks] = *(const bf16x8*)(WAX + ((size_t)((gq * 4 + blk) * 64 + ob + ot * 16 + fr)) * 64 + ks * 32 + fq * 8);
    float ba[2], bx[2], ls[2];
#pragma unroll
    for (int ot = 0; ot < 2; ++ot) { const int cc = blk * 64 + ob + ot * 16 + fr; ba[ot] = P.in[27][l * 256 + cc]; bx[ot] = P.in[29][l * 256 + cc]; ls[ot] = -log1pf(expf(-P.in[30][l * 256 + cc])); }
    float hl = 0.f, pc = 1.f;
    for (int hf = 0; hf < nh; ++hf) {
        {
            const int tper = TH >> 1, tb = part * tper;
            const int pos0 = (smp ? 0 : c * 64) + hf * 32 + tb;
            const size_t rb = smp ? (size_t)MP + b * 16 : (size_t)b * 4096;
            float xw[19];
#pragma unroll
            for (int i = 0; i < 19; ++i) {
                const int pp = pos0 + i - 3;
                xw[i] = 0.f;
                if (i < tper + 3) {
                    if (pp >= 0) xw[i] = XL[(rb + pp) * 256 + ch];
                    else if (smp) xw[i] = P.in[6][((size_t)((l * 32 + b) * 3 + (pp + 3))) * 256 + ch];
                }
            }
#pragma unroll
            for (int tt = 0; tt < 16; ++tt) {
                if (tt < tper) {
                    const int t = tb + tt;
                    const float a = cb + cw0 * xw[tt] + cw1 * xw[tt + 1] + cw2 * xw[tt + 2] + cw3 * xw[tt + 3];
                    XC32[t * 256 + ch] = a; XCB[t * 264 + ch] = f2bf(a);
                }
            }
        }
        __syncthreads();
#pragma unroll
        for (int tt = 0; tt < 2; ++tt) {
            if (tt * 16 < TH) {
                bf16x8 A[2];
#pragma unroll
                for (int ks = 0; ks < 2; ++ks) A[ks] = *(const LAS bf16x8*)(XCB + (tt * 16 + fr) * 264 + blk * 64 + ks * 32 + fq * 8);
#pragma unroll
                for (int ot = 0; ot < 2; ++ot) {
                    f32x4 ga = (f32x4){0.f, 0.f, 0.f, 0.f}, gx = ga;
#pragma unroll
                    for (int ks = 0; ks < 2; ++ks) { ga = mfma16(A[ks], Bw[0][ot][ks], ga); gx = mfma16(A[ks], Bw[1][ot][ks], gx); }
                    const int cc = blk * 64 + ob + ot * 16 + fr;
#pragma unroll
                    for (int j = 0; j < 4; ++j) {
                        const int t = tt * 16 + fq * 4 + j;
                        const float r = sigmoidf_(ga[j] + ba[ot]), ig = sigmoidf_(gx[j] + bx[ot]);
                        const float la = 8.f * r * ls[ot];
                        const float av = __expf(la), mult = sqrtf(-expm1f(2.f * la));
                        const float xc = XC32[t * 256 + cc];
                        XC32[t * 256 + cc] = mult * ig * xc; A32[t * 256 + cc] = av;
                    }
                }
            }
        }
        __syncthreads();
        if (tid < 256) {
            for (int t = 0; t < TH; ++t) {
                const float av = A32[t * 256 + ch], bt = XC32[t * 256 + ch];
                hl = av * hl + bt; pc = av * pc;
                const size_t r = (size_t)(row0 + hf * 32 + t) * 256 + ch;
                HL[r] = f2bf(hl); PC[r] = f2bf(pc);
            }
        }
        __syncthreads();
    }
    if (tid < 256) {
        if (!smp) { float* ls_ = (float*)(ws + WS_LSUM) + ((size_t)(b * 64 + c) * 2) * 256; ls_[ch] = pc; ls_[256 + ch] = hl; }
        if (smp) { for (int i = 0; i < 3; ++i) P.out[O_CONVS + ((size_t)((l * 32 + b) * 3 + i)) * 256 + ch] = XL[((size_t)(MP + b * 16 + 13 + i)) * 256 + ch]; }
        else if (c == 63) { for (int i = 0; i < 3; ++i) P.out[O_CONVP + ((size_t)((l * 4 + b) * 3 + i)) * 256 + ch] = XL[((size_t)(b * 4096 + 4093 + i)) * 256 + ch]; }
    }
    (void)T;
}

DI void ssma_item(CParams& P, int l, int si, LAS unsigned char* lds, int tid) {
    unsigned char* ws = P.ws;
    const int wave = tid >> 6, lane = tid & 63, fr = lane & 15, fq = lane >> 4;
    const int b = si >> 6, c = si & 63, row0 = b * 4096 + c * 64;
    const bf16_t* Y = (const bf16_t*)(ws + WS_Y);
    LAS float* XW = (LAS float*)lds + wave * (32 * 132);
#pragma unroll 1
    for (int gi = 0; gi < 2; ++gi) {
        const int g = wave * 2 + gi;
        const f32x4 lb4 = *(const f32x4*)((const float*)(ws + WS_SPAR + (size_t)l * SZ_SPAR) + (size_t)(g * 64 + lane) * 4);
        const f32x2 lb = (f32x2){lb4[0], lb4[1]};
        bf16x8 Bf[8];
        const bf16_t* bbf = (const bf16_t*)(ws + WS_BBF) + ((size_t)((l * 16 + g) * 128 + fr)) * 32 + fq * 8;
#pragma unroll
        for (int nt = 0; nt < 8; ++nt) Bf[nt] = *(const bf16x8*)(bbf + (size_t)nt * 16 * 32);
        bf16x8 Af[4];
#pragma unroll
        for (int mt = 0; mt < 4; ++mt) { Af[mt] = (bf16x8){0, 0, 0, 0, 0, 0, 0, 0}; if (fq < 2) Af[mt] = *(const bf16x8*)(Y + (size_t)(row0 + mt * 16 + fr) * 1024 + g * 16 + fq * 8); }
        f32x2 H = (f32x2){0.f, 0.f};
#pragma unroll
        for (int hf = 0; hf < 2; ++hf) {
#pragma unroll
            for (int m2 = 0; m2 < 2; ++m2)
#pragma unroll
                for (int nt = 0; nt < 8; ++nt) {
                    const f32x4 a = mfma16(Af[hf * 2 + m2], Bf[nt], (f32x4){0.f, 0.f, 0.f, 0.f});
#pragma unroll
                    for (int jj = 0; jj < 4; ++jj) XW[(m2 * 16 + fq * 4 + jj) * 132 + nt * 16 + fr] = a[jj];
                }
            lds_fence();
#pragma unroll 8
            for (int t = 0; t < 32; ++t) { const f32x2 x = (f32x2){XW[t * 132 + lane], XW[t * 132 + 64 + lane]}; H = cmul(lb, H) + x; }
            lds_fence();
        }
        *(f32x2*)((float*)(ws + WS_SSUM) + ((size_t)((b * 64 + c) * 16 + g) * 64 + lane) * 2) = H;
    }
    __syncthreads();
}

DI void m1_phase(CParams& P, int l, LAS unsigned char* lds, const int tid, bf16_t* Yw, const int bid, const int nb, const int id_lo = 0, const int id_hi = 832) {
    const int wave = tid >> 6, lane = tid & 63;
    for (int id = id_lo + bid; id < id_hi; id += nb) {
        int t2 = tid; asm volatile("" : "+v"(t2));
        if (id < 256) ssma_item(P, l, id, lds, t2);
        else if (id < 544) lru_item(P, l, id - 256, lds, t2);
        else attn_chunk_item(P, l, id - 544, lds, t2, Yw);
    }
}
DI void m2_item(CParams& P, int l, int id, LAS unsigned char* lds, int tid, bf16_t* Yw) {
    unsigned char* ws = P.ws;
    const int wave = tid >> 6, lane = tid & 63, fr = lane & 15, fq = lane >> 4;
    const bool smp = id >= 256;
    const int b = smp ? id - 256 : id >> 6, c = smp ? 0 : id & 63;
    const int row0 = smp ? MP + b * 16 : b * 4096 + c * 64;
    const int T = smp ? 16 : 64, ntb = T >> 4;
    const bool lastc = smp || c == 63;
    bf16_t* Y = (bf16_t*)(ws + WS_Y);
    LAS float* XW = (LAS float*)lds + wave * (16 * 132);
    LAS bf16_t* Z = (LAS bf16_t*)(lds + 67584);
    LAS bf16_t* HS = (LAS bf16_t*)(lds + 67584 + 33792) + wave * (16 * 136);
    LAS float* RED = (LAS float*)(lds + 67584 + 33792 + 34816);
    f32x2 Hc0, Hc1; f32x4 lbq0, lbq1;
#pragma unroll
    for (int gi = 0; gi < 2; ++gi) {
        const int g = wave * 2 + gi;
        const f32x4 lb4 = *(const f32x4*)((const float*)(ws + WS_SPAR + (size_t)l * SZ_SPAR) + (unsigned)(g * 64 + lane) * 4u);
        if (gi) lbq1 = lb4; else lbq0 = lb4;
        const f32x2 lb64 = (f32x2){lb4[2], lb4[3]};
        f32x2 H = (f32x2){0.f, 0.f};
        if (smp) { const size_t si = ((size_t)((l * 32 + b) * 16 + g)) * 64 + lane; H = (f32x2){P.in[4][si], P.in[5][si]}; }
        else {
            const float* sp = (const float*)(ws + WS_SSUM) + ((size_t)((b * 64) * 16 + g) * 64 + lane) * 2;
            for (int j0 = 0; j0 < c; j0 += 8) {
                f32x2 S[8];
#pragma unroll
                for (int k = 0; k < 8; ++k) { const int jj = (j0 + k < c) ? j0 + k : c - 1; S[k] = *(const f32x2*)(sp + (unsigned)jj * 2048u); }
#pragma unroll
                for (int k = 0; k < 8; ++k) if (j0 + k < c) H = cmul(lb64, H) + S[k];
            }
        }
        if (gi) Hc1 = H; else Hc0 = H;
    }
    {
        const bf16_t* HL = (const bf16_t*)(ws + WS_HL); const bf16_t* PC = (const bf16_t*)(ws + WS_PC);
        f32x4 Hin = (f32x4){0.f, 0.f, 0.f, 0.f};
        if (smp) Hin = *(const f32x4*)(P.in[7] + (size_t)(l * 32 + b) * 256 + lane * 4);
        else {
            const float* lsum = (const float*)(ws + WS_LSUM) + (size_t)(b * 64) * 2 * 256 + lane * 4;
            for (int j0 = 0; j0 < c; j0 += 4) {
                f32x4 A[4], S[4];
#pragma unroll
                for (int k = 0; k < 4; ++k) { const int jj = (j0 + k < c) ? j0 + k : c - 1; A[k] = *(const f32x4*)(lsum + (unsigned)jj * 512u); S[k] = *(const f32x4*)(lsum + (unsigned)jj * 512u + 256); }
#pragma unroll
                for (int k = 0; k < 4; ++k) if (j0 + k < c) Hin = A[k] * Hin + S[k];
            }
        }
        for (int t0 = wave; t0 < T; t0 += 32) {
            f32x4 hl[4], pc[4]; u32x2 gw[4];
#pragma unroll
            for (int q = 0; q < 4; ++q) {
                const int t = (t0 + 8 * q < T) ? t0 + 8 * q : t0; const size_t row = row0 + t;
                const u32x2 hw = *(const u32x2*)(HL + row * 256 + lane * 4), pw = *(const u32x2*)(PC + row * 256 + lane * 4);
                hl[q][0] = __uint_as_float(hw.x << 16); hl[q][1] = __uint_as_float(hw.x & 0xffff0000u); hl[q][2] = __uint_as_float(hw.y << 16); hl[q][3] = __uint_as_float(hw.y & 0xffff0000u);
                pc[q][0] = __uint_as_float(pw.x << 16); pc[q][1] = __uint_as_float(pw.x & 0xffff0000u); pc[q][2] = __uint_as_float(pw.y << 16); pc[q][3] = __uint_as_float(pw.y & 0xffff0000u);
                gw[q] = *(const u32x2*)(Y + row * 1024 + 768 + lane * 4);
            }
#pragma unroll
            for (int q = 0; q < 4; ++q) {
                const int t = t0 + 8 * q;
                if (t < T) {
                    const size_t row = row0 + t;
                    const f32x4 h = hl[q] + pc[q] * Hin;
                    f32x4 gl; gl[0] = __uint_as_float(gw[q].x << 16); gl[1] = __uint_as_float(gw[q].x & 0xffff0000u); gl[2] = __uint_as_float(gw[q].y << 16); gl[3] = __uint_as_float(gw[q].y & 0xffff0000u);
                    f32x4 yl; float s = 0.f;
#pragma unroll
                    for (int jj = 0; jj < 4; ++jj) { yl[jj] = gelu_tanh(gl[jj]) * h[jj]; s += yl[jj] * yl[jj]; }
#pragma unroll
                    for (int o = 1; o < 64; o <<= 1) s += __shfl_xor(s, o);
                    const float rs = rsqrtf(s * (1.f / 256.f) + EPS);
                    u32x2 w; w.x = cvt_pk_bf16(yl[0] * rs, yl[1] * rs); w.y = cvt_pk_bf16(yl[2] * rs, yl[3] * rs);
                    *(u32x2*)(Yw + row * 1024 + 768 + lane * 4) = w;
                    if (lastc && t == T - 1) *(f32x4*)(P.out + (smp ? O_LRUS + (size_t)(l * 32 + b) * 256 : O_LRUP + (size_t)(l * 4 + b) * 256) + lane * 4) = h;
                }
            }
        }
    }
    __syncthreads();
#pragma unroll 1
    for (int gi = 0; gi < 2; ++gi) {
        const int g = wave * 2 + gi;
        const f32x4 lb4 = gi ? lbq1 : lbq0;
        const f32x2 lb = (f32x2){lb4[0], lb4[1]};
        bf16x8 Bf[8];
        const bf16_t* bbf = (const bf16_t*)(ws + WS_BBF) + ((size_t)((l * 16 + g) * 128 + fr)) * 32 + fq * 8;
#pragma unroll
        for (int nt = 0; nt < 8; ++nt) Bf[nt] = *(const bf16x8*)(bbf + (size_t)nt * 16 * 32);
        bf16x8 Af[4];
#pragma unroll
        for (int mt = 0; mt < 4; ++mt) { Af[mt] = (bf16x8){0, 0, 0, 0, 0, 0, 0, 0}; if (fq < 2 && mt < ntb) Af[mt] = *(const bf16x8*)(Y + (size_t)(row0 + mt * 16 + fr) * 1024 + g * 16 + fq * 8); }
        float usk[4][4];
#pragma unroll
        for (int mt = 0; mt < 4; ++mt)
#pragma unroll
            for (int jj = 0; jj < 4; ++jj) usk[mt][jj] = (mt < ntb) ? bf2f(Y[(size_t)(row0 + mt * 16 + fq * 4 + jj) * 1024 + g * 16 + fr]) : 0.f;
        bf16x8 Cw[4];
        const bf16_t* ccp = (const bf16_t*)(ws + WS_CC) + ((size_t)((l * 16 + g) * 16 + fr)) * 128 + fq * 8;
#pragma unroll
        for (int ks = 0; ks < 4; ++ks) Cw[ks] = *(const bf16x8*)(ccp + ks * 32);
        const float dsk = P.in[21][l * 256 + g * 16 + fr];
        f32x2 H = gi ? Hc1 : Hc0;
#pragma unroll
        for (int tb = 0; tb < 4; ++tb) {
            if (tb < ntb) {
#pragma unroll
                for (int nt = 0; nt < 8; ++nt) {
                    const f32x4 a = mfma16(Af[tb], Bf[nt], (f32x4){0.f, 0.f, 0.f, 0.f});
#pragma unroll
                    for (int jj = 0; jj < 4; ++jj) XW[(fq * 4 + jj) * 132 + nt * 16 + fr] = a[jj];
                }
                lds_fence();
#pragma unroll
                for (int tt = 0; tt < 16; ++tt) {
                    const f32x2 x = (f32x2){XW[tt * 132 + lane], XW[tt * 132 + 64 + lane]};
                    H = cmul(lb, H) + x;
                    const unsigned pk = cvt_pk_bf16(H.x, H.y);
                    HS[tt * 136 + lane] = (bf16_t)(pk & 0xffffu); HS[tt * 136 + 64 + lane] = (bf16_t)(pk >> 16);
                }
                lds_fence();
                f32x4 acc = (f32x4){0.f, 0.f, 0.f, 0.f};
#pragma unroll
                for (int ks = 0; ks < 4; ++ks) { const bf16x8 A = *(const LAS bf16x8*)(HS + fr * 136 + ks * 32 + fq * 8); acc = mfma16(A, Cw[ks], acc); }
#pragma unroll
                for (int jj = 0; jj < 4; ++jj) {
                    const int t = tb * 16 + fq * 4 + jj;
                    const float yv = acc[jj] + dsk * usk[tb][jj];
                    Z[t * 264 + g * 16 + fr] = f2bf(gelu_tanh(yv));
                }
                lds_fence();
            }
        }
        if (lastc) {
            const size_t so = smp ? ((size_t)((l * 32 + b) * 16 + g)) * 64 + lane : ((size_t)((l * 4 + b) * 16 + g)) * 64 + lane;
            P.out[(smp ? O_SRES : O_SREP) + so] = H.x; P.out[(smp ? O_SIMS : O_SIMP) + so] = H.y;
        }
    }
    __syncthreads();
    {
        const bf16_t* WG = (const bf16_t*)(ws + WS_WGLU) + (size_t)l * 65536;
        bf16x8 Bw[2][8];
#pragma unroll
        for (int i = 0; i < 2; ++i)
#pragma unroll
            for (int ks = 0; ks < 8; ++ks) Bw[i][ks] = *(const bf16x8*)(WG + ((size_t)((2 * wave + i) * 16 + fr)) * 256 + ks * 32 + fq * 8);
        float o[4][2][4];
#pragma unroll
        for (int tt = 0; tt < 4; ++tt) {
            if (tt < ntb) {
                f32x4 a0 = (f32x4){0.f, 0.f, 0.f, 0.f}, a1 = a0;
#pragma unroll
                for (int ks = 0; ks < 8; ++ks) { const bf16x8 A = *(const LAS bf16x8*)(Z + (tt * 16 + fr) * 264 + ks * 32 + fq * 8); a0 = mfma16(A, Bw[0][ks], a0); a1 = mfma16(A, Bw[1][ks], a1); }
#pragma unroll
                for (int j = 0; j < 4; ++j) {
                    const int t = tt * 16 + fq * 4 + j;
                    const float z0 = bf2f(Z[t * 264 + (2 * wave) * 16 + fr]), z1 = bf2f(Z[t * 264 + (2 * wave + 1) * 16 + fr]);
                    const float o0 = z0 * sigmoidf_(a0[j]), o1 = z1 * sigmoidf_(a1[j]);
                    o[tt][0][j] = o0; o[tt][1][j] = o1;
                    float s = o0 * o0 + o1 * o1;
                    s += __shfl_xor(s, 1); s += __shfl_xor(s, 2); s += __shfl_xor(s, 4); s += __shfl_xor(s, 8);
                    if (fr == 0) RED[wave * 64 + t] = s;
                }
            }
        }
        __syncthreads();
#pragma unroll
        for (int tt = 0; tt < 4; ++tt) {
            if (tt < ntb) {
#pragma unroll
                for (int j = 0; j < 4; ++j) {
                    const int t = tt * 16 + fq * 4 + j;
                    float tot = 0.f;
#pragma unroll
                    for (int w = 0; w < 8; ++w) tot += RED[w * 64 + t];
                    const float rs = rsqrtf(tot * (1.f / 256.f) + EPS);
                    bf16_t* yp = Yw + (size_t)(row0 + t) * 1024 + (2 * wave) * 16 + fr;
                    yp[0] = f2bf(o[tt][0][j] * rs); yp[16] = f2bf(o[tt][1][j] * rs);
                }
            }
        }
    }
    __syncthreads();
}
DI void m2_phase(CParams& P, int l, LAS unsigned char* lds, const int tid, bf16_t* Yw, const int bid, const int nb) {
    if (nb == 256) {
        { int t2 = tid; asm volatile("" : "+v"(t2)); m2_item(P, l, bid, lds, t2, Yw); }
        if ((bid & 63) < 8) { int t2 = tid; asm volatile("" : "+v"(t2)); m2_item(P, l, 256 + (bid >> 6) * 8 + (bid & 7), lds, t2, Yw); }
    } else
    for (int id = bid; id < 288; id += nb) { int t2 = tid; asm volatile("" : "+v"(t2)); m2_item(P, l, id, lds, t2, Yw); }
}

DI void final_phase(CParams& P, const int tid, const int bid, const int nb) {
    const int lane = tid & 63, wave = tid >> 6;
    const float* ss = (const float*)(P.ws + WS_SS);
    const float* g = P.in[37];
    f32x4 gv[4];
#pragma unroll
    for (int i = 0; i < 4; ++i) gv[i] = *(const f32x4*)(g + i * 256 + lane * 4);
    const bf16_t* xb = (const bf16_t*)(P.ws + WS_XB);
    for (int row = bid * 8 + wave; row < MT; row += nb * 8) {
        const float rs = row_rstd(ss, row, 1.f / 1024.f);
        float* x = P.out + (size_t)row * 1024;
        u32x2 w[4];
#pragma unroll
        for (int i = 0; i < 4; ++i) w[i] = *(const u32x2*)(xb + (size_t)row * 1024 + i * 256 + lane * 4);
#pragma unroll
        for (int i = 0; i < 4; ++i) { f32x4 v; v[0] = __uint_as_float(w[i].x << 16); v[1] = __uint_as_float(w[i].x & 0xffff0000u); v[2] = __uint_as_float(w[i].y << 16); v[3] = __uint_as_float(w[i].y & 0xffff0000u);
            v = v * rs * gv[i]; *(f32x4*)(x + i * 256 + lane * 4) = v; }
    }
}


template <int K>
DI void sgemm_resid(const bf16_t* A  , const bf16_t* Bt  , const float* xin  , bf16_t* xb, float* ss  , float scale, bool first,
                    LAS unsigned char* lds, const int tid, const int bid, const int nb) {
    const int wave = tid >> 6, lane = tid & 63, fr = lane & 15, fq = lane >> 4;
    constexpr int KW = K / 8, NS = KW / 32;
    LAS float* PART = (LAS float*)lds;
    for (int it = bid; it < 256; it += nb) {
        const int r0 = (it >> 4) * 32, c0 = (it & 15) * 64, k0 = wave * KW;
        f32x4 acc[2][4];
#pragma unroll
        for (int i = 0; i < 2; ++i)
#pragma unroll
            for (int j = 0; j < 4; ++j) acc[i][j] = (f32x4){0.f, 0.f, 0.f, 0.f};
        const bf16_t* ap = A + (size_t)(r0 + fr) * K + k0 + fq * 8;
        const bf16_t* bp = Bt + (size_t)(c0 + fr) * K + k0 + fq * 8;
#pragma unroll
        for (int kb = 0; kb < NS; kb += 4) {
            bf16x8 a[4][2], b[4][4];
#pragma unroll
            for (int s4 = 0; s4 < 4; ++s4) {
                if (kb + s4 < NS) {
#pragma unroll
                    for (int i = 0; i < 2; ++i) a[s4][i] = *(const bf16x8*)(ap + (size_t)i * 16 * K + (kb + s4) * 32);
#pragma unroll
                    for (int j = 0; j < 4; ++j) b[s4][j] = *(const bf16x8*)(bp + (size_t)j * 16 * K + (kb + s4) * 32);
                }
            }
            __builtin_amdgcn_sched_barrier(0);
#pragma unroll
            for (int s4 = 0; s4 < 4; ++s4) {
                if (kb + s4 < NS) {
#pragma unroll
                    for (int i = 0; i < 2; ++i)
#pragma unroll
                        for (int j = 0; j < 4; ++j) acc[i][j] = mfma16(b[s4][j], a[s4][i], acc[i][j]);
                }
            }
            __builtin_amdgcn_sched_barrier(0);
        }
#pragma unroll
        for (int i = 0; i < 2; ++i)
#pragma unroll
            for (int j = 0; j < 4; ++j) *(LAS f32x4*)(PART + wave * 2048 + (i * 16 + fr) * 64 + j * 16 + fq * 4) = acc[i][j];
        __syncthreads();
        {
            const int row = tid >> 4, c4 = (tid & 15) * 4;
            f32x4 sum = *(const LAS f32x4*)(PART + row * 64 + c4);
#pragma unroll
            for (int w = 1; w < 8; ++w) sum += *(const LAS f32x4*)(PART + w * 2048 + row * 64 + c4);
            const size_t off = (size_t)(r0 + row) * 1024 + c0 + c4;
            f32x4 xo;
            if (first) xo = *(const f32x4*)(xin + off);
            else { const u32x2 o = *(const u32x2*)(xb + off); xo[0] = __uint_as_float(o.x << 16); xo[1] = __uint_as_float(o.x & 0xffff0000u); xo[2] = __uint_as_float(o.y << 16); xo[3] = __uint_as_float(o.y & 0xffff0000u); }
            const f32x4 v = xo + sum * scale;
            u32x2 pk; pk.x = cvt_pk_bf16(v[0], v[1]); pk.y = cvt_pk_bf16(v[2], v[3]);
            *(u32x2*)(xb + off) = pk;
            float sq = (v[0] * v[0] + v[1] * v[1]) + (v[2] * v[2] + v[3] * v[3]);
            sq += __shfl_xor(sq, 1); sq += __shfl_xor(sq, 2); sq += __shfl_xor(sq, 4); sq += __shfl_xor(sq, 8);
            if ((tid & 15) == 0) ss[(size_t)(r0 + row) * 16 + (it & 15)] = sq;
        }
        __syncthreads();
    }
}

__global__ void __launch_bounds__(NTHR) hymba_fwd(Params Pa) {
    extern __shared__ __attribute__((aligned(16))) unsigned char lds_raw[];
    LAS unsigned char* lds = (LAS unsigned char*)lds_raw;
    cg::grid_group grid = cg::this_grid();
    volatile LAS unsigned* xb_st = (volatile LAS unsigned*)((LAS unsigned char*)lds_raw + LDS_BYTES - 16);
    const int wv = __builtin_amdgcn_readfirstlane((int)(threadIdx.x >> 6));
    if (threadIdx.x == 0) { xb_st[0] = 0u; xb_st[1] = 0u; }
    __syncthreads();
    const XcdBarrier xbar = xcd_barrier_post((unsigned*)(Pa.ws + WS_BAR), xb_st);
    const int ph_lo = Pa.ph_lo, ph_hi = Pa.ph_hi;
    for (int ph = ph_lo; ph < ph_hi; ++ph) {
        CParams* Pk = (CParams*)__builtin_amdgcn_kernarg_segment_ptr();
        asm volatile("" : "+s"(Pk));
        CParams& P = *Pk;
        int wvl_ = wv; asm volatile("" : "+s"(wvl_));
        int tid = wvl_ * 64 + (int)__builtin_amdgcn_mbcnt_hi(~0u, __builtin_amdgcn_mbcnt_lo(~0u, 0u)); asm volatile("" : "+v"(tid));
        int bid = blockIdx.x, nb = gridDim.x; asm volatile("" : "+s"(bid), "+s"(nb));
        unsigned char* ws = P.ws;
        bf16_t* XB = (bf16_t*)(ws + WS_XB); bf16_t* Y = (bf16_t*)(ws + WS_Y); bf16_t* ACT = (bf16_t*)(ws + WS_BIG);
        float* SS = (float*)(ws + WS_SS);
        if (ph == 0) { prep_phase(P, lds, tid, bid, nb); if (DUP & 1) { grid.sync(); prep_phase(P, lds, tid, bid, nb); } }
        else if (ph == 17) final_phase(P, tid, bid, nb);
        else {
            const int l = (ph - 1) >> 3, s = (ph - 1) & 7;
            if (s == 0 || s == 6) {
                const int f = s == 6;
                pg8::Gemm g{XB, (const bf16_t*)(ws + WS_WGU + (size_t)(l * 2 + f) * SZ_WGU), MT, 5632, 1024};
                pg8::StaticOrder S; S.init(MT, 5632, nb, bid);
                EpiGateUp E{ACT, SS};
                pg8::gemm_phase<EpiGateUp, pg8::StaticOrder, GEMM_ALIGN, GEMM_SP2>(lds, g, S, E, tid);
                if (l == 0) {
                    const int rounds = (1452 + nb - 1) / nb, b0 = 1452 - (rounds - 1) * nb;
                    const int t0 = f ? 2432 + 1216 : 704, t1 = f ? 4864 : 2432;
                    if (b0 < nb) { if (bid >= b0) convert_tiles(P, lds, tid, bid - b0, nb - b0, t0, t1); }
                    else convert_tiles(P, lds, tid, bid, nb, t0, t1);
                }
            } else if (s == 1 || s == 7) {
                const int f = s == 7;
                const bf16_t* Wd = (const bf16_t*)(ws + WS_WD + (size_t)(l * 2 + f) * SZ_WD);
                pg8::Gemm g{ACT, Wd, MP, 1024, 2816};
                pg8::StaticOrder S; S.init(MP, 1024, nb, bid);
                const bool first = false;
                EpiResid E{P.in[0], XB, SS, 0.5f, first};
                pg8::gemm_phase<EpiResid, pg8::StaticOrder, GEMM_ALIGN, GEMM_SP2>(lds, g, S, E, tid);
                sgemm_resid<2816>(ACT + (size_t)MP * DFF, Wd, P.in[1], XB + (size_t)MP * 1024, SS + (size_t)MP * 16, 0.5f, first, lds, tid, bid, nb);
            } else if (s == 2) {
                pg8::Gemm g{XB, (const bf16_t*)(ws + WS_WIN + (size_t)l * SZ_WIN), MT, 1536, 1024};
                pg8::StaticOrder S; S.init(MT, 1536, nb, bid);
                EpiProj E{SS, Y, (float*)(ws + WS_XL), (bf16_t*)(ws + WS_KBP), (bf16_t*)(ws + WS_VTP),
                          (bf16_t*)(ws + WS_KBS + (size_t)l * SZ_KBS), (bf16_t*)(ws + WS_VTS + (size_t)l * SZ_KBS),
                          P.out + O_KP + (size_t)l * 4 * 128 * 128, P.out + O_VP + (size_t)l * 4 * 128 * 128, P.out + O_KS + (size_t)l * 32 * 16 * 128, P.out + O_VS + (size_t)l * 32 * 16 * 128};
                pg8::gemm_phase<EpiProj, pg8::StaticOrder, GEMM_ALIGN, GEMM_SP2>(lds, g, S, E, tid);
                if (l == 0) {
                    const int rounds = (396 + nb - 1) / nb, b0 = 396 - (rounds - 1) * nb;
                    if (b0 < nb) { if (bid >= b0) convert_tiles(P, lds, tid, bid - b0, nb - b0, 2432, 2432 + 1216); }
                    else convert_tiles(P, lds, tid, bid, nb, 2432, 2432 + 1216);
                }
            } else if (s == 3) { if (DUP & (2 | 32 | 64 | 128)) { m1_phase(P, l, lds, tid, XB, bid, nb, (DUP & 2) ? 0 : (DUP & 32) ? 0 : (DUP & 64) ? 256 : 544, (DUP & 2) ? 832 : (DUP & 32) ? 256 : (DUP & 64) ? 544 : 832); grid.sync(); } m1_phase(P, l, lds, tid, Y, bid, nb); }
            else if (s == 4) { if (DUP & 4) { m2_phase(P, l, lds, tid, XB, bid, nb); grid.sync(); } m2_phase(P, l, lds, tid, Y, bid, nb); }
            else {
                const bf16_t* Wo = (const bf16_t*)(ws + WS_WOUT + (size_t)l * SZ_WOUT);
                pg8::Gemm g{Y, Wo, MP, 1024, 1024};
                pg8::StaticOrder S; S.init(MP, 1024, nb, bid);
                EpiResid E{P.in[0], XB, SS, 1.0f, false};
                pg8::gemm_phase<EpiResid, pg8::StaticOrder, GEMM_ALIGN, GEMM_SP2>(lds, g, S, E, tid);
                sgemm_resid<1024>(Y + (size_t)MP * 1024, Wo, P.in[1], XB + (size_t)MP * 1024, SS + (size_t)MP * 16, 1.0f, false, lds, tid, bid, nb);
            }
        }
        if (ph + 1 < ph_hi) { if (ph_hi == 0x7fff) grid.sync(); else xcd_barrier(xbar, tid == 0); }
    }
}

#ifndef DUP
#define DUP 0
#endif
#ifndef N_PHASE_LAUNCH
#define N_PHASE_LAUNCH 0
#endif
extern "C" void kernel_launch(void* const* d_in, const int* in_sizes, int n_in, void* d_out, int out_size, void* d_ws, size_t ws_size, hipStream_t stream) {
    static int grid_blocks = 0;
    if (!grid_blocks) {
        int dev = 0, cus = 0, per_cu = 0;
        hipGetDevice(&dev);
        hipDeviceGetAttribute(&cus, hipDeviceAttributeMultiprocessorCount, dev);
        if (hipFuncSetAttribute((const void*)hymba_fwd, hipFuncAttributeMaxDynamicSharedMemorySize, LDS_BYTES) != hipSuccess) fprintf(stderr, "hipFuncSetAttribute failed\n");
        if (hipOccupancyMaxActiveBlocksPerMultiprocessor(&per_cu, (const void*)hymba_fwd, NTHR, LDS_BYTES) != hipSuccess || per_cu < 1) { fprintf(stderr, "occupancy query: %d\n", per_cu); per_cu = 1; }
        (void)hipGetLastError();
        if (per_cu > 1) per_cu = 1;
        grid_blocks = cus * per_cu;
        if (n_in != 38 || (size_t)out_size != O_END || ws_size < WS_END) fprintf(stderr, "kernel_launch: unexpected sizes n_in %d out %d ws %zu\n", n_in, out_size, ws_size);
    }
    if (hipMemsetAsync((unsigned char*)d_ws + WS_BAR, 0, (size_t)XCD_BAR_WORDS * 4, stream) != hipSuccess) fprintf(stderr, "memset of barrier words failed\n");
    Params p{};
    for (int i = 0; i < 38; ++i) p.in[i] = (const float*)d_in[i];
    p.out = (float*)d_out; p.ws = (unsigned char*)d_ws;
#if N_PHASE_LAUNCH
    for (int ph = 0; ph < 18; ++ph) { p.ph_lo = ph; p.ph_hi = ph + 1; hipLaunchKernelGGL(hymba_fwd, dim3(grid_blocks), dim3(NTHR), LDS_BYTES, stream, p); }
#else
    p.ph_lo = 0; p.ph_hi = 18;
    void* args[] = {&p};
    hipError_t e = hipLaunchCooperativeKernel((const void*)hymba_fwd, dim3(grid_blocks), dim3(NTHR), args, LDS_BYTES, stream);
    if (e != hipSuccess) fprintf(stderr, "cooperative launch failed: %s (grid %d)\n", hipGetErrorString(e), grid_blocks);
#endif
}
```

```cpp
#include <hip/hip_runtime.h>
#include <hip/hip_cooperative_groups.h>
#include <cstdio>
namespace cg = cooperative_groups;
namespace pg8 {
#define PG8_LAS __attribute__((address_space(3)))
typedef unsigned short bf16_t;
typedef short bf16x8 __attribute__((ext_vector_type(8)));
typedef float f32x4 __attribute__((ext_vector_type(4)));
typedef unsigned u32x4 __attribute__((ext_vector_type(4)));
constexpr int BM = 256, BK = 64, HALF = 128, HTB = HALF * BK * 2  , STAGE_BYTES = 8 * HTB, NXCD = 8, WGM = 8;

__host__ __device__ __forceinline__ int lds_byte(int r, int c) { const int st = (r >> 4) * 2 + (c >> 5), rr = r & 15, cc = c & 31, ob = rr * 64 + cc * 2; return st * 1024 + (ob ^ (((ob >> 9) & 1) << 5)); }
__host__ __device__ __forceinline__ void stage_rc(int b, int& R, int& C) { const int st = b / 1024, sb = b % 1024, swz = sb ^ (((sb >> 9) & 1) << 5); R = (st >> 1) * 16 + swz / 64; C = (st & 1) * 32 + (swz % 64) / 2; }
__host__ __device__ __forceinline__ int perm32(int rho) { const int n = rho >> 4, i = rho & 15; return 8 * (i >> 2) + 4 * n + (i & 3); }

struct Unit { int pm, pn; };
struct Gemm { const bf16_t* A; const bf16_t* Bt; int M, N, K; };

struct StaticOrder {
    int nM, nN, nwg, G, c;
    __host__ __device__ void init(int M, int N, int G_, int c_) { nM = M / BM; nN = N / BM; nwg = nM * nN; G = G_; c = c_; }
    __host__ __device__ bool next(int i, Unit& u) const {
        const long L = (long)i * G + c; if (L >= nwg) return false;
        int wgid = (int)L; { const int q = nwg / NXCD, r = nwg % NXCD, xcd = wgid % NXCD, off = wgid / NXCD; wgid = (xcd < r ? xcd * (q + 1) : r * (q + 1) + (xcd - r) * q) + off; }
        const int nig = WGM * nN, gid = wgid / nig, fm = gid * WGM, gsz = (nM - fm) < WGM ? (nM - fm) : WGM;
        u.pm = fm + ((wgid % nig) % gsz); u.pn = (wgid % nig) / gsz; return true;
    }
    __device__ __forceinline__ void a_ready(const Unit&) const {}
    __device__ __forceinline__ void done(const Unit&) const {}
};
__device__ __forceinline__ unsigned cvt_pk_bf16(float lo, float hi) { unsigned r; asm volatile("v_cvt_pk_bf16_f32 %0, %1, %2" : "=v"(r) : "v"(lo), "v"(hi)); return r; }
typedef float f32x2 __attribute__((ext_vector_type(2)));
template <class Epi, class Sched, bool ALIGN_EPI = false, bool SP2 = false>
__device__ __forceinline__ void gemm_phase(PG8_LAS unsigned char* lds, const Gemm g, const Sched& S, const Epi& E, const int tid) {
    const int wid = __builtin_amdgcn_readfirstlane(tid >> 6), lane = tid & 63, wr = wid >> 2, wc = wid & 3, fr = lane & 15, fq = lane >> 4;
    const int K = g.K, nt = K / BK;
    unsigned voffA[2], voffB[2];
#pragma unroll
    for (int i = 0; i < 2; ++i) { int R, C; stage_rc(tid * 16 + i * 8192, R, C); const int Rb = Epi::PERM ? ((R & ~31) + perm32(R & 31)) : R;
        voffA[i] = (unsigned)(R * K + C) * 2u; voffB[i] = (unsigned)(Rb * K + C) * 2u; }
    const size_t kstep = (size_t)(BK * 2);
    const size_t hstep = (size_t)HALF * K * 2;
    const size_t tstep = 2 * hstep;
    const unsigned ldsw = (unsigned)wid * 1024u;
    const int aoff = lds_byte(wr * 64 + fr, fq * 8), boff = lds_byte(wc * 32 + fr, fq * 8);
#define PG8_SA(b, h) (((b) * 2 + (h)) * HTB)
#define PG8_SB(b, h) ((4 + (b) * 2 + (h)) * HTB)
#define PG8_STAGE(bufoff, gbase, voff) do { _Pragma("unroll") for (int _i = 0; _i < 2; ++_i) \
        __builtin_amdgcn_global_load_lds((const unsigned*)((const char*)(gbase) + (voff)[_i]), (PG8_LAS unsigned*)(lds + (bufoff) + ldsw + _i * 8192), 16, 0, 0); } while (0)
#define PG8_LDA(dst, b, h) do { _Pragma("unroll") for (int m = 0; m < 4; ++m) _Pragma("unroll") for (int k = 0; k < 2; ++k) dst[m][k] = *(const PG8_LAS bf16x8*)(lds + PG8_SA(b, h) + aoff + m * 2048 + k * 1024); } while (0)
#define PG8_LDB(dst, b, h) do { _Pragma("unroll") for (int n = 0; n < 2; ++n) _Pragma("unroll") for (int k = 0; k < 2; ++k) dst[n][k] = *(const PG8_LAS bf16x8*)(lds + PG8_SB(b, h) + boff + n * 2048 + k * 1024); } while (0)
#define PG8_MMA(ai, bj, At, Bt) do { __builtin_amdgcn_s_setprio(1); _Pragma("unroll") for (int m = 0; m < 4; ++m) _Pragma("unroll") for (int n = 0; n < 2; ++n) _Pragma("unroll") for (int k = 0; k < 2; ++k) \
        acc[ai][bj][m][n] = __builtin_amdgcn_mfma_f32_16x16x32_bf16(Bt[n][k], At[m][k], acc[ai][bj][m][n], 0, 0, 0); __builtin_amdgcn_s_setprio(0); } while (0)
#define PG8_WAIT_V(n) asm volatile("s_waitcnt vmcnt(" #n ")" ::: "memory")
#define PG8_WAIT_L(n) asm volatile("s_waitcnt lgkmcnt(" #n ")" ::: "memory")
#define PG8_BAR __builtin_amdgcn_s_barrier()
#define PG8_SCHED __builtin_amdgcn_sched_barrier(0)
    Unit cur, nxt; int ui = 0;
    if (!S.next(0, cur)) return;
    f32x4 acc[2][2][4][2];
#pragma unroll
    for (int a = 0; a < 2; ++a)
#pragma unroll
        for (int b = 0; b < 2; ++b)
#pragma unroll
            for (int m = 0; m < 4; ++m)
#pragma unroll
                for (int n = 0; n < 2; ++n) acc[a][b][m][n] = (f32x4){0.f, 0.f, 0.f, 0.f};
    bf16x8 At[4][2], B0[2][2], B1[2][2];
    const char* cA = (const char*)g.A + (size_t)cur.pm * tstep; const char* cB = (const char*)g.Bt + (size_t)cur.pn * tstep;
    S.a_ready(cur);
    if constexpr (SP2) {
        PG8_STAGE(PG8_SB(0, 0), cB, voffB); PG8_STAGE(PG8_SB(0, 1), cB + hstep, voffB); PG8_STAGE(PG8_SA(0, 0), cA, voffA); PG8_STAGE(PG8_SA(0, 1), cA + hstep, voffA);
        if (wr == 1) PG8_BAR;
        PG8_WAIT_V(2); PG8_BAR;
        PG8_STAGE(PG8_SB(1, 0), cB + kstep, voffB); PG8_STAGE(PG8_SA(1, 0), cA + kstep, voffA); PG8_STAGE(PG8_SB(1, 1), cB + hstep + kstep, voffB);
        PG8_WAIT_V(6); PG8_BAR;
    } else {
        PG8_STAGE(PG8_SB(0, 0), cB, voffB); PG8_STAGE(PG8_SA(0, 0), cA, voffA); PG8_STAGE(PG8_SB(0, 1), cB + hstep, voffB); PG8_STAGE(PG8_SA(0, 1), cA + hstep, voffA);
        if (wr == 1) PG8_BAR;
        PG8_WAIT_V(4); PG8_BAR;
        PG8_STAGE(PG8_SB(1, 0), cB + kstep, voffB); PG8_STAGE(PG8_SA(1, 0), cA + kstep, voffA); PG8_STAGE(PG8_SB(1, 1), cB + hstep + kstep, voffB);
        PG8_WAIT_V(6); PG8_BAR;
    }
    for (;;) {
        const bool has_next = S.next(ui + 1, nxt);
        const char* nA = has_next ? (const char*)g.A + (size_t)nxt.pm * tstep : cA; const char* nB = has_next ? (const char*)g.Bt + (size_t)nxt.pn * tstep : cB;
        for (int t = 0; t < nt; t += 2) {
            const bool last = (t == nt - 2);
            const char* a1 = cA + (size_t)(t + 1) * kstep;
            const char* a2 = last ? nA : cA + (size_t)(t + 2) * kstep; const char* b2 = last ? nB : cB + (size_t)(t + 2) * kstep;
            const char* a3 = a2 + kstep; const char* b3 = b2 + kstep;
            if (last && has_next) S.a_ready(nxt);
            if constexpr (SP2) {
            PG8_LDB(B0, 0, 0); PG8_LDB(B1, 0, 1); PG8_SCHED; PG8_LDA(At, 0, 0); PG8_STAGE(PG8_SA(1, 1), a1 + hstep, voffA);
            PG8_WAIT_V(8); PG8_WAIT_L(0); PG8_BAR; PG8_MMA(0, 0, At, B0); PG8_MMA(0, 1, At, B1); PG8_BAR; PG8_SCHED;
            PG8_LDA(At, 0, 1); PG8_STAGE(PG8_SB(0, 0), b2, voffB); PG8_STAGE(PG8_SB(0, 1), b2 + hstep, voffB); PG8_STAGE(PG8_SA(0, 0), a2, voffA);
            PG8_WAIT_V(8); PG8_WAIT_L(0); PG8_BAR; PG8_MMA(1, 0, At, B0); PG8_MMA(1, 1, At, B1); PG8_BAR; PG8_SCHED;
            PG8_LDB(B0, 1, 0); PG8_LDB(B1, 1, 1); PG8_SCHED; PG8_LDA(At, 1, 0); PG8_STAGE(PG8_SA(0, 1), a2 + hstep, voffA);
            PG8_WAIT_V(8); PG8_WAIT_L(0); PG8_BAR; PG8_MMA(0, 0, At, B0); PG8_MMA(0, 1, At, B1); PG8_BAR; PG8_SCHED;
            PG8_LDA(At, 1, 1); PG8_STAGE(PG8_SB(1, 0), b3, voffB); PG8_STAGE(PG8_SB(1, 1), b3 + hstep, voffB); PG8_STAGE(PG8_SA(1, 0), a3, voffA);
            PG8_WAIT_V(8); PG8_WAIT_L(0); PG8_BAR; PG8_MMA(1, 0, At, B0); PG8_MMA(1, 1, At, B1); PG8_BAR; PG8_SCHED;
            } else {
            PG8_LDB(B0, 0, 0); PG8_SCHED; PG8_LDA(At, 0, 0); PG8_STAGE(PG8_SA(1, 1), a1 + hstep, voffA);
            PG8_WAIT_L(8); PG8_BAR; PG8_WAIT_L(0); PG8_MMA(0, 0, At, B0); PG8_BAR; PG8_SCHED;
            PG8_LDB(B1, 0, 1); PG8_STAGE(PG8_SB(0, 0), b2, voffB);
            PG8_BAR; PG8_WAIT_L(0); PG8_MMA(0, 1, At, B1); PG8_BAR;
            PG8_LDA(At, 0, 1); PG8_STAGE(PG8_SA(0, 0), a2, voffA);
            PG8_BAR; PG8_WAIT_L(0); PG8_MMA(1, 0, At, B0); PG8_BAR; PG8_SCHED;
            PG8_STAGE(PG8_SB(0, 1), b2 + hstep, voffB);
            PG8_WAIT_V(6); PG8_BAR; PG8_MMA(1, 1, At, B1); PG8_BAR;
            PG8_LDB(B0, 1, 0); PG8_SCHED; PG8_LDA(At, 1, 0); PG8_STAGE(PG8_SA(0, 1), a2 + hstep, voffA);
            PG8_WAIT_L(8); PG8_BAR; PG8_WAIT_L(0); PG8_MMA(0, 0, At, B0); PG8_BAR; PG8_SCHED;
            PG8_LDB(B1, 1, 1); PG8_STAGE(PG8_SB(1, 0), b3, voffB);
            PG8_BAR; PG8_WAIT_L(0); PG8_MMA(0, 1, At, B1); PG8_BAR;
            PG8_LDA(At, 1, 1); PG8_STAGE(PG8_SA(1, 0), a3, voffA);
            PG8_BAR; PG8_WAIT_L(0); PG8_MMA(1, 0, At, B0); PG8_BAR; PG8_SCHED;
            PG8_STAGE(PG8_SB(1, 1), b3 + hstep, voffB);
            PG8_WAIT_V(6); PG8_BAR; PG8_MMA(1, 1, At, B1); PG8_BAR;
            }
        }
        if constexpr (ALIGN_EPI) { if (wr == 0) PG8_BAR; }
        if constexpr (!Epi::AFTER_DRAIN) { E(acc, cur, wr, wc, fr, fq); S.done(cur); }
        if (!has_next) break;
#pragma unroll
        for (int a = 0; a < 2; ++a)
#pragma unroll
            for (int b = 0; b < 2; ++b)
#pragma unroll
                for (int m = 0; m < 4; ++m)
#pragma unroll
                    for (int n = 0; n < 2; ++n) acc[a][b][m][n] = (f32x4){0.f, 0.f, 0.f, 0.f};
        cur = nxt; cA = nA; cB = nB; ++ui;
        if constexpr (ALIGN_EPI) { if (wr == 1) PG8_BAR; }
    }
    PG8_WAIT_V(0);
    if constexpr (!ALIGN_EPI) { if (wr == 0) PG8_BAR; }
    PG8_BAR;
    if constexpr (Epi::AFTER_DRAIN) { E.fused(acc, cur, wr, wc, fr, fq, lds, wid, lane); S.done(cur); }
#undef PG8_SA
#undef PG8_SB
#undef PG8_STAGE
#undef PG8_LDA
#undef PG8_LDB
#undef PG8_MMA
#undef PG8_WAIT_V
#undef PG8_WAIT_L
#undef PG8_BAR
#undef PG8_SCHED
}
}
using pg8::bf16_t; using pg8::bf16x8; using pg8::f32x4; using pg8::u32x4; using pg8::f32x2; using pg8::cvt_pk_bf16;
#define LAS __attribute__((address_space(3)))
#define XB_TMO      128
#define XB_XCNT(j)  (256  + 64 * (j))
#define XB_XSUB(j)  (1280 + 64 * (j))
#define XB_XGEN(j)  (2304 + 64 * (j))
#define XB_TOP      3328
#define XB_TOPGEN   3392
#define XCD_BAR_WORDS 3456
#define XB_SPIN_CAP (1u << 18)

__device__ __forceinline__ unsigned xb_ld(unsigned* p)              { return __hip_atomic_load(p, __ATOMIC_RELAXED, __HIP_MEMORY_SCOPE_AGENT); }
__device__ __forceinline__ unsigned xb_add(unsigned* p, unsigned v) { return __hip_atomic_fetch_add(p, v, __ATOMIC_RELAXED, __HIP_MEMORY_SCOPE_AGENT); }
__device__ __forceinline__ unsigned xb_xcc_id() { return (unsigned)__builtin_amdgcn_s_getreg((3 << 11) | 20) & 0xFu; }
#define XB_SPIN(cond, bar) do { unsigned _sp = 0; while (cond) { __builtin_amdgcn_s_sleep(1); \
    if ((++_sp & 255u) == 0u) { if (xb_ld(&(bar)[XB_TMO])) break; if (_sp > XB_SPIN_CAP) { atomicAdd(&(bar)[XB_TMO], 1u); break; } } } } while (0)

struct XcdBarrier {
    unsigned* bar; unsigned x;
    volatile LAS unsigned* st;
};

__device__ __forceinline__ XcdBarrier xcd_barrier_post(unsigned* bar, volatile LAS unsigned* st) {
    XcdBarrier b; b.bar = bar; b.x = xb_xcc_id(); b.st = st;
    if (threadIdx.x == 0) (void)xb_add(&bar[XB_XCNT(b.x)], 1u);
    return b;
}
__device__ __forceinline__ void xcd_barrier_complete(unsigned* bar, unsigned x, unsigned& nloc, unsigned& nx) {
    const unsigned G = gridDim.x * gridDim.y * gridDim.z;
    unsigned sum, cnt, mine, sp = 0u;
    for (;;) {
        sum = 0u; cnt = 0u; mine = 0u;
#pragma unroll
        for (unsigned j = 0; j < 16; ++j) { const unsigned c = xb_ld(&bar[XB_XCNT(j)]); sum += c; cnt += (c > 0u) ? 1u : 0u; mine = (j == x) ? c : mine; }
        if (sum == G) break;
        __builtin_amdgcn_s_sleep(1);
        if ((++sp & 255u) == 0u) { if (xb_ld(&bar[XB_TMO])) break; if (sp > XB_SPIN_CAP) { atomicAdd(&bar[XB_TMO], 1u); break; } }
    }
    nloc = mine > 0u ? mine : 1u; nx = cnt > 0u ? cnt : 1u;
}

__device__ __forceinline__ void xcd_barrier(const XcdBarrier& b, const bool leader_thread) {
    asm volatile("s_waitcnt vmcnt(0)" ::: "memory");
    __syncthreads();
    if (leader_thread) {
        unsigned* bar = b.bar;
        __builtin_amdgcn_s_waitcnt(0);
        unsigned nloc = b.st[0], nx = b.st[1];
        if (nloc == 0u) { xcd_barrier_complete(bar, b.x, nloc, nx); b.st[0] = nloc; b.st[1] = nx; }
        const unsigned old = xb_add(&bar[XB_XSUB(b.x)], 1u);
        const unsigned gen = old / nloc;
        if (old + 1u == (gen + 1u) * nloc) {
            __builtin_amdgcn_fence(__ATOMIC_RELEASE, "agent");
            asm volatile("s_waitcnt vmcnt(0)" ::: "memory");
            const unsigned og = xb_add(&bar[XB_TOP], 1u);
            const unsigned tg = og / nx;
            if (og + 1u == (tg + 1u) * nx) xb_add(&bar[XB_TOPGEN], 1u);
            else XB_SPIN(xb_ld(&bar[XB_TOPGEN]) == tg, bar);
            __builtin_amdgcn_fence(__ATOMIC_ACQUIRE, "agent");
            xb_add(&bar[XB_XGEN(b.x)], 1u);
            asm volatile("s_waitcnt vmcnt(0)" ::: "memory");
        } else {
            XB_SPIN(xb_ld(&bar[XB_XGEN(b.x)]) == gen, bar);
            __builtin_amdgcn_fence(__ATOMIC_ACQUIRE, "agent");
            asm volatile("s_waitcnt vmcnt(0)" ::: "memory");
        }
    }
    __syncthreads();
}

typedef unsigned u32x2 __attribute__((ext_vector_type(2)));
typedef short s16x4 __attribute__((ext_vector_type(4)));
#define DI __device__ __forceinline__
#ifndef GEMM_SP2
#define GEMM_SP2 true
#endif
#ifndef GEMM_ALIGN
#define GEMM_ALIGN true
#endif
#ifndef DUP
#define DUP 0
#endif

constexpr int DM = 1024, MP = 16384, MS = 512, MT = 16896, DFF = 2816, NIN = 1536;
constexpr float EPS = 1e-6f;
constexpr int NTHR = 512;
constexpr int LDS_BYTES = 152 * 1024;

constexpr size_t SZ_WGU = (size_t)5632 * 1024 * 2, SZ_WD = (size_t)1024 * 2816 * 2, SZ_WIN = (size_t)1536 * 1024 * 2, SZ_WOUT = (size_t)1024 * 1024 * 2;
constexpr size_t WS_WGU = 0;
constexpr size_t WS_WD = WS_WGU + 4 * SZ_WGU;
constexpr size_t WS_WIN = WS_WD + 4 * SZ_WD;
constexpr size_t WS_WOUT = WS_WIN + 2 * SZ_WIN;
constexpr size_t SZ_XB = (size_t)MT * 1024 * 2;
constexpr size_t WS_XB = WS_WOUT + 2 * SZ_WOUT;
constexpr size_t WS_Y = WS_XB + SZ_XB;
constexpr size_t WS_BIG = WS_Y + SZ_XB;
constexpr size_t SZ_BIG = (size_t)MT * DFF * 2;
constexpr size_t SZ_F256 = (size_t)MT * 256 * 4;
constexpr size_t WS_XL = WS_BIG, WS_HL = WS_XL + SZ_F256, WS_PC = WS_HL + SZ_F256, WS_KBP = WS_PC + SZ_F256;
constexpr size_t SZ_KBP = (size_t)4 * 4096 * 128 * 2;
constexpr size_t WS_VTP = WS_KBP + SZ_KBP;
static_assert(WS_VTP + SZ_KBP <= WS_BIG + SZ_BIG, "mixer scratch must fit in the act buffer");
constexpr size_t WS_SS = WS_BIG + SZ_BIG;
constexpr size_t WS_KBS = WS_SS + (size_t)MT * 16 * 4;
constexpr size_t SZ_KBS = (size_t)32 * 160 * 128 * 2;
constexpr size_t WS_VTS = WS_KBS + 2 * SZ_KBS;
constexpr size_t WS_SSUM = WS_VTS + 2 * SZ_KBS;
constexpr size_t WS_LSUM = WS_SSUM + (size_t)4 * 64 * 16 * 64 * 8;
constexpr size_t WS_SPAR = WS_LSUM + (size_t)4 * 64 * 2 * 256 * 4;
constexpr size_t SZ_SPAR = 16384 + 131072;
constexpr size_t WS_CC = WS_SPAR + 2 * SZ_SPAR;
constexpr size_t WS_WGLU = WS_CC + 2 * 65536;
constexpr size_t WS_WAX = WS_WGLU + 2 * 131072;
constexpr size_t WS_BAR = WS_WAX + 2 * 65536;
constexpr size_t WS_BBF = WS_BAR + (size_t)XCD_BAR_WORDS * 4;
constexpr size_t WS_END = WS_BBF + (size_t)2 * 16 * 128 * 32 * 2;
static_assert(WS_END <= (size_t)256 * 1024 * 1024, "workspace budget");

constexpr size_t O_YP = 0, O_YS = (size_t)MP * 1024, O_KP = O_YS + (size_t)MS * 1024, O_VP = O_KP + 131072, O_SREP = O_VP + 131072, O_SIMP = O_SREP + 8192,
                 O_CONVP = O_SIMP + 8192, O_LRUP = O_CONVP + 6144, O_KS = O_LRUP + 2048, O_VS = O_KS + 131072, O_SRES = O_VS + 131072, O_SIMS = O_SRES + 65536,
                 O_CONVS = O_SIMS + 65536, O_LRUS = O_CONVS + 49152, O_END = O_LRUS + 16384;

struct Params { const float* in[38]; float* out; unsigned char* ws; int ph_lo, ph_hi; };
typedef const Params __attribute__((address_space(4))) CParams;

DI float bf2f(bf16_t v) { return __uint_as_float(((unsigned)v) << 16); }
DI bf16_t f2bf(float f) { return (bf16_t)(cvt_pk_bf16(f, 0.f) & 0xffffu); }
DI float sigmoidf_(float x) { return __builtin_amdgcn_rcpf(1.f + __expf(-x)); }
DI float gelu_tanh(float x) { const float v = 1.5957691216057308f * (x + 0.044715f * x * x * x); return x * __builtin_amdgcn_rcpf(1.f + __expf(-v)); }
DI f32x4 mfma16(bf16x8 a, bf16x8 b, f32x4 c) { return __builtin_amdgcn_mfma_f32_16x16x32_bf16(a, b, c, 0, 0, 0); }
DI f32x2 cmul(f32x2 a, f32x2 b) { return (f32x2){a.x * b.x - a.y * b.y, a.x * b.y + a.y * b.x}; }
DI float row_rstd(const float* ss, int row, float invn) {
    const f32x4* p = (const f32x4*)(ss + (size_t)row * 16); const f32x4 a = p[0], b = p[1], c = p[2], d = p[3];
    const f32x4 t = (a + b) + (c + d); return rsqrtf(((t[0] + t[1]) + (t[2] + t[3])) * invn + EPS);
}
DI void lds_fence() { asm volatile("s_waitcnt lgkmcnt(0)" ::: "memory"); }

DI void unit_rstd8(const float* ss, int row0, int fq, float (&rs)[8]) {
    f32x4 q[8];
#pragma unroll
    for (int i = 0; i < 8; ++i) q[i] = *(const f32x4*)(ss + (size_t)(row0 + (i >> 2) * 128 + (i & 3) * 16) * 16 + fq * 4);
#pragma unroll
    for (int i = 0; i < 8; ++i) { float t = (q[i][0] + q[i][1]) + (q[i][2] + q[i][3]); t += __shfl_xor(t, 16); t += __shfl_xor(t, 32); rs[i] = rsqrtf(t * (1.f / 1024.f) + EPS); }
}
struct EpiGateUp {
    static constexpr bool PERM = true, AFTER_DRAIN = false;
    bf16_t* act; const float* ss;
    DI void operator()(const f32x4 (&acc)[2][2][4][2], const pg8::Unit& u, int wr, int wc, int fr, int fq) const {
        const int row0 = u.pm * 256 + wr * 64 + fr, col = u.pn * 128 + wc * 32 + 8 * fq;
        float rs8[8]; unit_rstd8(ss, row0, fq, rs8);
#pragma unroll
        for (int ai = 0; ai < 2; ++ai)
#pragma unroll
            for (int m = 0; m < 4; ++m) {
                const int row = row0 + ai * 128 + m * 16;
                const float rs = rs8[ai * 4 + m];
                f32x2 o2[4];
#pragma unroll
                for (int n = 0; n < 2; ++n)
#pragma unroll
                    for (int hh = 0; hh < 2; ++hh) {
                        const f32x2 g = (f32x2){acc[ai][0][m][n][2 * hh], acc[ai][0][m][n][2 * hh + 1]} * rs, up = (f32x2){acc[ai][1][m][n][2 * hh], acc[ai][1][m][n][2 * hh + 1]} * rs;
                        const f32x2 t = g * (-1.44269504089f);
                        f32x2 e; e.x = __builtin_amdgcn_exp2f(t.x); e.y = __builtin_amdgcn_exp2f(t.y);
                        const f32x2 d = e + 1.0f;
                        f32x2 r; r.x = __builtin_amdgcn_rcpf(d.x); r.y = __builtin_amdgcn_rcpf(d.y);
                        o2[n * 2 + hh] = (g * r) * up;
                    }
                u32x4 w; w.x = cvt_pk_bf16(o2[0].x, o2[0].y); w.y = cvt_pk_bf16(o2[1].x, o2[1].y); w.z = cvt_pk_bf16(o2[2].x, o2[2].y); w.w = cvt_pk_bf16(o2[3].x, o2[3].y);
                *(u32x4*)(act + (size_t)row * DFF + col) = w;
            }
    }
};
struct EpiResid {
    static constexpr bool PERM = true, AFTER_DRAIN = false;
    const float* xin_p; bf16_t* xb; float* ssout; float scale; bool first;
    DI void operator()(const f32x4 (&acc)[2][2][4][2], const pg8::Unit& u, int wr, int wc, int fr, int fq) const {
        const int row0 = u.pm * 256 + wr * 64 + fr, colb = u.pn * 256 + wc * 32 + 8 * fq;
#pragma unroll
        for (int ai = 0; ai < 2; ++ai)
#pragma unroll
            for (int m = 0; m < 4; ++m) {
                const int row = row0 + ai * 128 + m * 16;
                bf16_t* xbo = xb + (size_t)row * 1024;
                float s = 0.f;
#pragma unroll
                for (int bj = 0; bj < 2; ++bj) {
                    const int col = colb + bj * 128;
                    f32x4 a0, a1;
                    if (first) { const float* xi = xin_p + (size_t)row * 1024 + col; a0 = *(const f32x4*)xi; a1 = *(const f32x4*)(xi + 4); }
                    else { const u32x4 o = *(const u32x4*)(xbo + col);
                        a0[0] = __uint_as_float(o.x << 16); a0[1] = __uint_as_float(o.x & 0xffff0000u); a0[2] = __uint_as_float(o.y << 16); a0[3] = __uint_as_float(o.y & 0xffff0000u);
                        a1[0] = __uint_as_float(o.z << 16); a1[1] = __uint_as_float(o.z & 0xffff0000u); a1[2] = __uint_as_float(o.w << 16); a1[3] = __uint_as_float(o.w & 0xffff0000u); }
                    const f32x4 v0 = a0 + acc[ai][bj][m][0] * scale, v1 = a1 + acc[ai][bj][m][1] * scale;
                    u32x4 w; w.x = cvt_pk_bf16(v0[0], v0[1]); w.y = cvt_pk_bf16(v0[2], v0[3]); w.z = cvt_pk_bf16(v1[0], v1[1]); w.w = cvt_pk_bf16(v1[2], v1[3]);
                    *(u32x4*)(xbo + col) = w;
                    s += (v0[0] * v0[0] + v0[1] * v0[1]) + (v0[2] * v0[2] + v0[3] * v0[3]) + (v1[0] * v1[0] + v1[1] * v1[1]) + (v1[2] * v1[2] + v1[3] * v1[3]);
                }
                s += __shfl_xor(s, 16); s += __shfl_xor(s, 32);
                if (fq == 0) ssout[(size_t)row * 16 + u.pn * 4 + wc] = s;
                if (m == 3) asm volatile("" ::: "memory");
            }
    }
};
struct EpiProj {
    static constexpr bool PERM = true, AFTER_DRAIN = false;
    const float* ss; bf16_t* y; float* xl; bf16_t* kbp; bf16_t* vtp; bf16_t* kbs; bf16_t* vts; float* okp; float* ovp; float* oks; float* ovs;
    DI void operator()(const f32x4 (&acc)[2][2][4][2], const pg8::Unit& u, int wr, int wc, int fr, int fq) const {
        const int row0 = u.pm * 256 + wr * 64 + fr, cl = wc * 32 + 8 * fq;
        const int pn = u.pn;
        float rs8[8]; unit_rstd8(ss, row0, fq, rs8);
#pragma unroll
        for (int ai = 0; ai < 2; ++ai)
#pragma unroll
            for (int m = 0; m < 4; ++m) {
                const int row = row0 + ai * 128 + m * 16;
                float rs = rs8[ai * 4 + m];
                if (pn == 4) {
#pragma unroll
                    for (int bj = 0; bj < 2; ++bj) { float* d = xl + (size_t)row * 256 + bj * 128 + cl; *(f32x4*)d = acc[ai][bj][m][0] * rs; *(f32x4*)(d + 4) = acc[ai][bj][m][1] * rs; }
                } else if (pn == 3) {
                    const int kvh = cl >> 6, d0 = cl & 63;
                    const bool prm = row < MP;
                    const int b = prm ? (row >> 12) : ((row - MP) >> 4), pos = prm ? (row & 4095) : ((row - MP) & 15);
                    const bool wout = prm ? (pos >= 3968) : true;
                    const unsigned oo = prm ? (unsigned)((b * 128 + (pos - 3968)) * 128 + cl) : (unsigned)((b * 16 + pos) * 128 + cl);
                    {
                        const f32x4 v0 = acc[ai][0][m][0] * rs, v1 = acc[ai][0][m][1] * rs;
                        if (wout) { float* of = (prm ? okp : oks) + oo; *(f32x4*)of = v0; *(f32x4*)(of + 4) = v1; }
                        u32x4 w; w.x = cvt_pk_bf16(v0[0], v0[1]); w.y = cvt_pk_bf16(v0[2], v0[3]); w.z = cvt_pk_bf16(v1[0], v1[1]); w.w = cvt_pk_bf16(v1[2], v1[3]);
                        bf16_t* kd = prm ? kbp + (unsigned)(row * 128 + cl) : kbs + (unsigned)((b * 160 + 128 + pos) * 128 + cl);
                        *(u32x4*)kd = w;
                    }
                    {
                        const f32x4 v0 = acc[ai][1][m][0] * rs, v1 = acc[ai][1][m][1] * rs;
                        if (wout) { float* of = (prm ? ovp : ovs) + oo; *(f32x4*)of = v0; *(f32x4*)(of + 4) = v1; }
                        const unsigned vstride = prm ? 4096u : 160u;
                        bf16_t* vd = prm ? vtp + (unsigned)(((b * 2 + kvh) * 64 + d0) * 4096 + pos) : vts + (unsigned)(((b * 2 + kvh) * 64 + d0) * 160 + 128 + pos);
#pragma unroll
                        for (int jj = 0; jj < 4; ++jj) { vd[jj * vstride] = f2bf(v0[jj]); vd[(jj + 4) * vstride] = f2bf(v1[jj]); }
                    }
                } else {
                    const int cbase = (pn == 0) ? 0 : (pn == 5 ? 768 : 256 + (pn - 1) * 256);
                    if (pn == 1 || pn == 2) rs *= 0.125f;
#pragma unroll
                    for (int bj = 0; bj < 2; ++bj) {
                        const f32x4 v0 = acc[ai][bj][m][0] * rs, v1 = acc[ai][bj][m][1] * rs;
                        u32x4 w; w.x = cvt_pk_bf16(v0[0], v0[1]); w.y = cvt_pk_bf16(v0[2], v0[3]); w.z = cvt_pk_bf16(v1[0], v1[1]); w.w = cvt_pk_bf16(v1[2], v1[3]);
                        *(u32x4*)(y + (size_t)row * 1024 + cbase + bj * 128 + cl) = w;
                    }
                }
            }
    }
};
struct TileJob { const float* src; const float* gain; bf16_t* dst; int K, N, map, k0, n0; };
DI TileJob decode_tile(CParams& P, int tile) {
    unsigned char* ws = P.ws; TileJob J;
    const int l = tile / 2432, r = tile % 2432;
    int j, tl; if (r < 2112) { j = r / 352; tl = r % 352; } else if (r < 2304) { j = 6; tl = r - 2112; } else { j = 7; tl = r - 2304; }
    J.map = 0;
    if (j == 0 || j == 1 || j == 3 || j == 4) {
        const int f = j >= 3; const int which = (j == 1 || j == 4);
        J.src = P.in[(f ? 34 : 9) + which] + (size_t)l * 1024 * 2816; J.gain = P.in[f ? 33 : 8] + l * 1024; J.dst = (bf16_t*)(ws + WS_WGU + (size_t)(l * 2 + f) * SZ_WGU); J.K = 1024; J.N = 2816; J.map = 1 + which;
    } else if (j == 2 || j == 5) {
        const int f = j == 5; J.src = P.in[f ? 36 : 11] + (size_t)l * 2816 * 1024; J.gain = nullptr; J.dst = (bf16_t*)(ws + WS_WD + (size_t)(l * 2 + f) * SZ_WD); J.K = 2816; J.N = 1024;
    } else if (j == 6) { J.src = P.in[13] + (size_t)l * 1024 * 1536; J.gain = P.in[12] + l * 1024; J.dst = (bf16_t*)(ws + WS_WIN + (size_t)l * SZ_WIN); J.K = 1024; J.N = 1536; }
    else { J.src = P.in[32] + (size_t)l * 1024 * 1024; J.gain = P.in[31] + l * 1024; J.dst = (bf16_t*)(ws + WS_WOUT + (size_t)l * SZ_WOUT); J.K = 1024; J.N = 1024; }
    const int nkt = J.K / 128, kt = tl % nkt, nt = tl / nkt; J.k0 = kt * 128; J.n0 = nt * 64;
    return J;
}
DI void convert_tiles(CParams& P, LAS unsigned char* lds, const int tid, const int first, const int stride, const int tbeg, const int tend) {
    LAS bf16_t* T = (LAS bf16_t*)lds;
    {
        LAS bf16_t* T2_ = T + 64 * 136;
        int tA = tbeg + first, tB = tbeg + first + stride; const int NT = tend;
        f32x4 vA[4], vB[4]; float gA = 1.f, gB = 1.f;
        const int lk = tid >> 2, lns = (tid & 3) * 16;
#define T1_LOAD(tile, v, g) do { const TileJob J = decode_tile(P, tile); const float* sp = J.src + (size_t)(J.k0 + lk) * J.N + J.n0 + lns; g = J.gain ? J.gain[J.k0 + lk] : 1.f; \
            _Pragma("unroll") for (int i = 0; i < 4; ++i) v[i] = *(const f32x4*)(sp + 4 * i); } while (0)
#define T1_TOLDS(Tb, v, g) do { _Pragma("unroll") for (int i = 0; i < 4; ++i) _Pragma("unroll") for (int e = 0; e < 4; ++e) Tb[(lns + 4 * i + e) * 136 + lk] = f2bf(v[i][e] * g); } while (0)
#define T1_STORE(Tb, tile) do { const TileJob J = decode_tile(P, tile); const int n = tid >> 3, ks = (tid & 7) * 16; \
            const int ng = J.n0 + n; const int drow = (J.map == 0) ? ng : (256 * (ng >> 7) + (ng & 127) + (J.map == 2 ? 128 : 0)); \
            const u32x4 a = *(const LAS u32x4*)(Tb + n * 136 + ks), b = *(const LAS u32x4*)(Tb + n * 136 + ks + 8); \
            bf16_t* d = J.dst + (size_t)drow * J.K + J.k0 + ks; *(u32x4*)d = a; *(u32x4*)(d + 8) = b; } while (0)
        if (tA < NT) T1_LOAD(tA, vA, gA);
        if (tB < NT) T1_LOAD(tB, vB, gB);
        while (tA < NT) {
            T1_TOLDS(T, vA, gA);
            if (tB < NT) T1_TOLDS(T2_, vB, gB);
            __syncthreads();
            const int nA = tA + 2 * stride, nB = tB + 2 * stride;
            if (nA < NT) T1_LOAD(nA, vA, gA);
            if (nB < NT) T1_LOAD(nB, vB, gB);
            T1_STORE(T, tA);
            if (tB < NT) T1_STORE(T2_, tB);
            __syncthreads();
            tA = nA; tB = nB;
        }
#undef T1_LOAD
#undef T1_TOLDS
#undef T1_STORE
    }
}
DI void prep_phase(CParams& P, LAS unsigned char* lds, const int tid, const int bid, const int nb) {
    const int lane = tid & 63, wave = tid >> 6;
    unsigned char* ws = P.ws;
    convert_tiles(P, lds, tid, bid, nb, 0, 704);
    {
        bf16_t* xb = (bf16_t*)(ws + WS_XB); float* ss0 = (float*)(ws + WS_SS);
        for (int row = bid * 8 + wave; row < MT; row += nb * 8) {
            const float* x = (row < MP) ? P.in[0] + (size_t)row * 1024 : P.in[1] + (size_t)(row - MP) * 1024;
            float s = 0.f;
#pragma unroll
            for (int i = 0; i < 4; ++i) {
                const f32x4 v = *(const f32x4*)(x + i * 256 + lane * 4);
                s += v[0] * v[0] + v[1] * v[1] + v[2] * v[2] + v[3] * v[3];
                u32x2 w; w.x = cvt_pk_bf16(v[0], v[1]); w.y = cvt_pk_bf16(v[2], v[3]);
                *(u32x2*)(xb + (size_t)row * 1024 + i * 256 + lane * 4) = w;
            }
#pragma unroll
            for (int o = 1; o < 64; o <<= 1) s += __shfl_xor(s, o);
            if (lane < 16) ss0[(size_t)row * 16 + lane] = (lane == 0) ? s : 0.f;
        }
    }
    const int gt = bid * NTHR + tid, gs = nb * NTHR;
    for (int e = gt; e < 2 * 32 * 128 * 128; e += gs) {
        const int c = e & 127, r = (e >> 7) & 127, sb = (e >> 14) & 31, l = e >> 19;
        bf16_t* kbs = (bf16_t*)(ws + WS_KBS + (size_t)l * SZ_KBS); bf16_t* vts = (bf16_t*)(ws + WS_VTS + (size_t)l * SZ_KBS);
        kbs[((size_t)(sb * 160 + r)) * 128 + c] = f2bf(P.in[2][e]);
        const int r2 = e & 127, c2 = (e >> 7) & 127;
        vts[((size_t)((sb * 2 + (c2 >> 6)) * 64 + (c2 & 63))) * 160 + r2] = f2bf(P.in[3][((size_t)((l * 32 + sb) * 128 + r2)) * 128 + c2]);
    }
    for (int e = gt; e < 2 * 32 * 16 * 128; e += gs) {
        const int c = e & 127, r = (e >> 7) & 15, sb = (e >> 11) & 31, l = e >> 16;
        bf16_t* kbs = (bf16_t*)(ws + WS_KBS + (size_t)l * SZ_KBS); bf16_t* vts = (bf16_t*)(ws + WS_VTS + (size_t)l * SZ_KBS);
        kbs[((size_t)(sb * 160 + 144 + r)) * 128 + c] = 0;
        vts[((size_t)((sb * 2 + (c >> 6)) * 64 + (c & 63))) * 160 + 144 + r] = 0;
    }
    for (int e = gt >> 4; e < 2 * 16 * 64; e += gs >> 4) {
        const int h = gt & 15;
        const int p = e & 63, g = (e >> 6) & 15, l = e >> 10;
        const float dt = expf(P.in[16][l * 16 + g]);
        const float are = P.in[14][e], aim = P.in[15][e];
        const float mag = expf(are * dt);
        const float lbr = mag * cosf(aim * dt), lbi = mag * sinf(aim * dt);
        const float den = are * are + aim * aim, nr = lbr - 1.f;
        const float kr = (nr * are + lbi * aim) / den, ki = (lbi * are - nr * aim) / den;
        if (h == 0) {
            f32x2 pw = (f32x2){lbr, lbi};
#pragma unroll
            for (int i = 0; i < 6; ++i) pw = cmul(pw, pw);
            float* lb = (float*)(ws + WS_SPAR + (size_t)l * SZ_SPAR) + (size_t)(g * 64 + p) * 4;
            lb[0] = lbr; lb[1] = lbi; lb[2] = pw.x; lb[3] = pw.y;
        }
        float* bb = (float*)(ws + WS_SPAR + (size_t)l * SZ_SPAR + 16384) + (size_t)(g * 64 + p) * 32;
        bf16_t* bfr = (bf16_t*)(ws + WS_BBF) + ((size_t)((l * 16 + g) * 128 + p)) * 32; bf16_t* bfi = bfr + 64 * 32;
        const float br = P.in[17][(size_t)e * 16 + h], bi = P.in[18][(size_t)e * 16 + h];
        const float xr = kr * br - ki * bi, xi = kr * bi + ki * br;
        bb[2 * h] = xr; bb[2 * h + 1] = xi;
        bfr[h] = f2bf(xr); bfi[h] = f2bf(xi); bfr[16 + h] = 0; bfi[16 + h] = 0;
    }
    for (int e = gt; e < 2 * 16 * 16 * 128; e += gs) {
        const int k = e & 127, h = (e >> 7) & 15, g = (e >> 11) & 15, l = e >> 15;
        const size_t si = ((size_t)((l * 16 + g) * 16 + h)) * 64 + (k & 63);
        ((bf16_t*)(ws + WS_CC))[e] = f2bf(k < 64 ? P.in[19][si] : -P.in[20][si]);
    }
    for (int e = gt; e < 2 * 256 * 256; e += gs) {
        const int k = e & 255, n = (e >> 8) & 255, l = e >> 16;
        ((bf16_t*)(ws + WS_WGLU))[e] = f2bf(P.in[22][((size_t)(l * 256 + k)) * 256 + n]);
    }
    for (int e = gt; e < 2 * 2 * 4 * 64 * 64; e += gs) {
        const int i = e & 63, o = (e >> 6) & 63, blk = (e >> 12) & 3, which = (e >> 14) & 1, l = e >> 15;
        ((bf16_t*)(ws + WS_WAX))[e] = f2bf(P.in[which ? 28 : 26][((size_t)((l * 4 + blk) * 64 + i)) * 64 + o]);
    }
}

DI f32x2 ssm_x(const f32x2 (&bb)[16], const LAS float* ut) {
    const f32x4 u0 = *(const LAS f32x4*)ut, u1 = *(const LAS f32x4*)(ut + 4), u2 = *(const LAS f32x4*)(ut + 8), u3 = *(const LAS f32x4*)(ut + 12);
    f32x2 xa = bb[0] * u0[0], xb = bb[1] * u0[1], xc = bb[2] * u0[2], xd = bb[3] * u0[3];
    xa += bb[4] * u1[0]; xb += bb[5] * u1[1]; xc += bb[6] * u1[2]; xd += bb[7] * u1[3];
    xa += bb[8] * u2[0]; xb += bb[9] * u2[1]; xc += bb[10] * u2[2]; xd += bb[11] * u2[3];
    xa += bb[12] * u3[0]; xb += bb[13] * u3[1]; xc += bb[14] * u3[2]; xd += bb[15] * u3[3];
    return (xa + xb) + (xc + xd);
}
DI void stage_u(const bf16_t* y, int row0, int T, LAS float* U32, int tid) {
    for (int idx = tid; idx < T * 32; idx += NTHR) {
        const int t = idx >> 5, seg = idx & 31;
        const u32x4 v = *(const u32x4*)(y + (size_t)(row0 + t) * 1024 + seg * 8);
        f32x4 a, b;
        a[0] = __uint_as_float(v.x << 16); a[1] = __uint_as_float(v.x & 0xffff0000u); a[2] = __uint_as_float(v.y << 16); a[3] = __uint_as_float(v.y & 0xffff0000u);
        b[0] = __uint_as_float(v.z << 16); b[1] = __uint_as_float(v.z & 0xffff0000u); b[2] = __uint_as_float(v.w << 16); b[3] = __uint_as_float(v.w & 0xffff0000u);
        *(LAS f32x4*)(U32 + t * 256 + seg * 8) = a; *(LAS f32x4*)(U32 + t * 256 + seg * 8 + 4) = b;
    }
}

DI void attn_chunk_item(CParams& P, int l, int ci, LAS unsigned char* lds, int tid, bf16_t* Yw) {
    unsigned char* ws = P.ws;
    const bf16_t* Y = (const bf16_t*)(ws + WS_Y);
    const int wave = tid >> 6, lane = tid & 63, fr = lane & 15, fq = lane >> 4;
    const bool smp = ci >= 256;
    const bf16_t* kb; const bf16_t* vt; int lpad, nkeys, nvt, row0, nsub;
    if (!smp) {
        const int b = ci >> 6, c = ci & 63, c0 = c >= 2 ? c - 2 : 0, klo = c0 * 64;
        nkeys = (c + 1) * 64 - klo; nvt = nkeys >> 4; row0 = b * 4096 + c * 64; nsub = 4;
        kb = (const bf16_t*)(ws + WS_KBP) + ((size_t)(b * 4096 + klo)) * 128; vt = (const bf16_t*)(ws + WS_VTP) + (size_t)(b * 2) * 64 * 4096 + klo; lpad = 4096;
    } else {
        const int sb = ci - 256; nkeys = 160; nvt = 9; row0 = MP + sb * 16; nsub = 1;
        kb = (const bf16_t*)(ws + WS_KBS + (size_t)l * SZ_KBS) + (size_t)sb * 160 * 128; vt = (const bf16_t*)(ws + WS_VTS + (size_t)l * SZ_KBS) + (size_t)sb * 2 * 64 * 160; lpad = 160;
    }
    const int npair = nkeys >> 5;
    LAS unsigned char* KL = lds;
    LAS unsigned char* VL = lds + 192 * 272;
    LAS float* ssq = (LAS float*)(lds + 192 * 272 + 128 * 400);
    {
        const int ppr = nkeys >> 3, nk = nkeys * 16, nv = 128 * ppr;
        u32x4 kq[6], vq[6];
#pragma unroll
        for (int i = 0; i < 6; ++i) { const int idx = tid + i * NTHR; const int ic = idx < nk ? idx : 0; kq[i] = *(const u32x4*)(kb + (size_t)(ic >> 4) * 128 + (ic & 15) * 8); }
#pragma unroll
        for (int i = 0; i < 6; ++i) { const int idx = tid + i * NTHR; const int ic = idx < nv ? idx : 0; const int r = ic / ppr, sg = ic - r * ppr; vq[i] = *(const u32x4*)(vt + (size_t)r * lpad + sg * 8); }
#pragma unroll
        for (int i = 0; i < 6; ++i) { const int idx = tid + i * NTHR; if (idx < nk) *(LAS u32x4*)(KL + (idx >> 4) * 272 + (idx & 15) * 16) = kq[i]; }
#pragma unroll
        for (int i = 0; i < 6; ++i) { const int idx = tid + i * NTHR; if (idx < nv) { const int r = idx / ppr, sg = idx - r * ppr; *(LAS u32x4*)(VL + r * 400 + sg * 16) = vq[i]; } }
    }
    const int h = wave, kvh = h >> 2;
    bf16x8 qf[4][2];
#pragma unroll
    for (int sb_ = 0; sb_ < 4; ++sb_) {
        const int su = sb_ < nsub ? sb_ : 0;
        const bf16_t* yq = Y + (size_t)(row0 + su * 16 + fr) * 1024 + 256 + h * 64;
        qf[sb_][0] = *(const bf16x8*)(yq + fq * 8); qf[sb_][1] = *(const bf16x8*)(yq + 32 + fq * 8);
    }
    const float sink = P.in[23][l * 8 + h];
    __syncthreads();
    f32x4 O[4][4];
#pragma unroll
    for (int su = 0; su < 4; ++su) {
        if (su < nsub) {
            f32x4 s[12];
#pragma unroll
            for (int kt = 0; kt < 12; ++kt) {
                if (kt < nvt) {
                    const LAS unsigned char* kp = KL + (kt * 16 + fr) * 272 + kvh * 128 + fq * 16;
                    const bf16x8 k0 = *(const LAS bf16x8*)kp, k1 = *(const LAS bf16x8*)(kp + 64);
                    f32x4 a = (f32x4){0.f, 0.f, 0.f, 0.f};
                    a = mfma16(k0, qf[su][0], a); a = mfma16(k1, qf[su][1], a);
                    s[kt] = a;
                } else s[kt] = (f32x4){-1e30f, -1e30f, -1e30f, -1e30f};
            }
            float mx = sink;
#pragma unroll
            for (int kt = 0; kt < 12; ++kt)
#pragma unroll
                for (int jj = 0; jj < 4; ++jj) mx = fmaxf(mx, s[kt][jj]);
            mx = fmaxf(mx, __shfl_xor(mx, 16)); mx = fmaxf(mx, __shfl_xor(mx, 32));
            float sum = 0.f;
#pragma unroll
            for (int kt = 0; kt < 12; ++kt)
#pragma unroll
                for (int jj = 0; jj < 4; ++jj) { const float p = __expf(s[kt][jj] - mx); s[kt][jj] = p; sum += p; }
            sum += __shfl_xor(sum, 16); sum += __shfl_xor(sum, 32);
            const float inv = 1.f / (sum + __expf(sink - mx));
#pragma unroll
            for (int dt = 0; dt < 4; ++dt) O[su][dt] = (f32x4){0.f, 0.f, 0.f, 0.f};
#pragma unroll
            for (int i = 0; i < 6; ++i) {
                if (i < npair) {
                    u32x4 pw; pw.x = cvt_pk_bf16(s[2 * i][0], s[2 * i][1]); pw.y = cvt_pk_bf16(s[2 * i][2], s[2 * i][3]); pw.z = cvt_pk_bf16(s[2 * i + 1][0], s[2 * i + 1][1]); pw.w = cvt_pk_bf16(s[2 * i + 1][2], s[2 * i + 1][3]);
                    const bf16x8 pb = __builtin_bit_cast(bf16x8, pw);
#pragma unroll
                    for (int dt = 0; dt < 4; ++dt) {
                        const LAS unsigned char* vp = VL + (kvh * 64 + dt * 16 + fr) * 400 + i * 64 + fq * 8;
                        const s16x4 lo = *(const LAS s16x4*)vp, hi = *(const LAS s16x4*)(vp + 32);
                        const bf16x8 vf = __builtin_shufflevector(lo, hi, 0, 1, 2, 3, 4, 5, 6, 7);
                        O[su][dt] = mfma16(vf, pb, O[su][dt]);
                    }
                }
            }
            float sl = 0.f;
#pragma unroll
            for (int dt = 0; dt < 4; ++dt) { O[su][dt] = O[su][dt] * inv; sl += O[su][dt][0] * O[su][dt][0] + O[su][dt][1] * O[su][dt][1] + O[su][dt][2] * O[su][dt][2] + O[su][dt][3] * O[su][dt][3]; }
            sl += __shfl_xor(sl, 16); sl += __shfl_xor(sl, 32);
            if (fq == 0) ssq[(su * 8 + h) * 16 + fr] = sl;
        }
    }
    __syncthreads();
#pragma unroll
    for (int su = 0; su < 4; ++su) {
        if (su < nsub) {
            float tot = 0.f;
#pragma unroll
            for (int hh = 0; hh < 8; ++hh) tot += ssq[(su * 8 + hh) * 16 + fr];
            const float rs = rsqrtf(tot * (1.f / 512.f) + EPS);
            bf16_t* yo = Yw + (size_t)(row0 + su * 16 + fr) * 1024 + 256 + h * 64;
#pragma unroll
            for (int dt = 0; dt < 4; ++dt) {
                u32x2 w; w.x = cvt_pk_bf16(O[su][dt][0] * rs, O[su][dt][1] * rs); w.y = cvt_pk_bf16(O[su][dt][2] * rs, O[su][dt][3] * rs);
                *(u32x2*)(yo + dt * 16 + fq * 4) = w;
            }
        }
    }
    __syncthreads();
}

DI void lru_item(CParams& P, int l, int li, LAS unsigned char* lds, int tid) {
    unsigned char* ws = P.ws;
    const int wave = tid >> 6, lane = tid & 63, fr = lane & 15, fq = lane >> 4;
    const bool smp = li >= 256;
    const int b = smp ? li - 256 : li >> 6, c = smp ? 0 : li & 63;
    const int row0 = smp ? MP + b * 16 : b * 4096 + c * 64;
    const int T = smp ? 16 : 64, TH = smp ? 16 : 32, nh = smp ? 1 : 2;
    const float* XL = (const float*)(ws + WS_XL); bf16_t* HL = (bf16_t*)(ws + WS_HL); bf16_t* PC = (bf16_t*)(ws + WS_PC);
    LAS float* XC32 = (LAS float*)lds; LAS float* A32 = (LAS float*)(lds + 32768); LAS bf16_t* XCB = (LAS bf16_t*)(lds + 65536);
    const int ch = tid & 255, part = tid >> 8;
    const float cw0 = P.in[24][(l * 4 + 0) * 256 + ch], cw1 = P.in[24][(l * 4 + 1) * 256 + ch], cw2 = P.in[24][(l * 4 + 2) * 256 + ch], cw3 = P.in[24][(l * 4 + 3) * 256 + ch], cb = P.in[25][l * 256 + ch];
    const int blk = wave >> 1, ob = (wave & 1) * 32;
    const bf16_t* WAX = (const bf16_t*)(ws + WS_WAX) + (size_t)l * 2 * 4 * 64 * 64;
    bf16x8 Bw[2][2][2];
#pragma unroll
    for (int gq = 0; gq < 2; ++gq)
#pragma unroll
        for (int ot = 0; ot < 2; ++ot)
#pragma unroll
            for (int ks = 0; ks < 2; ++ks) Bw[gq][ot][ks] = *(const bf16x8*)(WAX + ((size_t)((gq * 4 + blk) * 64 + ob + ot * 16 + fr)) * 64 + ks * 32 + fq * 8);
    float ba[2], bx[2], ls[2];
#pragma unroll
    for (int ot = 0; ot < 2; ++ot) { const int cc = blk * 64 + ob + ot * 16 + fr; ba[ot] = P.in[27][l * 256 + cc]; bx[ot] = P.in[29][l * 256 + cc]; ls[ot] = -log1pf(expf(-P.in[30][l * 256 + cc])); }
    float hl = 0.f, pc = 1.f;
    for (int hf = 0; hf < nh; ++hf) {
        {
            const int tper = TH >> 1, tb = part * tper;
            const int pos0 = (smp ? 0 : c * 64) + hf * 32 + tb;
            const size_t rb = smp ? (size_t)MP + b * 16 : (size_t)b * 4096;
            float xw[19];
#pragma unroll
            for (int i = 0; i < 19; ++i) {
                const int pp = pos0 + i - 3;
                xw[i] = 0.f;
                if (i < tper + 3) {
                    if (pp >= 0) xw[i] = XL[(rb + pp) * 256 + ch];
                    else if (smp) xw[i] = P.in[6][((size_t)((l * 32 + b) * 3 + (pp + 3))) * 256 + ch];
                }
            }
#pragma unroll
            for (int tt = 0; tt < 16; ++tt) {
                if (tt < tper) {
                    const int t = tb + tt;
                    const float a = cb + cw0 * xw[tt] + cw1 * xw[tt + 1] + cw2 * xw[tt + 2] + cw3 * xw[tt + 3];
                    XC32[t * 256 + ch] = a; XCB[t * 264 + ch] = f2bf(a);
                }
            }
        }
        __syncthreads();
#pragma unroll
        for (int tt = 0; tt < 2; ++tt) {
            if (tt * 16 < TH) {
                bf16x8 A[2];
#pragma unroll
                for (int ks = 0; ks < 2; ++ks) A[ks] = *(const LAS bf16x8*)(XCB + (tt * 16 + fr) * 264 + blk * 64 + ks * 32 + fq * 8);
#pragma unroll
                for (int ot = 0; ot < 2; ++ot) {
                    f32x4 ga = (f32x4){0.f, 0.f, 0.f, 0.f}, gx = ga;
#pragma unroll
                    for (int ks = 0; ks < 2; ++ks) { ga = mfma16(A[ks], Bw[0][ot][ks], ga); gx = mfma16(A[ks], Bw[1][ot][ks], gx); }
                    const int cc = blk * 64 + ob + ot * 16 + fr;
#pragma unroll
                    for (int j = 0; j < 4; ++j) {
                        const int t = tt * 16 + fq * 4 + j;
                        const float r = sigmoidf_(ga[j] + ba[ot]), ig = sigmoidf_(gx[j] + bx[ot]);
                        const float la = 8.f * r * ls[ot];
                        const float av = __expf(la), mult = sqrtf(-expm1f(2.f * la));
                        const float xc = XC32[t * 256 + cc];
                        XC32[t * 256 + cc] = mult * ig * xc; A32[t * 256 + cc] = av;
                    }
                }
            }
        }
        __syncthreads();
        if (tid < 256) {
            for (int t = 0; t < TH; ++t) {
                const float av = A32[t * 256 + ch], bt = XC32[t * 256 + ch];
                hl = av * hl + bt; pc = av * pc;
                const size_t r = (size_t)(row0 + hf * 32 + t) * 256 + ch;
                HL[r] = f2bf(hl); PC[r] = f2bf(pc);
            }
        }
        __syncthreads();
    }
    if (tid < 256) {
        if (!smp) { float* ls_ = (float*)(ws + WS_LSUM) + ((size_t)(b * 64 + c) * 2) * 256; ls_[ch] = pc; ls_[256 + ch] = hl; }
        if (smp) { for (int i = 0; i < 3; ++i) P.out[O_CONVS + ((size_t)((l * 32 + b) * 3 + i)) * 256 + ch] = XL[((size_t)(MP + b * 16 + 13 + i)) * 256 + ch]; }
        else if (c == 63) { for (int i = 0; i < 3; ++i) P.out[O_CONVP + ((size_t)((l * 4 + b) * 3 + i)) * 256 + ch] = XL[((size_t)(b * 4096 + 4093 + i)) * 256 + ch]; }
    }
    (void)T;
}

DI void ssma_item(CParams& P, int l, int si, LAS unsigned char* lds, int tid) {
    unsigned char* ws = P.ws;
    const int wave = tid >> 6, lane = tid & 63, fr = lane & 15, fq = lane >> 4;
    const int b = si >> 6, c = si & 63, row0 = b * 4096 + c * 64;
    const bf16_t* Y = (const bf16_t*)(ws + WS_Y);
    LAS float* XW = (LAS float*)lds + wave * (32 * 132);
#pragma unroll 1
    for (int gi = 0; gi < 2; ++gi) {
        const int g = wave * 2 + gi;
        const f32x4 lb4 = *(const f32x4*)((const float*)(ws + WS_SPAR + (size_t)l * SZ_SPAR) + (size_t)(g * 64 + lane) * 4);
        const f32x2 lb = (f32x2){lb4[0], lb4[1]};
        bf16x8 Bf[8];
        const bf16_t* bbf = (const bf16_t*)(ws + WS_BBF) + ((size_t)((l * 16 + g) * 128 + fr)) * 32 + fq * 8;
#pragma unroll
        for (int nt = 0; nt < 8; ++nt) Bf[nt] = *(const bf16x8*)(bbf + (size_t)nt * 16 * 32);
        bf16x8 Af[4];
#pragma unroll
        for (int mt = 0; mt < 4; ++mt) { Af[mt] = (bf16x8){0, 0, 0, 0, 0, 0, 0, 0}; if (fq < 2) Af[mt] = *(const bf16x8*)(Y + (size_t)(row0 + mt * 16 + fr) * 1024 + g * 16 + fq * 8); }
        f32x2 H = (f32x2){0.f, 0.f};
#pragma unroll
        for (int hf = 0; hf < 2; ++hf) {
#pragma unroll
            for (int m2 = 0; m2 < 2; ++m2)
#pragma unroll
                for (int nt = 0; nt < 8; ++nt) {
                    const f32x4 a = mfma16(Af[hf * 2 + m2], Bf[nt], (f32x4){0.f, 0.f, 0.f, 0.f});
#pragma unroll
                    for (int jj = 0; jj < 4; ++jj) XW[(m2 * 16 + fq * 4 + jj) * 132 + nt * 16 + fr] = a[jj];
                }
            lds_fence();
#pragma unroll 8
            for (int t = 0; t < 32; ++t) { const f32x2 x = (f32x2){XW[t * 132 + lane], XW[t * 132 + 64 + lane]}; H = cmul(lb, H) + x; }
            lds_fence();
        }
        *(f32x2*)((float*)(ws + WS_SSUM) + ((size_t)((b * 64 + c) * 16 + g) * 64 + lane) * 2) = H;
    }
    __syncthreads();
}

DI void m1_phase(CParams& P, int l, LAS unsigned char* lds, const int tid, bf16_t* Yw, const int bid, const int nb, const int id_lo = 0, const int id_hi = 832) {
    const int wave = tid >> 6, lane = tid & 63;
    for (int id = id_lo + bid; id < id_hi; id += nb) {
        int t2 = tid; asm volatile("" : "+v"(t2));
        if (id < 256) ssma_item(P, l, id, lds, t2);
        else if (id < 544) lru_item(P, l, id - 256, lds, t2);
        else attn_chunk_item(P, l, id - 544, lds, t2, Yw);
    }
}
DI void m2_item(CParams& P, int l, int id, LAS unsigned char* lds, int tid, bf16_t* Yw) {
    unsigned char* ws = P.ws;
    const int wave = tid >> 6, lane = tid & 63, fr = lane & 15, fq = lane >> 4;
    const bool smp = id >= 256;
    const int b = smp ? id - 256 : id >> 6, c = smp ? 0 : id & 63;
    const int row0 = smp ? MP + b * 16 : b * 4096 + c * 64;
    const int T = smp ? 16 : 64, ntb = T >> 4;
    const bool lastc = smp || c == 63;
    bf16_t* Y = (bf16_t*)(ws + WS_Y);
    LAS float* XW = (LAS float*)lds + wave * (16 * 132);
    LAS bf16_t* Z = (LAS bf16_t*)(lds + 67584);
    LAS bf16_t* HS = (LAS bf16_t*)(lds + 67584 + 33792) + wave * (16 * 136);
    LAS float* RED = (LAS float*)(lds + 67584 + 33792 + 34816);
    f32x2 Hc0, Hc1; f32x4 lbq0, lbq1;
#pragma unroll
    for (int gi = 0; gi < 2; ++gi) {
        const int g = wave * 2 + gi;
        const f32x4 lb4 = *(const f32x4*)((const float*)(ws + WS_SPAR + (size_t)l * SZ_SPAR) + (unsigned)(g * 64 + lane) * 4u);
        if (gi) lbq1 = lb4; else lbq0 = lb4;
        const f32x2 lb64 = (f32x2){lb4[2], lb4[3]};
        f32x2 H = (f32x2){0.f, 0.f};
        if (smp) { const size_t si = ((size_t)((l * 32 + b) * 16 + g)) * 64 + lane; H = (f32x2){P.in[4][si], P.in[5][si]}; }
        else {
            const float* sp = (const float*)(ws + WS_SSUM) + ((size_t)((b * 64) * 16 + g) * 64 + lane) * 2;
            for (int j0 = 0; j0 < c; j0 += 8) {
                f32x2 S[8];
#pragma unroll
                for (int k = 0; k < 8; ++k) { const int jj = (j0 + k < c) ? j0 + k : c - 1; S[k] = *(const f32x2*)(sp + (unsigned)jj * 2048u); }
#pragma unroll
                for (int k = 0; k < 8; ++k) if (j0 + k < c) H = cmul(lb64, H) + S[k];
            }
        }
        if (gi) Hc1 = H; else Hc0 = H;
    }
    {
        const bf16_t* HL = (const bf16_t*)(ws + WS_HL); const bf16_t* PC = (const bf16_t*)(ws + WS_PC);
        f32x4 Hin = (f32x4){0.f, 0.f, 0.f, 0.f};
        if (smp) Hin = *(const f32x4*)(P.in[7] + (size_t)(l * 32 + b) * 256 + lane * 4);
        else {
            const float* lsum = (const float*)(ws + WS_LSUM) + (size_t)(b * 64) * 2 * 256 + lane * 4;
            for (int j0 = 0; j0 < c; j0 += 4) {
                f32x4 A[4], S[4];
#pragma unroll
                for (int k = 0; k < 4; ++k) { const int jj = (j0 + k < c) ? j0 + k : c - 1; A[k] = *(const f32x4*)(lsum + (unsigned)jj * 512u); S[k] = *(const f32x4*)(lsum + (unsigned)jj * 512u + 256); }
#pragma unroll
                for (int k = 0; k < 4; ++k) if (j0 + k < c) Hin = A[k] * Hin + S[k];
            }
        }
        for (int t0 = wave; t0 < T; t0 += 32) {
            f32x4 hl[4], pc[4]; u32x2 gw[4];
#pragma unroll
            for (int q = 0; q < 4; ++q) {
                const int t = (t0 + 8 * q < T) ? t0 + 8 * q : t0; const size_t row = row0 + t;
                const u32x2 hw = *(const u32x2*)(HL + row * 256 + lane * 4), pw = *(const u32x2*)(PC + row * 256 + lane * 4);
                hl[q][0] = __uint_as_float(hw.x << 16); hl[q][1] = __uint_as_float(hw.x & 0xffff0000u); hl[q][2] = __uint_as_float(hw.y << 16); hl[q][3] = __uint_as_float(hw.y & 0xffff0000u);
                pc[q][0] = __uint_as_float(pw.x << 16); pc[q][1] = __uint_as_float(pw.x & 0xffff0000u); pc[q][2] = __uint_as_float(pw.y << 16); pc[q][3] = __uint_as_float(pw.y & 0xffff0000u);
                gw[q] = *(const u32x2*)(Y + row * 1024 + 768 + lane * 4);
            }
#pragma unroll
            for (int q = 0; q < 4; ++q) {
                const int t = t0 + 8 * q;
                if (t < T) {
                    const size_t row = row0 + t;
                    const f32x4 h = hl[q] + pc[q] * Hin;
                    f32x4 gl; gl[0] = __uint_as_float(gw[q].x << 16); gl[1] = __uint_as_float(gw[q].x & 0xffff0000u); gl[2] = __uint_as_float(gw[q].y << 16); gl[3] = __uint_as_float(gw[q].y & 0xffff0000u);
                    f32x4 yl; float s = 0.f;
#pragma unroll
                    for (int jj = 0; jj < 4; ++jj) { yl[jj] = gelu_tanh(gl[jj]) * h[jj]; s += yl[jj] * yl[jj]; }
#pragma unroll
                    for (int o = 1; o < 64; o <<= 1) s += __shfl_xor(s, o);
                    const float rs = rsqrtf(s * (1.f / 256.f) + EPS);
                    u32x2 w; w.x = cvt_pk_bf16(yl[0] * rs, yl[1] * rs); w.y = cvt_pk_bf16(yl[2] * rs, yl[3] * rs);
                    *(u32x2*)(Yw + row * 1024 + 768 + lane * 4) = w;
                    if (lastc && t == T - 1) *(f32x4*)(P.out + (smp ? O_LRUS + (size_t)(l * 32 + b) * 256 : O_LRUP + (size_t)(l * 4 + b) * 256) + lane * 4) = h;
                }
            }
        }
    }
    __syncthreads();
#pragma unroll 1
    for (int gi = 0; gi < 2; ++gi) {
        const int g = wave * 2 + gi;
        const f32x4 lb4 = gi ? lbq1 : lbq0;
        const f32x2 lb = (f32x2){lb4[0], lb4[1]};
        bf16x8 Bf[8];
        const bf16_t* bbf = (const bf16_t*)(ws + WS_BBF) + ((size_t)((l * 16 + g) * 128 + fr)) * 32 + fq * 8;
#pragma unroll
        for (int nt = 0; nt < 8; ++nt) Bf[nt] = *(const bf16x8*)(bbf + (size_t)nt * 16 * 32);
        bf16x8 Af[4];
#pragma unroll
        for (int mt = 0; mt < 4; ++mt) { Af[mt] = (bf16x8){0, 0, 0, 0, 0, 0, 0, 0}; if (fq < 2 && mt < ntb) Af[mt] = *(const bf16x8*)(Y + (size_t)(row0 + mt * 16 + fr) * 1024 + g * 16 + fq * 8); }
        float usk[4][4];
#pragma unroll
        for (int mt = 0; mt < 4; ++mt)
#pragma unroll
            for (int jj = 0; jj < 4; ++jj) usk[mt][jj] = (mt < ntb) ? bf2f(Y[(size_t)(row0 + mt * 16 + fq * 4 + jj) * 1024 + g * 16 + fr]) : 0.f;
        bf16x8 Cw[4];
        const bf16_t* ccp = (const bf16_t*)(ws + WS_CC) + ((size_t)((l * 16 + g) * 16 + fr)) * 128 + fq * 8;
#pragma unroll
        for (int ks = 0; ks < 4; ++ks) Cw[ks] = *(const bf16x8*)(ccp + ks * 32);
        const float dsk = P.in[21][l * 256 + g * 16 + fr];
        f32x2 H = gi ? Hc1 : Hc0;
#pragma unroll
        for (int tb = 0; tb < 4; ++tb) {
            if (tb < ntb) {
#pragma unroll
                for (int nt = 0; nt < 8; ++nt) {
                    const f32x4 a = mfma16(Af[tb], Bf[nt], (f32x4){0.f, 0.f, 0.f, 0.f});
#pragma unroll
                    for (int jj = 0; jj < 4; ++jj) XW[(fq * 4 + jj) * 132 + nt * 16 + fr] = a[jj];
                }
                lds_fence();
#pragma unroll
                for (int tt = 0; tt < 16; ++tt) {
                    const f32x2 x = (f32x2){XW[tt * 132 + lane], XW[tt * 132 + 64 + lane]};
                    H = cmul(lb, H) + x;
                    const unsigned pk = cvt_pk_bf16(H.x, H.y);
                    HS[tt * 136 + lane] = (bf16_t)(pk & 0xffffu); HS[tt * 136 + 64 + lane] = (bf16_t)(pk >> 16);
                }
                lds_fence();
                f32x4 acc = (f32x4){0.f, 0.f, 0.f, 0.f};
#pragma unroll
                for (int ks = 0; ks < 4; ++ks) { const bf16x8 A = *(const LAS bf16x8*)(HS + fr * 136 + ks * 32 + fq * 8); acc = mfma16(A, Cw[ks], acc); }
#pragma unroll
                for (int jj = 0; jj < 4; ++jj) {
                    const int t = tb * 16 + fq * 4 + jj;
                    const float yv = acc[jj] + dsk * usk[tb][jj];
                    Z[t * 264 + g * 16 + fr] = f2bf(gelu_tanh(yv));
                }
                lds_fence();
            }
        }
        if (lastc) {
            const size_t so = smp ? ((size_t)((l * 32 + b) * 16 + g)) * 64 + lane : ((size_t)((l * 4 + b) * 16 + g)) * 64 + lane;
            P.out[(smp ? O_SRES : O_SREP) + so] = H.x; P.out[(smp ? O_SIMS : O_SIMP) + so] = H.y;
        }
    }
    __syncthreads();
    {
        const bf16_t* WG = (const bf16_t*)(ws + WS_WGLU) + (size_t)l * 65536;
        bf16x8 Bw[2][8];
#pragma unroll
        for (int i = 0; i < 2; ++i)
#pragma unroll
            for (int ks = 0; ks < 8; ++ks) Bw[i][ks] = *(const bf16x8*)(WG + ((size_t)((2 * wave + i) * 16 + fr)) * 256 + ks * 32 + fq * 8);
        float o[4][2][4];
#pragma unroll
        for (int tt = 0; tt < 4; ++tt) {
            if (tt < ntb) {
                f32x4 a0 = (f32x4){0.f, 0.f, 0.f, 0.f}, a1 = a0;
#pragma unroll
                for (int ks = 0; ks < 8; ++ks) { const bf16x8 A = *(const LAS bf16x8*)(Z + (tt * 16 + fr) * 264 + ks * 32 + fq * 8); a0 = mfma16(A, Bw[0][ks], a0); a1 = mfma16(A, Bw[1][ks], a1); }
#pragma unroll
                for (int j = 0; j < 4; ++j) {
                    const int t = tt * 16 + fq * 4 + j;
                    const float z0 = bf2f(Z[t * 264 + (2 * wave) * 16 + fr]), z1 = bf2f(Z[t * 264 + (2 * wave + 1) * 16 + fr]);
                    const float o0 = z0 * sigmoidf_(a0[j]), o1 = z1 * sigmoidf_(a1[j]);
                    o[tt][0][j] = o0; o[tt][1][j] = o1;
                    float s = o0 * o0 + o1 * o1;
                    s += __shfl_xor(s, 1); s += __shfl_xor(s, 2); s += __shfl_xor(s, 4); s += __shfl_xor(s, 8);
                    if (fr == 0) RED[wave * 64 + t] = s;
                }
            }
        }
        __syncthreads();
#pragma unroll
        for (int tt = 0; tt < 4; ++tt) {
            if (tt < ntb) {
#pragma unroll
                for (int j = 0; j < 4; ++j) {
                    const int t = tt * 16 + fq * 4 + j;
                    float tot = 0.f;
#pragma unroll
                    for (int w = 0; w < 8; ++w) tot += RED[w * 64 + t];
                    const float rs = rsqrtf(tot * (1.f / 256.f) + EPS);
                    bf16_t* yp = Yw + (size_t)(row0 + t) * 1024 + (2 * wave) * 16 + fr;
                    yp[0] = f2bf(o[tt][0][j] * rs); yp[16] = f2bf(o[tt][1][j] * rs);
                }
            }
        }
    }
    __syncthreads();
}
DI void m2_phase(CParams& P, int l, LAS unsigned char* lds, const int tid, bf16_t* Yw, const int bid, const int nb) {
    if (nb == 256) {
        { int t2 = tid; asm volatile("" : "+v"(t2)); m2_item(P, l, bid, lds, t2, Yw); }
        if ((bid & 63) < 8) { int t2 = tid; asm volatile("" : "+v"(t2)); m2_item(P, l, 256 + (bid >> 6) * 8 + (bid & 7), lds, t2, Yw); }
    } else
    for (int id = bid; id < 288; id += nb) { int t2 = tid; asm volatile("" : "+v"(t2)); m2_item(P, l, id, lds, t2, Yw); }
}

DI void final_phase(CParams& P, const int tid, const int bid, const int nb) {
    const int lane = tid & 63, wave = tid >> 6;
    const float* ss = (const float*)(P.ws + WS_SS);
    const float* g = P.in[37];
    f32x4 gv[4];
#pragma unroll
    for (int i = 0; i < 4; ++i) gv[i] = *(const f32x4*)(g + i * 256 + lane * 4);
    const bf16_t* xb = (const bf16_t*)(P.ws + WS_XB);
    for (int row = bid * 8 + wave; row < MT; row += nb * 8) {
        const float rs = row_rstd(ss, row, 1.f / 1024.f);
        float* x = P.out + (size_t)row * 1024;
        u32x2 w[4];
#pragma unroll
        for (int i = 0; i < 4; ++i) w[i] = *(const u32x2*)(xb + (size_t)row * 1024 + i * 256 + lane * 4);
#pragma unroll
        for (int i = 0; i < 4; ++i) { f32x4 v; v[0] = __uint_as_float(w[i].x << 16); v[1] = __uint_as_float(w[i].x & 0xffff0000u); v[2] = __uint_as_float(w[i].y << 16); v[3] = __uint_as_float(w[i].y & 0xffff0000u);
            v = v * rs * gv[i]; *(f32x4*)(x + i * 256 + lane * 4) = v; }
    }
}


template <int K>
DI void sgemm_resid(const bf16_t* A  , const bf16_t* Bt  , const float* xin  , bf16_t* xb, float* ss  , float scale, bool first,
                    LAS unsigned char* lds, const int tid, const int bid, const int nb) {
    const int wave = tid >> 6, lane = tid & 63, fr = lane & 15, fq = lane >> 4;
    constexpr int KW = K / 8, NS = KW / 32;
    LAS float* PART = (LAS float*)lds;
    for (int it = bid; it < 256; it += nb) {
        const int r0 = (it >> 4) * 32, c0 = (it & 15) * 64, k0 = wave * KW;
        f32x4 acc[2][4];
#pragma unroll
        for (int i = 0; i < 2; ++i)
#pragma unroll
            for (int j = 0; j < 4; ++j) acc[i][j] = (f32x4){0.f, 0.f, 0.f, 0.f};
        const bf16_t* ap = A + (size_t)(r0 + fr) * K + k0 + fq * 8;
        const bf16_t* bp = Bt + (size_t)(c0 + fr) * K + k0 + fq * 8;
#pragma unroll
        for (int kb = 0; kb < NS; kb += 4) {
            bf16x8 a[4][2], b[4][4];
#pragma unroll
            for (int s4 = 0; s4 < 4; ++s4) {
                if (kb + s4 < NS) {
#pragma unroll
                    for (int i = 0; i < 2; ++i) a[s4][i] = *(const bf16x8*)(ap + (size_t)i * 16 * K + (kb + s4) * 32);
#pragma unroll
                    for (int j = 0; j < 4; ++j) b[s4][j] = *(const bf16x8*)(bp + (size_t)j * 16 * K + (kb + s4) * 32);
                }
            }
            __builtin_amdgcn_sched_barrier(0);
#pragma unroll
            for (int s4 = 0; s4 < 4; ++s4) {
                if (kb + s4 < NS) {
#pragma unroll
                    for (int i = 0; i < 2; ++i)
#pragma unroll
                        for (int j = 0; j < 4; ++j) acc[i][j] = mfma16(b[s4][j], a[s4][i], acc[i][j]);
                }
            }
            __builtin_amdgcn_sched_barrier(0);
        }
#pragma unroll
        for (int i = 0; i < 2; ++i)
#pragma unroll
            for (int j = 0; j < 4; ++j) *(LAS f32x4*)(PART + wave * 2048 + (i * 16 + fr) * 64 + j * 16 + fq * 4) = acc[i][j];
        __syncthreads();
        {
            const int row = tid >> 4, c4 = (tid & 15) * 4;
            f32x4 sum = *(const LAS f32x4*)(PART + row * 64 + c4);
#pragma unroll
            for (int w = 1; w < 8; ++w) sum += *(const LAS f32x4*)(PART + w * 2048 + row * 64 + c4);
            const size_t off = (size_t)(r0 + row) * 1024 + c0 + c4;
            f32x4 xo;
            if (first) xo = *(const f32x4*)(xin + off);
            else { const u32x2 o = *(const u32x2*)(xb + off); xo[0] = __uint_as_float(o.x << 16); xo[1] = __uint_as_float(o.x & 0xffff0000u); xo[2] = __uint_as_float(o.y << 16); xo[3] = __uint_as_float(o.y & 0xffff0000u); }
            const f32x4 v = xo + sum * scale;
            u32x2 pk; pk.x = cvt_pk_bf16(v[0], v[1]); pk.y = cvt_pk_bf16(v[2], v[3]);
            *(u32x2*)(xb + off) = pk;
            float sq = (v[0] * v[0] + v[1] * v[1]) + (v[2] * v[2] + v[3] * v[3]);
            sq += __shfl_xor(sq, 1); sq += __shfl_xor(sq, 2); sq += __shfl_xor(sq, 4); sq += __shfl_xor(sq, 8);
            if ((tid & 15) == 0) ss[(size_t)(r0 + row) * 16 + (it & 15)] = sq;
        }
        __syncthreads();
    }
}

__global__ void __launch_bounds__(NTHR) hymba_fwd(Params Pa) {
    extern __shared__ __attribute__((aligned(16))) unsigned char lds_raw[];
    LAS unsigned char* lds = (LAS unsigned char*)lds_raw;
    cg::grid_group grid = cg::this_grid();
    volatile LAS unsigned* xb_st = (volatile LAS unsigned*)((LAS unsigned char*)lds_raw + LDS_BYTES - 16);
    const int wv = __builtin_amdgcn_readfirstlane((int)(threadIdx.x >> 6));
    if (threadIdx.x == 0) { xb_st[0] = 0u; xb_st[1] = 0u; }
    __syncthreads();
    const XcdBarrier xbar = xcd_barrier_post((unsigned*)(Pa.ws + WS_BAR), xb_st);
    const int ph_lo = Pa.ph_lo, ph_hi = Pa.ph_hi;
    for (int ph = ph_lo; ph < ph_hi; ++ph) {
        CParams* Pk = (CParams*)__builtin_amdgcn_kernarg_segment_ptr();
        asm volatile("" : "+s"(Pk));
        CParams& P = *Pk;
        int wvl_ = wv; asm volatile("" : "+s"(wvl_));
        int tid = wvl_ * 64 + (int)__builtin_amdgcn_mbcnt_hi(~0u, __builtin_amdgcn_mbcnt_lo(~0u, 0u)); asm volatile("" : "+v"(tid));
        int bid = blockIdx.x, nb = gridDim.x; asm volatile("" : "+s"(bid), "+s"(nb));
        unsigned char* ws = P.ws;
        bf16_t* XB = (bf16_t*)(ws + WS_XB); bf16_t* Y = (bf16_t*)(ws + WS_Y); bf16_t* ACT = (bf16_t*)(ws + WS_BIG);
        float* SS = (float*)(ws + WS_SS);
        if (ph == 0) { prep_phase(P, lds, tid, bid, nb); if (DUP & 1) { grid.sync(); prep_phase(P, lds, tid, bid, nb); } }
        else if (ph == 17) final_phase(P, tid, bid, nb);
        else {
            const int l = (ph - 1) >> 3, s = (ph - 1) & 7;
            if (s == 0 || s == 6) {
                const int f = s == 6;
                pg8::Gemm g{XB, (const bf16_t*)(ws + WS_WGU + (size_t)(l * 2 + f) * SZ_WGU), MT, 5632, 1024};
                pg8::StaticOrder S; S.init(MT, 5632, nb, bid);
                EpiGateUp E{ACT, SS};
                pg8::gemm_phase<EpiGateUp, pg8::StaticOrder, GEMM_ALIGN, GEMM_SP2>(lds, g, S, E, tid);
                if (l == 0) {
                    const int rounds = (1452 + nb - 1) / nb, b0 = 1452 - (rounds - 1) * nb;
                    const int cf = (b0 < nb) ? bid - b0 : bid, cs = (b0 < nb) ? nb - b0 : nb;
                    if (cf >= 0) {
                        if (!f) { convert_tiles(P, lds, tid, cf, cs, 704, 1614); convert_tiles(P, lds, tid, cf, cs, 2112, 2432); }
                        else convert_tiles(P, lds, tid, cf, cs, 3634, 4864);
                    }
                }
            } else if (s == 1 || s == 7) {
                const int f = s == 7;
                const bf16_t* Wd = (const bf16_t*)(ws + WS_WD + (size_t)(l * 2 + f) * SZ_WD);
                pg8::Gemm g{ACT, Wd, MP, 1024, 2816};
                pg8::StaticOrder S; S.init(MP, 1024, nb, bid);
                const bool first = false;
                EpiResid E{P.in[0], XB, SS, 0.5f, first};
                pg8::gemm_phase<EpiResid, pg8::StaticOrder, GEMM_ALIGN, GEMM_SP2>(lds, g, S, E, tid);
                sgemm_resid<2816>(ACT + (size_t)MP * DFF, Wd, P.in[1], XB + (size_t)MP * 1024, SS + (size_t)MP * 16, 0.5f, first, lds, tid, bid, nb);
            } else if (s == 2) {
                pg8::Gemm g{XB, (const bf16_t*)(ws + WS_WIN + (size_t)l * SZ_WIN), MT, 1536, 1024};
                pg8::StaticOrder S; S.init(MT, 1536, nb, bid);
                EpiProj E{SS, Y, (float*)(ws + WS_XL), (bf16_t*)(ws + WS_KBP), (bf16_t*)(ws + WS_VTP),
                          (bf16_t*)(ws + WS_KBS + (size_t)l * SZ_KBS), (bf16_t*)(ws + WS_VTS + (size_t)l * SZ_KBS),
                          P.out + O_KP + (size_t)l * 4 * 128 * 128, P.out + O_VP + (size_t)l * 4 * 128 * 128, P.out + O_KS + (size_t)l * 32 * 16 * 128, P.out + O_VS + (size_t)l * 32 * 16 * 128};
                pg8::gemm_phase<EpiProj, pg8::StaticOrder, GEMM_ALIGN, GEMM_SP2>(lds, g, S, E, tid);
                if (l == 0) {
                    const int rounds = (396 + nb - 1) / nb, b0 = 396 - (rounds - 1) * nb;
                    const int cf = (b0 < nb) ? bid - b0 : bid, cs = (b0 < nb) ? nb - b0 : nb;
                    if (cf >= 0) { convert_tiles(P, lds, tid, cf, cs, 1614, 2112); convert_tiles(P, lds, tid, cf, cs, 2432, 3634); }
                }
            } else if (s == 3) { if (DUP & (2 | 32 | 64 | 128)) { m1_phase(P, l, lds, tid, XB, bid, nb, (DUP & 2) ? 0 : (DUP & 32) ? 0 : (DUP & 64) ? 256 : 544, (DUP & 2) ? 832 : (DUP & 32) ? 256 : (DUP & 64) ? 544 : 832); grid.sync(); } m1_phase(P, l, lds, tid, Y, bid, nb); }
            else if (s == 4) { if (DUP & 4) { m2_phase(P, l, lds, tid, XB, bid, nb); grid.sync(); } m2_phase(P, l, lds, tid, Y, bid, nb); }
            else {
                const bf16_t* Wo = (const bf16_t*)(ws + WS_WOUT + (size_t)l * SZ_WOUT);
                pg8::Gemm g{Y, Wo, MP, 1024, 1024};
                pg8::StaticOrder S; S.init(MP, 1024, nb, bid);
                EpiResid E{P.in[0], XB, SS, 1.0f, false};
                pg8::gemm_phase<EpiResid, pg8::StaticOrder, GEMM_ALIGN, GEMM_SP2>(lds, g, S, E, tid);
                sgemm_resid<1024>(Y + (size_t)MP * 1024, Wo, P.in[1], XB + (size_t)MP * 1024, SS + (size_t)MP * 16, 1.0f, false, lds, tid, bid, nb);
            }
        }
        if (ph + 1 < ph_hi) { if (ph_hi == 0x7fff) grid.sync(); else xcd_barrier(xbar, tid == 0); }
    }
}

#ifndef DUP
#define DUP 0
#endif
#ifndef N_PHASE_LAUNCH
#define N_PHASE_LAUNCH 0
#endif
extern "C" void kernel_launch(void* const* d_in, const int* in_sizes, int n_in, void* d_out, int out_size, void* d_ws, size_t ws_size, hipStream_t stream) {
    static int grid_blocks = 0;
    if (!grid_blocks) {
        int dev = 0, cus = 0, per_cu = 0;
        hipGetDevice(&dev);
        hipDeviceGetAttribute(&cus, hipDeviceAttributeMultiprocessorCount, dev);
        if (hipFuncSetAttribute((const void*)hymba_fwd, hipFuncAttributeMaxDynamicSharedMemorySize, LDS_BYTES) != hipSuccess) fprintf(stderr, "hipFuncSetAttribute failed\n");
        if (hipOccupancyMaxActiveBlocksPerMultiprocessor(&per_cu, (const void*)hymba_fwd, NTHR, LDS_BYTES) != hipSuccess || per_cu < 1) { fprintf(stderr, "occupancy query: %d\n", per_cu); per_cu = 1; }
        (void)hipGetLastError();
        if (per_cu > 1) per_cu = 1;
        grid_blocks = cus * per_cu;
        if (n_in != 38 || (size_t)out_size != O_END || ws_size < WS_END) fprintf(stderr, "kernel_launch: unexpected sizes n_in %d out %d ws %zu\n", n_in, out_size, ws_size);
    }
    if (hipMemsetAsync((unsigned char*)d_ws + WS_BAR, 0, (size_t)XCD_BAR_WORDS * 4, stream) != hipSuccess) fprintf(stderr, "memset of barrier words failed\n");
    Params p{};
    for (int i = 0; i < 38; ++i) p.in[i] = (const float*)d_in[i];
    p.out = (float*)d_out; p.ws = (unsigned char*)d_ws;
#if N_PHASE_LAUNCH
    for (int ph = 0; ph < 18; ++ph) { p.ph_lo = ph; p.ph_hi = ph + 1; hipLaunchKernelGGL(hymba_fwd, dim3(grid_blocks), dim3(NTHR), LDS_BYTES, stream, p); }
#else
    p.ph_lo = 0; p.ph_hi = 18;
    void* args[] = {&p};
    hipError_t e = hipLaunchCooperativeKernel((const void*)hymba_fwd, dim3(grid_blocks), dim3(NTHR), args, LDS_BYTES, stream);
    if (e != hipSuccess) fprintf(stderr, "cooperative launch failed: %s (grid %d)\n", hipGetErrorString(e), grid_blocks);
#endif
}
```
